# Optimizing an MI355X kernel written in HIP

```python
import math
import jax, jax.numpy as jnp
from jax import lax
import numpy as np

D_MODEL = 2048
BATCH = 2
SEQ = 16384
DEPTH = 1
DEC_BATCH = 32
DEC_SEQ = 64
PAST_LEN = 1024

CHUNK = 64
DA_HEADS = 8
DA_HD = 64
DA_VD = 2 * DA_HD
DA_W = DA_HEADS * 2 * DA_HD
CB_HEADS = 8
CB_HD = 128
CB_PREV = 8
CB_CLIP = 128
CB_W = CB_HEADS * CB_HD
X_HEADS = 4
X_HD = 128
X_W = X_HEADS * X_HD
N_MEM = 256
T5_BUCKETS = 32
T5_MAX_DIST = 128
D_FF = 5632
Q_BLOCK = 128
EPS = 1e-6
NEG_INF = -1e30
IN_COLS = 3 * DA_W + 3 * CB_W + 2 * D_MODEL
SPLITS = [DA_W, 2 * DA_W, 3 * DA_W, 3 * DA_W + CB_W, 3 * DA_W + 2 * CB_W, 3 * DA_W + 3 * CB_W]

kernel_name = 'hybrid_stream_diffattn_chunkband_step'


def rmsnorm(x, g):
    xf = x.astype(jnp.float32)
    y = xf * lax.rsqrt(jnp.mean(xf * xf, axis=-1, keepdims=True) + EPS)
    return (y * g.astype(jnp.float32)).astype(x.dtype)


def swiglu(x, w_gate, w_up, w_down):
    return (jax.nn.silu(x @ w_gate) * (x @ w_up)) @ w_down


def t5_bucket(rel):
    nb = T5_BUCKETS // 2
    max_exact = nb // 2
    base = jnp.where(rel > 0, nb, 0)
    n = jnp.abs(rel)
    nf = jnp.maximum(n, 1).astype(jnp.float32)
    large = max_exact + (jnp.log(nf / max_exact) / math.log(T5_MAX_DIST / max_exact)
                         * (nb - max_exact)).astype(jnp.int32)
    large = jnp.minimum(large, nb - 1)
    return base + jnp.where(n < max_exact, n, large)


def t5_bias_of(rel, table):
    return jnp.transpose(table[t5_bucket(rel)], (2, 0, 1)).astype(jnp.float32)


def band_bias_of(rel, table):
    return jnp.transpose(table[jnp.clip(rel, -CB_CLIP, CB_CLIP) + CB_CLIP], (2, 0, 1)).astype(jnp.float32)


def diff_attend(q, k, v, bias, mask, lam):
    s = jnp.einsum('bqhmd,bkhmd->bhmqk', q, k).astype(jnp.float32) * DA_HD ** -0.5 + bias[None, :, None]
    s = jnp.where(mask, s, NEG_INF)
    p = jax.nn.softmax(s, axis=-1)
    a = p[:, :, 0] - lam * p[:, :, 1]
    return jnp.einsum('bhqk,bkhd->bqhd', a.astype(v.dtype), v)


def diff_attn_prompt(q, k, v, t5_table, lam):
    B, S = q.shape[0], q.shape[1]
    k_pos = jnp.arange(S)

    def block(i):
        q0 = i * Q_BLOCK
        qb = lax.dynamic_slice_in_dim(q, q0, Q_BLOCK, axis=1)
        q_pos = q0 + jnp.arange(Q_BLOCK)
        rel = k_pos[None, :] - q_pos[:, None]
        mask = (k_pos[None, :] // CHUNK) <= (q_pos[:, None] // CHUNK)
        return diff_attend(qb, k, v, t5_bias_of(rel, t5_table), mask, lam)

    o = lax.map(block, jnp.arange(S // Q_BLOCK))
    return jnp.moveaxis(o, 0, 1).reshape(B, S, DA_HEADS, DA_VD)


def diff_attn_sample(q, k_new, v_new, k_cache, v_cache, t5_table, lam):
    B, T = q.shape[0], q.shape[1]
    P = k_cache.shape[1]
    k = jnp.concatenate([k_cache.reshape(B, P, DA_HEADS, 2, DA_HD), k_new], axis=1)
    v = jnp.concatenate([v_cache, v_new], axis=1)
    k_pos = jnp.arange(P + T)
    q_pos = P + jnp.arange(T)
    rel = k_pos[None, :] - q_pos[:, None]
    mask = (k_pos[None, :] // CHUNK) <= (q_pos[:, None] // CHUNK)
    return diff_attend(q, k, v, t5_bias_of(rel, t5_table), mask, lam)


def band_attn_prompt(q, k, v, rel_table):
    B, S = q.shape[0], q.shape[1]
    NC = S // CHUNK
    NB = CB_PREV + 1
    shp = (B, NC, CHUNK, CB_HEADS, CB_HD)
    pad = jnp.zeros((B, CB_PREV, CHUNK, CB_HEADS, CB_HD), k.dtype)
    kp = jnp.concatenate([pad, k.reshape(shp)], axis=1)
    vp = jnp.concatenate([pad, v.reshape(shp)], axis=1)
    idx = jnp.arange(NC)[:, None] + jnp.arange(NB)[None, :]
    kb = kp[:, idx].reshape(B, NC, NB * CHUNK, CB_HEADS, CB_HD)
    vb = vp[:, idx].reshape(B, NC, NB * CHUNK, CB_HEADS, CB_HD)
    kj = jnp.arange(NB * CHUNK)
    qi = jnp.arange(CHUNK)
    bias = band_bias_of(kj[None, :] - (CB_PREV * CHUNK + qi[:, None]), rel_table)
    valid = (jnp.arange(NC)[:, None] + kj[None, :] // CHUNK) >= CB_PREV
    s = jnp.einsum('bnqhd,bnkhd->bnhqk', q.reshape(shp), kb).astype(jnp.float32) * CB_HD ** -0.5 + bias[None, None]
    s = jnp.where(valid[None, :, None, None, :], s, NEG_INF)
    p = jax.nn.softmax(s, axis=-1)
    o = jnp.einsum('bnhqk,bnkhd->bnqhd', p.astype(v.dtype), vb)
    return o.reshape(B, S, CB_HEADS, CB_HD)


def band_attn_sample(q, k_new, v_new, k_buf, v_buf, rel_table, past_len):
    T = q.shape[1]
    R = k_buf.shape[1]
    k = jnp.concatenate([k_buf, k_new], axis=1)
    v = jnp.concatenate([v_buf, v_new], axis=1)
    k_pos = jnp.concatenate([past_len - R + jnp.arange(R), past_len + jnp.arange(T)])
    q_pos = past_len + jnp.arange(T)
    qc = q_pos[:, None] // CHUNK
    kc = k_pos[None, :] // CHUNK
    mask = (kc <= qc) & (kc >= qc - CB_PREV)
    bias = band_bias_of(k_pos[None, :] - q_pos[:, None], rel_table)
    s = jnp.einsum('bqhd,bkhd->bhqk', q, k).astype(jnp.float32) * CB_HD ** -0.5 + bias[None]
    s = jnp.where(mask, s, NEG_INF)
    p = jax.nn.softmax(s, axis=-1)
    o = jnp.einsum('bhqk,bkhd->bqhd', p.astype(v.dtype), v)
    return o, k[:, -R:], v[:, -R:]


def memory_kv(mem, g_mem, w_mem_kv):
    B, M = mem.shape[0], mem.shape[1]
    kv = rmsnorm(mem, g_mem) @ w_mem_kv
    mk, mv = jnp.split(kv, 2, axis=-1)
    return mk.reshape(B, M, X_HEADS, X_HD), mv.reshape(B, M, X_HEADS, X_HD)


def cross_attn(hn, mk, mv, w_q, w_o):
    B, T = hn.shape[0], hn.shape[1]
    q = (hn @ w_q).reshape(B, T, X_HEADS, X_HD)
    s = jnp.einsum('bqhd,bkhd->bhqk', q, mk).astype(jnp.float32) * X_HD ** -0.5
    p = jax.nn.softmax(s, axis=-1)
    o = jnp.einsum('bhqk,bkhd->bqhd', p.astype(mv.dtype), mv).reshape(B, T, X_W)
    return o @ w_o


def front(x, g1, w1g, w1u, w1d, g_mix, w_in, b_gate):
    B, T = x.shape[0], x.shape[1]
    h = x + 0.5 * swiglu(rmsnorm(x, g1), w1g, w1u, w1d)
    z = rmsnorm(h, g_mix) @ w_in
    dq, dk, dv, cq, ck, cv, gz = jnp.split(z, SPLITS, axis=-1)
    gates = jax.nn.sigmoid((gz + b_gate).astype(jnp.float32)).astype(x.dtype)
    return (h,
            dq.reshape(B, T, DA_HEADS, 2, DA_HD), dk.reshape(B, T, DA_HEADS, 2, DA_HD),
            dv.reshape(B, T, DA_HEADS, DA_VD),
            cq.reshape(B, T, CB_HEADS, CB_HD), ck.reshape(B, T, CB_HEADS, CB_HD),
            cv.reshape(B, T, CB_HEADS, CB_HD), gates)


def back(h, o_da, o_cb, gates, mem_k, mem_v, lam_init, da_g, w_br_da, w_br_cb, w_out,
         g_cross, w_cq, w_co, g2, w2g, w2u, w2d):
    B, T = h.shape[0], h.shape[1]
    o_da = rmsnorm(o_da, da_g) * (1.0 - lam_init)
    br_a = o_da.reshape(B, T, DA_HEADS * DA_VD) @ w_br_da
    br_b = o_cb.reshape(B, T, CB_W) @ w_br_cb
    g_a, g_b = jnp.split(gates, 2, axis=-1)
    h = h + (g_a * br_a + g_b * br_b) @ w_out
    h = h + cross_attn(rmsnorm(h, g_cross), mem_k, mem_v, w_cq, w_co)
    h = h + 0.5 * swiglu(rmsnorm(h, g2), w2g, w2u, w2d)
    return h


def setup_inputs(seed: int = 0) -> dict:
    key = jax.random.key(seed)
    ks = iter(jax.random.split(key, 48))
    f32 = jnp.float32

    def nrm(shape, scale=1.0):
        return jax.random.normal(next(ks), shape, f32) * scale

    def gain(shape):
        return 1.0 + nrm(shape, 0.02)

    L, D = DEPTH, D_MODEL
    cb_rows = min(CB_PREV * CHUNK, PAST_LEN)
    return {
        'x_prompt': nrm((BATCH, SEQ, D)),
        'x_sample': nrm((DEC_BATCH, DEC_SEQ, D)),
        'cache_da_k': nrm((L, DEC_BATCH, PAST_LEN, DA_HEADS, 2 * DA_HD)),
        'cache_da_v': nrm((L, DEC_BATCH, PAST_LEN, DA_HEADS, DA_VD)),
        'cache_cb_k': nrm((L, DEC_BATCH, cb_rows, CB_HEADS, CB_HD)),
        'cache_cb_v': nrm((L, DEC_BATCH, cb_rows, CB_HEADS, CB_HD)),
        'cache_mem_k': nrm((L, DEC_BATCH, N_MEM, X_HEADS, X_HD)),
        'cache_mem_v': nrm((L, DEC_BATCH, N_MEM, X_HEADS, X_HD)),
        'mem_prompt': nrm((BATCH, N_MEM, D)),
        't5_bias': nrm((T5_BUCKETS, DA_HEADS), 0.5),
        'g_ffn1': gain((L, D)),
        'w_ffn1_gate': nrm((L, D, D_FF), D ** -0.5),
        'w_ffn1_up': nrm((L, D, D_FF), D ** -0.5),
        'w_ffn1_down': nrm((L, D_FF, D), D_FF ** -0.5),
        'g_mix': gain((L, D)),
        'w_in': nrm((L, D, IN_COLS), D ** -0.5),
        'b_gate': nrm((L, 2 * D), 0.02),
        'da_lambda': nrm((L, 4, DA_HD), 0.1),
        'da_subln_g': gain((L, DA_VD)),
        'cb_rel_bias': nrm((L, 2 * CB_CLIP + 1, CB_HEADS), 0.5),
        'w_br_da': nrm((L, DA_HEADS * DA_VD, D), (DA_HEADS * DA_VD) ** -0.5),
        'w_br_cb': nrm((L, CB_W, D), CB_W ** -0.5),
        'w_out': nrm((L, D, D), D ** -0.5),
        'g_cross': gain((L, D)),
        'g_mem': gain((L, D)),
        'w_mem_kv': nrm((L, D, 2 * X_W), D ** -0.5),
        'w_cross_q': nrm((L, D, X_W), D ** -0.5),
        'w_cross_o': nrm((L, X_W, D), X_W ** -0.5),
        'g_ffn2': gain((L, D)),
        'w_ffn2_gate': nrm((L, D, D_FF), D ** -0.5),
        'w_ffn2_up': nrm((L, D, D_FF), D ** -0.5),
        'w_ffn2_down': nrm((L, D_FF, D), D_FF ** -0.5),
        'g_final': gain((D,)),
    }


def reference(x_prompt, x_sample, cache_da_k, cache_da_v, cache_cb_k, cache_cb_v, cache_mem_k, cache_mem_v,
              mem_prompt, t5_bias, g_ffn1, w_ffn1_gate, w_ffn1_up, w_ffn1_down, g_mix, w_in, b_gate,
              da_lambda, da_subln_g, cb_rel_bias, w_br_da, w_br_cb, w_out, g_cross, g_mem, w_mem_kv,
              w_cross_q, w_cross_o, g_ffn2, w_ffn2_gate, w_ffn2_up, w_ffn2_down, g_final):
    past_len = cache_da_k.shape[2]
    B, S = x_prompt.shape[0], x_prompt.shape[1]
    Bd, T = x_sample.shape[0], x_sample.shape[1]
    rows_p = min(CB_PREV * CHUNK, S)
    hp, hs = x_prompt, x_sample
    dkp, dvp, ckp, cvp, mkp, mvp = [], [], [], [], [], []
    dks, dvs, cks, cvs = [], [], [], []
    for l in range(DEPTH):
        lam_init = 0.8 - 0.6 * math.exp(-0.3 * l)
        lp = da_lambda[l].astype(jnp.float32)
        lam = jnp.exp(jnp.sum(lp[0] * lp[1])) - jnp.exp(jnp.sum(lp[2] * lp[3])) + lam_init
        fr = (g_ffn1[l], w_ffn1_gate[l], w_ffn1_up[l], w_ffn1_down[l], g_mix[l], w_in[l], b_gate[l])
        bk = (da_subln_g[l], w_br_da[l], w_br_cb[l], w_out[l], g_cross[l], w_cross_q[l], w_cross_o[l],
              g_ffn2[l], w_ffn2_gate[l], w_ffn2_up[l], w_ffn2_down[l])
        hp1, dq, dk, dv, cq, ck, cv, gp = front(hp, *fr)
        o_da = diff_attn_prompt(dq, dk, dv, t5_bias, lam)
        o_cb = band_attn_prompt(cq, ck, cv, cb_rel_bias[l])
        mk, mv = memory_kv(mem_prompt, g_mem[l], w_mem_kv[l])
        hp = back(hp1, o_da, o_cb, gp, mk, mv, lam_init, *bk)
        dkp.append(dk.reshape(B, S, DA_HEADS, 2 * DA_HD))
        dvp.append(dv)
        ckp.append(ck[:, S - rows_p:])
        cvp.append(cv[:, S - rows_p:])
        mkp.append(mk)
        mvp.append(mv)
        hs1, sq, sk, sv, tq, tk, tv, gs = front(hs, *fr)
        o_da_s = diff_attn_sample(sq, sk, sv, cache_da_k[l], cache_da_v[l], t5_bias, lam)
        o_cb_s, kbuf, vbuf = band_attn_sample(tq, tk, tv, cache_cb_k[l], cache_cb_v[l], cb_rel_bias[l], past_len)
        hs = back(hs1, o_da_s, o_cb_s, gs, cache_mem_k[l], cache_mem_v[l], lam_init, *bk)
        dks.append(sk.reshape(Bd, T, DA_HEADS, 2 * DA_HD))
        dvs.append(sv)
        cks.append(kbuf)
        cvs.append(vbuf)
    y_prompt = rmsnorm(hp, g_final)
    y_sample = rmsnorm(hs, g_final)
    return (y_prompt, y_sample,
            jnp.stack(dkp), jnp.stack(dvp), jnp.stack(ckp), jnp.stack(cvp), jnp.stack(mkp), jnp.stack(mvp),
            jnp.stack(dks), jnp.stack(dvs), jnp.stack(cks), jnp.stack(cvs))
```

```cpp
#include <hip/hip_runtime.h>
#include <cstdio>
#include <cstdint>
#include <cmath>

constexpr int DM = 2048, SEQ = 16384, NBP = 2, MP = NBP * SEQ, DB = 32, DT = 64, MS = DB * DT, MTOT = MP + MS;
constexpr int PAST = 1024, FF = 5632, NMEM = 256, XW = 512, CBR = 512;
constexpr int KDAS_ROWS = PAST + DT  , KCBS_ROWS = CBR + DT  ;
constexpr float EPS = 1e-6f, LOG2E = 1.4426950408889634f;
constexpr float SC_DA = 0.125f * LOG2E, SC_CB = 0.08838834764831845f * LOG2E;
constexpr float LAM_INIT = 0.2f;

constexpr size_t MiB = 1u << 20;
constexpr size_t WS_CTL = 0, CTL_ZERO_BYTES = 1 * MiB;
constexpr size_t WS_SSQ = 1 * MiB;
constexpr size_t WS_RSTD = 6 * MiB;
constexpr size_t WS_LUT = 6 * MiB + 512 * 1024;
constexpr size_t WS_XM = 7 * MiB;
constexpr size_t WS_MKP = 9 * MiB, WS_MVP = 9 * MiB + 512 * 1024;
constexpr size_t WS_MKS = 10 * MiB, WS_MVS = 18 * MiB;
constexpr size_t WS_W1GU = 26 * MiB, WS_W1D = 70 * MiB, WS_WQKV = 92 * MiB, WS_WG = 116 * MiB, WS_WBR = 132 * MiB, WS_WO = 140 * MiB;
constexpr size_t WS_WMKV = 148 * MiB, WS_WCQ = 152 * MiB, WS_WCO = 154 * MiB, WS_W2GU = 156 * MiB, WS_W2D = 200 * MiB;
constexpr size_t WS_XN = 222 * MiB;
constexpr size_t WS_QX = 358 * MiB;
constexpr size_t WS_STASH = WS_QX;
constexpr size_t WS_R = 392 * MiB;
constexpr size_t WS_A = WS_R;
constexpr size_t WS_QO = WS_R;
constexpr size_t WS_KDAP = 528 * MiB, WS_VDAP = 592 * MiB, WS_KCBP = 656 * MiB, WS_VCBP = 720 * MiB;
constexpr size_t WS_KDAS = 784 * MiB, WS_VDAS = 852 * MiB;
constexpr size_t WS_KCBS = 920 * MiB, WS_VCBS = 956 * MiB;
constexpr size_t WS_GR = 528 * MiB, WS_GB = 664 * MiB;
constexpr size_t WS_MIX = 800 * MiB;
constexpr size_t WS_END = 992 * MiB;
static_assert(WS_A + (size_t)MTOT * FF * 2 <= WS_KDAS, "A1/A2 must not reach the sample K/V buffers");
static_assert(WS_GB + (size_t)MTOT * DM * 2 <= WS_MIX && WS_MIX + (size_t)MTOT * DM * 2 <= WS_END, "ws map");
static_assert(WS_VCBS + (size_t)DB * KCBS_ROWS * 1024 * 2 <= WS_END, "ws map");
static_assert(WS_XN + (size_t)MTOT * DM * 2 <= WS_QX && WS_QX + (size_t)MTOT * XW * 2 <= WS_R, "ws map");

constexpr size_t O_Y = 0, O_DAKP = (size_t)MTOT * DM, O_DAVP = O_DAKP + (size_t)MP * 1024, O_CBKP = O_DAVP + (size_t)MP * 1024, O_CBVP = O_CBKP + (size_t)NBP * CBR * 1024;
constexpr size_t O_MKP = O_CBVP + (size_t)NBP * CBR * 1024, O_MVP = O_MKP + (size_t)NBP * NMEM * XW, O_DAKS = O_MVP + (size_t)NBP * NMEM * XW, O_DAVS = O_DAKS + (size_t)MS * 1024;
constexpr size_t O_CBKS = O_DAVS + (size_t)MS * 1024, O_CBVS = O_CBKS + (size_t)DB * CBR * 1024, O_TOTAL = O_CBVS + (size_t)DB * CBR * 1024;
static_assert(O_TOTAL == 178782208, "output size");

constexpr int CW_TMO = 0, CW_CODE = 1, CW_BAR = 4096;

constexpr int RING_OFF = 0, RING_BYTES = 131072, LDSCTL_OFF = RING_BYTES, MISC_OFF = LDSCTL_OFF + 320, LDS_BYTES = 147456;
constexpr int NWAVES = 8;
namespace pg8 {
#define PG8_LAS __attribute__((address_space(3)))
typedef unsigned short bf16_t;
typedef short bf16x8 __attribute__((ext_vector_type(8)));
typedef float f32x4 __attribute__((ext_vector_type(4)));
typedef unsigned u32x4 __attribute__((ext_vector_type(4)));
constexpr int BM = 256, BK = 64, HALF = 128, HTB = HALF * BK * 2  , STAGE_BYTES = 8 * HTB, NXCD = 8, WGM = 8;

__host__ __device__ __forceinline__ int lds_byte(int r, int c) { const int st = (r >> 4) * 2 + (c >> 5), rr = r & 15, cc = c & 31, ob = rr * 64 + cc * 2; return st * 1024 + (ob ^ (((ob >> 9) & 1) << 5)); }
__host__ __device__ __forceinline__ void stage_rc(int b, int& R, int& C) { const int st = b / 1024, sb = b % 1024, swz = sb ^ (((sb >> 9) & 1) << 5); R = (st >> 1) * 16 + swz / 64; C = (st & 1) * 32 + (swz % 64) / 2; }
__host__ __device__ __forceinline__ int perm32(int rho) { const int n = rho >> 4, i = rho & 15; return 8 * (i >> 2) + 4 * n + (i & 3); }

struct Unit { int pm, pn; };
struct Gemm { const bf16_t* A; const bf16_t* Bt; int M, N, K; };

struct StaticOrder {
    int nM, nN, nwg, G, c;
    __host__ __device__ void init(int M, int N, int G_, int c_) { nM = M / BM; nN = N / BM; nwg = nM * nN; G = G_; c = c_; }
    __host__ __device__ bool next(int i, Unit& u) const {
        const long L = (long)i * G + c; if (L >= nwg) return false;
        int wgid = (int)L; { const int q = nwg / NXCD, r = nwg % NXCD, xcd = wgid % NXCD, off = wgid / NXCD; wgid = (xcd < r ? xcd * (q + 1) : r * (q + 1) + (xcd - r) * q) + off; }
        const int nig = WGM * nN, gid = wgid / nig, fm = gid * WGM, gsz = (nM - fm) < WGM ? (nM - fm) : WGM;
        u.pm = fm + ((wgid % nig) % gsz); u.pn = (wgid % nig) / gsz; return true;
    }
    __device__ __forceinline__ void a_ready(const Unit&) const {}
    __device__ __forceinline__ void done(const Unit&) const {}
};

__device__ __forceinline__ unsigned cvt_pk_bf16(float lo, float hi) { unsigned r; asm volatile("v_cvt_pk_bf16_f32 %0, %1, %2" : "=v"(r) : "v"(lo), "v"(hi)); return r; }
typedef float f32x2 __attribute__((ext_vector_type(2)));
__device__ __forceinline__ float sigm(float x) { return __builtin_amdgcn_rcpf(1.f + __builtin_amdgcn_exp2f(-1.4426950408889634f * x)); }
__device__ __forceinline__ u32x4 pack8(const f32x4 a, const f32x4 b) { u32x4 w; w.x = cvt_pk_bf16(a[0], a[1]); w.y = cvt_pk_bf16(a[2], a[3]); w.z = cvt_pk_bf16(b[0], b[1]); w.w = cvt_pk_bf16(b[2], b[3]); return w; }
__device__ __forceinline__ void unpack8(const u32x4 w, f32x4& a, f32x4& b) {
    a[0] = __uint_as_float(w.x << 16); a[1] = __uint_as_float(w.x & 0xffff0000u); a[2] = __uint_as_float(w.y << 16); a[3] = __uint_as_float(w.y & 0xffff0000u);
    b[0] = __uint_as_float(w.z << 16); b[1] = __uint_as_float(w.z & 0xffff0000u); b[2] = __uint_as_float(w.w << 16); b[3] = __uint_as_float(w.w & 0xffff0000u); }

struct EpiSwiGLU {
    static constexpr bool PERM = true, AFTER_DRAIN = false, MIDK = false;
    bf16_t* O; int ldc; const float* rstd;
    __device__ __forceinline__ void operator()(const f32x4 (&acc)[2][2][4][2], const Unit& u, int wr, int wc, int fr, int fq) const {
        asm volatile("" : "+v"(fr), "+v"(fq));
        const int row0 = u.pm * BM + wr * 64 + fr, col0 = u.pn * HALF + wc * 32 + 8 * fq;
#pragma unroll
        for (int ai = 0; ai < 2; ++ai)
#pragma unroll
            for (int m = 0; m < 4; ++m) {
                const int row = row0 + ai * HALF + m * 16; const float rs = rstd ? rstd[row] : 1.f;
                f32x4 o[2];
#pragma unroll
                for (int n = 0; n < 2; ++n) { const f32x4 g = acc[ai][0][m][n] * rs, up = acc[ai][1][m][n] * rs;
#pragma unroll
                    for (int e = 0; e < 4; ++e) o[n][e] = g[e] * sigm(g[e]) * up[e]; }
                *(u32x4*)(O + (size_t)row * ldc + col0) = pack8(o[0], o[1]);
            }
    }
};

struct EpiResid {
    static constexpr bool PERM = true, AFTER_DRAIN = false, MIDK = false;
    const float* base_p; const float* base_s; float* out; float alpha; const float* gnext; bf16_t* HG; float* ssq;
    __device__ __forceinline__ void operator()(const f32x4 (&acc)[2][2][4][2], const Unit& u, int wr, int wc, int fr, int fq) const {
        asm volatile("" : "+v"(fr), "+v"(fq));
        const int row0 = u.pm * BM + wr * 64 + fr, col0 = u.pn * BM + wc * 32 + 8 * fq;
        const float* base = (u.pm < MP / BM) ? base_p : base_s;
        f32x4 gn[2][2];
#pragma unroll
        for (int bj = 0; bj < 2; ++bj)
#pragma unroll
            for (int n = 0; n < 2; ++n) gn[bj][n] = HG ? *(const f32x4*)(gnext + col0 + bj * HALF + 4 * n) : (f32x4){0.f, 0.f, 0.f, 0.f};
#pragma unroll
        for (int ai = 0; ai < 2; ++ai)
#pragma unroll
            for (int m = 0; m < 4; ++m) {
                const int row = row0 + ai * HALF + m * 16; const size_t off = (size_t)row * DM + col0; float ss = 0.f;
#pragma unroll
                for (int bj = 0; bj < 2; ++bj) { f32x4 v[2];
#pragma unroll
                    for (int n = 0; n < 2; ++n) { const f32x4 b = *(const f32x4*)(base + off + bj * HALF + 4 * n); v[n] = b + acc[ai][bj][m][n] * alpha;
                        ss += (v[n][0] * v[n][0] + v[n][1] * v[n][1]) + (v[n][2] * v[n][2] + v[n][3] * v[n][3]);
                        *(f32x4*)(out + off + bj * HALF + 4 * n) = v[n]; }
                    if (HG) *(u32x4*)(HG + off + bj * HALF) = pack8(v[0] * gn[bj][0], v[1] * gn[bj][1]); }
                ss += __shfl_xor(ss, 16); ss += __shfl_xor(ss, 32);
                if (fq == 0) ssq[(size_t)row * 32 + u.pn * 4 + wc] = ss;
            }
    }
};

struct EpiQKV {
    static constexpr bool PERM = true, AFTER_DRAIN = false, MIDK = false;
    const float* rstd; bf16_t* QO; bf16_t* KVP; bf16_t* KVS_DA; bf16_t* KVS_CB; float* out;
    __device__ __forceinline__ void operator()(const f32x4 (&acc)[2][2][4][2], const Unit& u, int wr, int wc, int fr, int fq) const {
        asm volatile("" : "+v"(fr), "+v"(fq));
        const int reg = u.pn >> 2, cin0 = (u.pn & 3) * BM + wc * 32 + 8 * fq, row0 = u.pm * BM + wr * 64 + fr;
        const bool prompt = u.pm < MP / BM;
        const float sc = reg == 0 ? SC_DA : (reg == 3 ? SC_CB : 1.f);
        const int kv = reg == 1 ? 0 : reg == 2 ? 1 : reg == 4 ? 2 : 3;
        const bool cb = reg >= 4;
#pragma unroll
        for (int ai = 0; ai < 2; ++ai)
#pragma unroll
            for (int m = 0; m < 4; ++m) {
                const int row = row0 + ai * HALF + m * 16; const float rs = rstd[row];
                bf16_t* bd; float* fd = nullptr;
                if (reg == 0) bd = QO + (size_t)row * DM + cin0;
                else if (reg == 3) bd = QO + (size_t)row * DM + 1024 + cin0;
                else if (prompt) {
                    bd = KVP + (size_t)kv * (32u * 1024u * 1024u) + (size_t)row * 1024 + cin0;
                    if (!cb) fd = out + (kv == 0 ? O_DAKP : O_DAVP) + (size_t)row * 1024 + cin0;
                    else { const int t = row & (SEQ - 1), b = row >> 14; if (t >= SEQ - CBR) fd = out + (kv == 2 ? O_CBKP : O_CBVP) + (size_t)(b * CBR + t - (SEQ - CBR)) * 1024 + cin0; }
                } else {
                    const int s = row - MP, b = s >> 6, t = s & 63;
                    if (!cb) { bd = KVS_DA + (size_t)kv * (34u * 1024u * 1024u) + (size_t)(b * KDAS_ROWS + PAST + t) * 1024 + cin0;
                               fd = out + (kv == 0 ? O_DAKS : O_DAVS) + (size_t)s * 1024 + cin0; }
                    else { bd = KVS_CB + (size_t)(kv - 2) * (18u * 1024u * 1024u) + (size_t)(b * KCBS_ROWS + CBR + t) * 1024 + cin0;
                           fd = out + (kv == 2 ? O_CBKS : O_CBVS) + (size_t)(b * CBR + (CBR - DT) + t) * 1024 + cin0; }
                }
#pragma unroll
                for (int bj = 0; bj < 2; ++bj) { const f32x4 v0 = acc[ai][bj][m][0] * rs, v1 = acc[ai][bj][m][1] * rs;
                    *(u32x4*)(bd + bj * HALF) = pack8(v0 * sc, v1 * sc);
                    if (fd) { *(f32x4*)(fd + bj * HALF) = v0; *(f32x4*)(fd + bj * HALF + 4) = v1; } }
            }
    }
};

struct EpiGates {
    static constexpr bool PERM = true, AFTER_DRAIN = false, MIDK = false;
    const float* rstd; const float* bgate; bf16_t* GR; bf16_t* GB;
    __device__ __forceinline__ void operator()(const f32x4 (&acc)[2][2][4][2], const Unit& u, int wr, int wc, int fr, int fq) const {
        asm volatile("" : "+v"(fr), "+v"(fq));
        const int row0 = u.pm * BM + wr * 64 + fr, col0 = u.pn * HALF + wc * 32 + 8 * fq;
        f32x4 ba[2], bb[2];
#pragma unroll
        for (int n = 0; n < 2; ++n) { ba[n] = *(const f32x4*)(bgate + col0 + 4 * n); bb[n] = *(const f32x4*)(bgate + DM + col0 + 4 * n); }
#pragma unroll
        for (int ai = 0; ai < 2; ++ai)
#pragma unroll
            for (int m = 0; m < 4; ++m) {
                const int row = row0 + ai * HALF + m * 16; const float rs = rstd[row];
                f32x4 r[2], g[2];
#pragma unroll
                for (int n = 0; n < 2; ++n) { const f32x4 za = acc[ai][0][m][n] * rs + ba[n], zb = acc[ai][1][m][n] * rs + bb[n];
#pragma unroll
                    for (int e = 0; e < 4; ++e) { const float xa = fminf(fmaxf(za[e], -30.f), 30.f), xb = fminf(fmaxf(zb[e], -30.f), 30.f);
                        const float ea = 1.f + __builtin_amdgcn_exp2f(-1.4426950408889634f * xa), eb = 1.f + __builtin_amdgcn_exp2f(-1.4426950408889634f * xb);
                        g[n][e] = __builtin_amdgcn_rcpf(eb); r[n][e] = eb * __builtin_amdgcn_rcpf(ea); } }
                *(u32x4*)(GR + (size_t)row * DM + col0) = pack8(r[0], r[1]);
                *(u32x4*)(GB + (size_t)row * DM + col0) = pack8(g[0], g[1]);
            }
    }
};

struct EpiMix {
    static constexpr bool PERM = true, AFTER_DRAIN = false, MIDK = true;
    const bf16_t* GR; const bf16_t* GB; bf16_t* MIX;
    __device__ __forceinline__ void midk(f32x4 (&acc)[2][2][4][2], const Unit& u, int wr, int wc, int fr, int fq) const {
        asm volatile("" : "+v"(fr), "+v"(fq));
        const int row0 = u.pm * BM + wr * 64 + fr, col0 = u.pn * BM + wc * 32 + 8 * fq;
#pragma unroll
        for (int ai = 0; ai < 2; ++ai)
#pragma unroll
            for (int m = 0; m < 4; ++m) { const size_t off = (size_t)(row0 + ai * HALF + m * 16) * DM + col0;
#pragma unroll
                for (int bj = 0; bj < 2; ++bj) { f32x4 a, b; unpack8(*(const u32x4*)(GR + off + bj * HALF), a, b); acc[ai][bj][m][0] *= a; acc[ai][bj][m][1] *= b; } }
    }
    __device__ __forceinline__ void operator()(const f32x4 (&acc)[2][2][4][2], const Unit& u, int wr, int wc, int fr, int fq) const {
        asm volatile("" : "+v"(fr), "+v"(fq));
        const int row0 = u.pm * BM + wr * 64 + fr, col0 = u.pn * BM + wc * 32 + 8 * fq;
#pragma unroll
        for (int ai = 0; ai < 2; ++ai)
#pragma unroll
            for (int m = 0; m < 4; ++m) { const size_t off = (size_t)(row0 + ai * HALF + m * 16) * DM + col0;
#pragma unroll
                for (int bj = 0; bj < 2; ++bj) { f32x4 a, b; unpack8(*(const u32x4*)(GB + off + bj * HALF), a, b);
                    *(u32x4*)(MIX + off + bj * HALF) = pack8(acc[ai][bj][m][0] * a, acc[ai][bj][m][1] * b); } }
    }
};

struct EpiScaleBf16 {
    static constexpr bool PERM = true, AFTER_DRAIN = false, MIDK = false;
    const float* rstd; bf16_t* O; int ldc; float sc;
    __device__ __forceinline__ void operator()(const f32x4 (&acc)[2][2][4][2], const Unit& u, int wr, int wc, int fr, int fq) const {
        asm volatile("" : "+v"(fr), "+v"(fq));
        const int row0 = u.pm * BM + wr * 64 + fr, col0 = u.pn * BM + wc * 32 + 8 * fq;
#pragma unroll
        for (int ai = 0; ai < 2; ++ai)
#pragma unroll
            for (int m = 0; m < 4; ++m) { const int row = row0 + ai * HALF + m * 16; const float rs = rstd[row] * sc;
#pragma unroll
                for (int bj = 0; bj < 2; ++bj) *(u32x4*)(O + (size_t)row * ldc + col0 + bj * HALF) = pack8(acc[ai][bj][m][0] * rs, acc[ai][bj][m][1] * rs); }
    }
};

struct EpiMemKV {
    static constexpr bool PERM = true, AFTER_DRAIN = false, MIDK = false;
    bf16_t* MKP; bf16_t* MVP; float* out;
    __device__ __forceinline__ void operator()(const f32x4 (&acc)[2][2][4][2], const Unit& u, int wr, int wc, int fr, int fq) const {
        asm volatile("" : "+v"(fr), "+v"(fq));
        const int row0 = u.pm * BM + wr * 64 + fr, col0 = (u.pn & 1) * BM + wc * 32 + 8 * fq; const bool isv = u.pn >= 2;
        bf16_t* B = isv ? MVP : MKP; float* F = out + (isv ? O_MVP : O_MKP);
#pragma unroll
        for (int ai = 0; ai < 2; ++ai)
#pragma unroll
            for (int m = 0; m < 4; ++m) { const size_t off = (size_t)(row0 + ai * HALF + m * 16) * XW + col0;
#pragma unroll
                for (int bj = 0; bj < 2; ++bj) { *(u32x4*)(B + off + bj * HALF) = pack8(acc[ai][bj][m][0], acc[ai][bj][m][1]);
                    *(f32x4*)(F + off + bj * HALF) = acc[ai][bj][m][0]; *(f32x4*)(F + off + bj * HALF + 4) = acc[ai][bj][m][1]; } }
    }
};
template <class Epi, class Sched, bool ALIGN_EPI = false, bool SP2 = false>
__device__ __forceinline__ void gemm_phase(PG8_LAS unsigned char* lds, const Gemm g, const Sched& S, const Epi& E) {
    int tid_l = threadIdx.x; asm volatile("" : "+v"(tid_l));
    const int tid = tid_l, wid = __builtin_amdgcn_readfirstlane(tid >> 6), lane = tid & 63, wr = wid >> 2, wc = wid & 3, fr = lane & 15, fq = lane >> 4;
    const int K = g.K, nt = K / BK;
    unsigned voffA[2], voffB[2];
#pragma unroll
    for (int i = 0; i < 2; ++i) { int R, C; stage_rc(tid * 16 + i * 8192, R, C); const int Rb = Epi::PERM ? ((R & ~31) + perm32(R & 31)) : R;
        voffA[i] = (unsigned)(R * K + C) * 2u; voffB[i] = (unsigned)(Rb * K + C) * 2u; }
    const size_t kstep = (size_t)(BK * 2);
    const size_t hstep = (size_t)HALF * K * 2;
    const size_t tstep = 2 * hstep;
    const unsigned ldsw = (unsigned)wid * 1024u;
    const int aoff = lds_byte(wr * 64 + fr, fq * 8), boff = lds_byte(wc * 32 + fr, fq * 8);
#define PG8_SA(b, h) (((b) * 2 + (h)) * HTB)
#define PG8_SB(b, h) ((4 + (b) * 2 + (h)) * HTB)
#define PG8_STAGE(bufoff, gbase, voff) do { _Pragma("unroll") for (int _i = 0; _i < 2; ++_i) \
        __builtin_amdgcn_global_load_lds((const unsigned*)((const char*)(gbase) + (voff)[_i]), (PG8_LAS unsigned*)(lds + (bufoff) + ldsw + _i * 8192), 16, 0, 0); } while (0)
#define PG8_LDA(dst, b, h) do { _Pragma("unroll") for (int m = 0; m < 4; ++m) _Pragma("unroll") for (int k = 0; k < 2; ++k) dst[m][k] = *(const PG8_LAS bf16x8*)(lds + PG8_SA(b, h) + aoff + m * 2048 + k * 1024); } while (0)
#define PG8_LDB(dst, b, h) do { _Pragma("unroll") for (int n = 0; n < 2; ++n) _Pragma("unroll") for (int k = 0; k < 2; ++k) dst[n][k] = *(const PG8_LAS bf16x8*)(lds + PG8_SB(b, h) + boff + n * 2048 + k * 1024); } while (0)
#define PG8_MMA(ai, bj, At, Bt) do { __builtin_amdgcn_s_setprio(1); _Pragma("unroll") for (int m = 0; m < 4; ++m) _Pragma("unroll") for (int n = 0; n < 2; ++n) _Pragma("unroll") for (int k = 0; k < 2; ++k) \
        acc[ai][bj][m][n] = __builtin_amdgcn_mfma_f32_16x16x32_bf16(Bt[n][k], At[m][k], acc[ai][bj][m][n], 0, 0, 0); __builtin_amdgcn_s_setprio(0); } while (0)
#define PG8_WAIT_V(n) asm volatile("s_waitcnt vmcnt(" #n ")" ::: "memory")
#define PG8_WAIT_L(n) asm volatile("s_waitcnt lgkmcnt(" #n ")" ::: "memory")
#define PG8_BAR __builtin_amdgcn_s_barrier()
#define PG8_SCHED __builtin_amdgcn_sched_barrier(0)
    Unit cur, nxt; int ui = 0;
    if (!S.next(0, cur)) return;
    f32x4 acc[2][2][4][2];
#pragma unroll
    for (int a = 0; a < 2; ++a)
#pragma unroll
        for (int b = 0; b < 2; ++b)
#pragma unroll
            for (int m = 0; m < 4; ++m)
#pragma unroll
                for (int n = 0; n < 2; ++n) acc[a][b][m][n] = (f32x4){0.f, 0.f, 0.f, 0.f};
    bf16x8 At[4][2], B0[2][2], B1[2][2];
    const char* cA = (const char*)g.A + (size_t)cur.pm * tstep; const char* cB = (const char*)g.Bt + (size_t)cur.pn * tstep;
    S.a_ready(cur);
    if constexpr (SP2) {
        PG8_STAGE(PG8_SB(0, 0), cB, voffB); PG8_STAGE(PG8_SB(0, 1), cB + hstep, voffB); PG8_STAGE(PG8_SA(0, 0), cA, voffA); PG8_STAGE(PG8_SA(0, 1), cA + hstep, voffA);
        if (wr == 1) PG8_BAR;
        PG8_WAIT_V(2); PG8_BAR;
        PG8_STAGE(PG8_SB(1, 0), cB + kstep, voffB); PG8_STAGE(PG8_SA(1, 0), cA + kstep, voffA); PG8_STAGE(PG8_SB(1, 1), cB + hstep + kstep, voffB);
        PG8_WAIT_V(6); PG8_BAR;
    } else {
        PG8_STAGE(PG8_SB(0, 0), cB, voffB); PG8_STAGE(PG8_SA(0, 0), cA, voffA); PG8_STAGE(PG8_SB(0, 1), cB + hstep, voffB); PG8_STAGE(PG8_SA(0, 1), cA + hstep, voffA);
        if (wr == 1) PG8_BAR;
        PG8_WAIT_V(4); PG8_BAR;
        PG8_STAGE(PG8_SB(1, 0), cB + kstep, voffB); PG8_STAGE(PG8_SA(1, 0), cA + kstep, voffA); PG8_STAGE(PG8_SB(1, 1), cB + hstep + kstep, voffB);
        PG8_WAIT_V(6); PG8_BAR;
    }
    for (;;) {
        const bool has_next = S.next(ui + 1, nxt);
        const char* nA = has_next ? (const char*)g.A + (size_t)nxt.pm * tstep : cA; const char* nB = has_next ? (const char*)g.Bt + (size_t)nxt.pn * tstep : cB;
        for (int t = 0; t < nt; t += 2) {
            const bool last = (t == nt - 2);
            const char* a1 = cA + (size_t)(t + 1) * kstep;
            const char* a2 = last ? nA : cA + (size_t)(t + 2) * kstep; const char* b2 = last ? nB : cB + (size_t)(t + 2) * kstep;
            const char* a3 = a2 + kstep; const char* b3 = b2 + kstep;
            if (last && has_next) S.a_ready(nxt);
            if constexpr (Epi::MIDK) { if (t == nt / 2) E.midk(acc, cur, wr, wc, fr, fq); }
            if constexpr (SP2) {
            PG8_LDB(B0, 0, 0); PG8_LDB(B1, 0, 1); PG8_SCHED; PG8_LDA(At, 0, 0); PG8_STAGE(PG8_SA(1, 1), a1 + hstep, voffA);
            PG8_WAIT_V(8); PG8_WAIT_L(0); PG8_BAR; PG8_MMA(0, 0, At, B0); PG8_MMA(0, 1, At, B1); PG8_BAR; PG8_SCHED;
            PG8_LDA(At, 0, 1); PG8_STAGE(PG8_SB(0, 0), b2, voffB); PG8_STAGE(PG8_SB(0, 1), b2 + hstep, voffB); PG8_STAGE(PG8_SA(0, 0), a2, voffA);
            PG8_WAIT_V(8); PG8_WAIT_L(0); PG8_BAR; PG8_MMA(1, 0, At, B0); PG8_MMA(1, 1, At, B1); PG8_BAR; PG8_SCHED;
            PG8_LDB(B0, 1, 0); PG8_LDB(B1, 1, 1); PG8_SCHED; PG8_LDA(At, 1, 0); PG8_STAGE(PG8_SA(0, 1), a2 + hstep, voffA);
            PG8_WAIT_V(8); PG8_WAIT_L(0); PG8_BAR; PG8_MMA(0, 0, At, B0); PG8_MMA(0, 1, At, B1); PG8_BAR; PG8_SCHED;
            PG8_LDA(At, 1, 1); PG8_STAGE(PG8_SB(1, 0), b3, voffB); PG8_STAGE(PG8_SB(1, 1), b3 + hstep, voffB); PG8_STAGE(PG8_SA(1, 0), a3, voffA);
            PG8_WAIT_V(8); PG8_WAIT_L(0); PG8_BAR; PG8_MMA(1, 0, At, B0); PG8_MMA(1, 1, At, B1); PG8_BAR; PG8_SCHED;
            } else {
            PG8_LDB(B0, 0, 0); PG8_SCHED; PG8_LDA(At, 0, 0); PG8_STAGE(PG8_SA(1, 1), a1 + hstep, voffA);
            PG8_WAIT_L(8); PG8_BAR; PG8_WAIT_L(0); PG8_MMA(0, 0, At, B0); PG8_BAR; PG8_SCHED;
            PG8_LDB(B1, 0, 1); PG8_STAGE(PG8_SB(0, 0), b2, voffB);
            PG8_BAR; PG8_WAIT_L(0); PG8_MMA(0, 1, At, B1); PG8_BAR;
            PG8_LDA(At, 0, 1); PG8_STAGE(PG8_SA(0, 0), a2, voffA);
            PG8_BAR; PG8_WAIT_L(0); PG8_MMA(1, 0, At, B0); PG8_BAR; PG8_SCHED;
            PG8_STAGE(PG8_SB(0, 1), b2 + hstep, voffB);
            PG8_WAIT_V(6); PG8_BAR; PG8_MMA(1, 1, At, B1); PG8_BAR;
            PG8_LDB(B0, 1, 0); PG8_SCHED; PG8_LDA(At, 1, 0); PG8_STAGE(PG8_SA(0, 1), a2 + hstep, voffA);
            PG8_WAIT_L(8); PG8_BAR; PG8_WAIT_L(0); PG8_MMA(0, 0, At, B0); PG8_BAR; PG8_SCHED;
            PG8_LDB(B1, 1, 1); PG8_STAGE(PG8_SB(1, 0), b3, voffB);
            PG8_BAR; PG8_WAIT_L(0); PG8_MMA(0, 1, At, B1); PG8_BAR;
            PG8_LDA(At, 1, 1); PG8_STAGE(PG8_SA(1, 0), a3, voffA);
            PG8_BAR; PG8_WAIT_L(0); PG8_MMA(1, 0, At, B0); PG8_BAR; PG8_SCHED;
            PG8_STAGE(PG8_SB(1, 1), b3 + hstep, voffB);
            PG8_WAIT_V(6); PG8_BAR; PG8_MMA(1, 1, At, B1); PG8_BAR;
            }
        }
        if constexpr (ALIGN_EPI) { if (wr == 0) PG8_BAR; }
        if constexpr (!Epi::AFTER_DRAIN) { E(acc, cur, wr, wc, fr, fq); S.done(cur); }
        if (!has_next) break;
#pragma unroll
        for (int a = 0; a < 2; ++a)
#pragma unroll
            for (int b = 0; b < 2; ++b)
#pragma unroll
                for (int m = 0; m < 4; ++m)
#pragma unroll
                    for (int n = 0; n < 2; ++n) acc[a][b][m][n] = (f32x4){0.f, 0.f, 0.f, 0.f};
        cur = nxt; cA = nA; cB = nB; ++ui;
        if constexpr (ALIGN_EPI) { if (wr == 1) PG8_BAR; }
    }
    PG8_WAIT_V(0);
    if constexpr (!ALIGN_EPI) { if (wr == 0) PG8_BAR; }
    PG8_BAR;
    if constexpr (Epi::AFTER_DRAIN) { E.fused(acc, cur, wr, wc, fr, fq, lds, wid, lane); S.done(cur); }
#undef PG8_SA
#undef PG8_SB
#undef PG8_STAGE
#undef PG8_LDA
#undef PG8_LDB
#undef PG8_MMA
#undef PG8_WAIT_V
#undef PG8_WAIT_L
#undef PG8_BAR
#undef PG8_SCHED
}
}

namespace att {
typedef unsigned short bf16;
using bf16x8 = __attribute__((ext_vector_type(8))) short;
using s16x4  = __attribute__((ext_vector_type(4))) short;
using f32x16 = __attribute__((ext_vector_type(16))) float;
using u32x4  = __attribute__((ext_vector_type(4))) unsigned;
constexpr int NW = 8, QBLK = 32, KVBLK = 64, DV = 128;
constexpr float THR = 8.f;
constexpr int LDS_V = 0, LDS_K = 32768, LDS_WS = 65536, LDS_LUT = 65536 + 2048, LDS_ATT_BYTES = LDS_LUT + 320 * 4;
#define ATT_SBAR() __builtin_amdgcn_sched_barrier(0)
__device__ __forceinline__ int crow(int r, int hi) { return (r & 3) + 8 * (r >> 2) + 4 * hi; }
__device__ __forceinline__ unsigned cvtpk(float lo, float hi) { unsigned r; asm volatile("v_cvt_pk_bf16_f32 %0, %1, %2" : "=v"(r) : "v"(lo), "v"(hi)); return r; }
template <int DQK> __device__ __forceinline__ int kswz(int row, int colB) { return row * (DQK * 2) + (colB ^ ((row & 7) << 4)); }

__device__ __forceinline__ int v_st(int k, int c) { const int kk = (k & ~0xC) | ((k & 4) << 1) | ((k & 8) >> 1); return ((kk >> 3) * 4 + (c >> 5)) * 512 + ((kk & 7) * 32 + (c & 31)) * 2; }
__device__ __forceinline__ int v_rd_base(int lane) { return ((lane & 3) << 3) | (((lane >> 2) & 3) << 6) | (((lane >> 4) & 1) << 5) | (((lane >> 5) & 1) << 8); }
constexpr int v_rd_off(int d0, int ks, int half) { return d0 * 512 + ks * 4096 + half * 2048; }
template <int OFF> __device__ __forceinline__ s16x4 tr_read(int vb) { s16x4 r; asm volatile("ds_read_b64_tr_b16 %0, %1 offset:%2" : "=&v"(r) : "v"(vb), "i"(OFF) : "memory"); return r; }
template <int D0> __device__ __forceinline__ void pv_one(f32x16& od, int vb, bf16x8 pa0, bf16x8 pa1, bf16x8 pa2, bf16x8 pa3) {
  const s16x4 l0 = tr_read<v_rd_off(D0, 0, 0)>(vb), h0 = tr_read<v_rd_off(D0, 0, 1)>(vb), l1 = tr_read<v_rd_off(D0, 1, 0)>(vb), h1 = tr_read<v_rd_off(D0, 1, 1)>(vb);
  const s16x4 l2 = tr_read<v_rd_off(D0, 2, 0)>(vb), h2 = tr_read<v_rd_off(D0, 2, 1)>(vb), l3 = tr_read<v_rd_off(D0, 3, 0)>(vb), h3 = tr_read<v_rd_off(D0, 3, 1)>(vb);
  asm volatile("s_waitcnt lgkmcnt(0)" ::: "memory"); ATT_SBAR();
#define ATT_PK(L, H) (bf16x8){L[0], L[1], L[2], L[3], H[0], H[1], H[2], H[3]}
  od = __builtin_amdgcn_mfma_f32_32x32x16_bf16(pa0, ATT_PK(l0, h0), od, 0, 0, 0);
  od = __builtin_amdgcn_mfma_f32_32x32x16_bf16(pa1, ATT_PK(l1, h1), od, 0, 0, 0);
  od = __builtin_amdgcn_mfma_f32_32x32x16_bf16(pa2, ATT_PK(l2, h2), od, 0, 0, 0);
  od = __builtin_amdgcn_mfma_f32_32x32x16_bf16(pa3, ATT_PK(l3, h3), od, 0, 0, 0);
#undef ATT_PK
}
__device__ __forceinline__ void pv_all(f32x16* o, int vb, bf16x8 pa0, bf16x8 pa1, bf16x8 pa2, bf16x8 pa3) {
  pv_one<0>(o[0], vb, pa0, pa1, pa2, pa3); pv_one<1>(o[1], vb, pa0, pa1, pa2, pa3); pv_one<2>(o[2], vb, pa0, pa1, pa2, pa3); pv_one<3>(o[3], vb, pa0, pa1, pa2, pa3);
}
template <int DQK> __device__ __forceinline__ void qkt(f32x16& p0, f32x16& p1, const char* Ks, const bf16x8* qr, int r32, int hi) {
  p0 = f32x16{}; p1 = f32x16{};
#pragma unroll
  for (int d0 = 0; d0 < DQK / 16; ++d0) { const int cb = (d0 * 16 + hi * 8) * 2;
    const bf16x8 b0 = *reinterpret_cast<const bf16x8*>(Ks + kswz<DQK>(r32, cb));
    const bf16x8 b1 = *reinterpret_cast<const bf16x8*>(Ks + kswz<DQK>(32 + r32, cb));
    p0 = __builtin_amdgcn_mfma_f32_32x32x16_bf16(b0, qr[d0], p0, 0, 0, 0);
    p1 = __builtin_amdgcn_mfma_f32_32x32x16_bf16(b1, qr[d0], p1, 0, 0, 0); }
}
template <bool BIAS> __device__ __forceinline__ void bias_mask(f32x16& p0, f32x16& p1, bool valid, bool far, float cfar, const float* lut, int relb, int hi) {
  if (!valid) {
#pragma unroll
    for (int r = 0; r < 16; ++r) { p0[r] = -INFINITY; p1[r] = -INFINITY; }
  } else if (BIAS) {
    if (far) {
#pragma unroll
      for (int r = 0; r < 16; ++r) { p0[r] += cfar; p1[r] += cfar; }
    } else {
      int rb = relb + 4 * hi; asm volatile("" : "+v"(rb));
#pragma unroll
      for (int r = 0; r < 16; ++r) { const int i0 = rb + (r & 3) + 8 * (r >> 2);
        p0[r] += lut[min(max(i0, 0), 319)]; p1[r] += lut[min(max(i0 + 32, 0), 319)];
        if ((r & 3) == 3) asm volatile("" ::: "memory"); }
    }
  }
}
__device__ __forceinline__ void partialSM(f32x16& p0, f32x16& p1, float& m_reg, float& alpha) {
  float pmax = p0[0];
#pragma unroll
  for (int r = 1; r < 16; ++r) pmax = fmaxf(pmax, p0[r]);
#pragma unroll
  for (int r = 0; r < 16; ++r) pmax = fmaxf(pmax, p1[r]);
  { auto rr = __builtin_amdgcn_permlane32_swap(__float_as_uint(pmax), __float_as_uint(pmax), false, false);
    pmax = fmaxf(__uint_as_float(rr[0]), __uint_as_float(rr[1])); }
  float mn;
  if (__builtin_expect(__all(pmax - m_reg <= THR), 1)) { mn = m_reg; alpha = 1.f; }
  else { mn = fmaxf(m_reg, pmax); alpha = __builtin_amdgcn_exp2f(m_reg - mn); m_reg = mn; }
#pragma unroll
  for (int r = 0; r < 16; ++r) { p0[r] -= mn; p1[r] -= mn; }
#pragma unroll
  for (int r = 0; r < 16; ++r) p0[r] = __builtin_amdgcn_exp2f(p0[r]);
}
__device__ __forceinline__ void finishSM(f32x16& p0, f32x16& p1, float alpha, float& l_reg, bf16x8& pa0, bf16x8& pa1, bf16x8& pa2, bf16x8& pa3) {
#pragma unroll
  for (int r = 0; r < 16; ++r) p1[r] = __builtin_amdgcn_exp2f(p1[r]);
  float ps = 0;
#pragma unroll
  for (int r = 0; r < 16; ++r) ps += p0[r];
#pragma unroll
  for (int r = 0; r < 16; ++r) ps += p1[r];
  { auto rr = __builtin_amdgcn_permlane32_swap(__float_as_uint(ps), __float_as_uint(ps), false, false);
    ps = __uint_as_float(rr[0]) + __uint_as_float(rr[1]); }
  l_reg = l_reg * alpha + ps;
#define ATT_PK4(P, BASE, OUT) do { unsigned a0 = cvtpk(P[BASE + 0], P[BASE + 1]), a1 = cvtpk(P[BASE + 2], P[BASE + 3]);   \
    unsigned b0 = cvtpk(P[BASE + 4], P[BASE + 5]), b1 = cvtpk(P[BASE + 6], P[BASE + 7]);                              \
    auto r0 = __builtin_amdgcn_permlane32_swap(a0, b0, false, false); auto r1 = __builtin_amdgcn_permlane32_swap(a1, b1, false, false); \
    u32x4 w = {r0[0], r1[0], r0[1], r1[1]}; OUT = *reinterpret_cast<bf16x8*>(&w); } while (0)
  ATT_PK4(p0, 0, pa0); ATT_PK4(p0, 8, pa1); ATT_PK4(p1, 0, pa2); ATT_PK4(p1, 8, pa3);
#undef ATT_PK4
}

struct TileArgs {
  const bf16* Qw; int ldq;
  const bf16* Kh; int ldk;
  const bf16* Vh; int ldv;
  int t0, NT, tmax;
  int wlo, whi;
  int relw;
};

template <int DQK, bool BIAS, int SD>
__device__ __forceinline__ void attn_tiles(const TileArgs& A, const float* lut, char* lds, f32x16 (&o)[4], float& l_out) {
  int tid_l = threadIdx.x; asm volatile("" : "+v"(tid_l));
  const int tid = tid_l, wid = tid >> 6, lane = tid & 63, r32 = lane & 31, hi = lane >> 5;
  char* V_lds = lds + LDS_V; char* K_lds = lds + LDS_K;
  constexpr int SHM_V = KVBLK * DV * 2, SHM_K = KVBLK * DQK * 2;
  float* ws = (float*)(lds + LDS_WS) + wid * 64; float* al_l = ws + 32;
  float m_reg = -1e30f, l_reg = 0.f; o[0] = f32x16{}; o[1] = f32x16{}; o[2] = f32x16{}; o[3] = f32x16{};
  bf16x8 qr[DQK / 16];
  { const bf16* Qp = A.Qw + (long)r32 * A.ldq + hi * 8;
#pragma unroll
    for (int d0 = 0; d0 < DQK / 16; ++d0) qr[d0] = *reinterpret_cast<const bf16x8*>(Qp + d0 * 16); }
  const int sr = tid >> 4, sc = (tid & 15) * 8, vst0 = v_st(sr, sc), vst1 = v_st(32 + sr, sc);
  const int kr = (DQK == 128) ? sr : (tid >> 3), kc = (DQK == 128) ? sc : (tid & 7) * 8;
  const int vb0 = (int)(uintptr_t)V_lds + v_rd_base(lane);
  const float cfar = BIAS ? lut[0] : 0.f;
  bf16x8 svs0[SD], svs1[SD], sks0[SD], sks1[SD];
  const int ldk = A.ldk, ldv = A.ldv; const bf16* Kh = A.Kh; const bf16* Vh = A.Vh; const int t0 = A.t0, tmax = A.tmax;
#define ATT_SLOAD(i, j) do { const int tl_ = min(t0 + (j), tmax); const long k0_ = (long)tl_ * KVBLK;                         \
    svs0[i] = *reinterpret_cast<const bf16x8*>(Vh + (k0_ + sr) * ldv + sc); svs1[i] = *reinterpret_cast<const bf16x8*>(Vh + (k0_ + 32 + sr) * ldv + sc); \
    sks0[i] = *reinterpret_cast<const bf16x8*>(Kh + (k0_ + kr) * ldk + kc);                                                   \
    if (DQK == 128) sks1[i] = *reinterpret_cast<const bf16x8*>(Kh + (k0_ + 32 + kr) * ldk + kc); } while (0)
#define ATT_SWRITE(b, i) do { *(bf16x8*)(V_lds + (b) * SHM_V + vst0) = svs0[i]; *(bf16x8*)(V_lds + (b) * SHM_V + vst1) = svs1[i]; \
    *(bf16x8*)(K_lds + (b) * SHM_K + kswz<DQK>(kr, kc * 2)) = sks0[i];                                                        \
    if (DQK == 128) *(bf16x8*)(K_lds + (b) * SHM_K + kswz<DQK>(32 + kr, kc * 2)) = sks1[i]; } while (0)
#define ATT_RESC(a) do { if (__any((a) < 1.f)) { if (hi == 0) al_l[r32] = (a); asm volatile("s_waitcnt lgkmcnt(0)" ::: "memory"); \
    _Pragma("unroll") for (int d = 0; d < 4; ++d) _Pragma("unroll") for (int r = 0; r < 16; ++r) o[d][r] *= al_l[crow(r, hi)]; } } while (0)
#define ATT_BM(P0, P1, j) do { const int t_ = t0 + (j); const bool valid_ = (t_ >= A.wlo) && (t_ <= A.whi); const int rk_ = A.relw + t_ * KVBLK;   \
    bias_mask<BIAS>(P0, P1, valid_, (rk_ + 63 <= -128), cfar, lut, rk_ - r32 + 256, hi); } while (0)
  f32x16 pA0, pA1, pB0, pB1; float alA, alB; bf16x8 pa0, pa1, pa2, pa3; const int NT = A.NT;
  constexpr int SE = 0, SO = SD - 1;
  ATT_SLOAD(SE, 0); ATT_SWRITE(0, SE); __syncthreads();
  qkt<DQK>(pA0, pA1, K_lds, qr, r32, hi); ATT_BM(pA0, pA1, 0); partialSM(pA0, pA1, m_reg, alA);
  ATT_SLOAD(SO, 1); if constexpr (SD == 2) { if (2 < NT) ATT_SLOAD(SE, 2); }
  ATT_SWRITE(1, SO); __syncthreads();
  for (int j = 1; j + 1 < NT; j += 2) {
    ATT_SBAR(); qkt<DQK>(pB0, pB1, K_lds + SHM_K, qr, r32, hi); ATT_BM(pB0, pB1, j);
    finishSM(pA0, pA1, alA, l_reg, pa0, pa1, pa2, pa3); ATT_SBAR();
    ATT_SLOAD(SO, j + SD); ATT_SBAR();
    pv_all(o, vb0, pa0, pa1, pa2, pa3); partialSM(pB0, pB1, m_reg, alB);
    __syncthreads(); ATT_SWRITE(0, SE);
    ATT_RESC(alB); __syncthreads();
    ATT_SBAR(); qkt<DQK>(pA0, pA1, K_lds, qr, r32, hi); ATT_BM(pA0, pA1, j + 1);
    finishSM(pB0, pB1, alB, l_reg, pa0, pa1, pa2, pa3); ATT_SBAR();
    if (SD == 1 || j + 3 < NT) ATT_SLOAD(SE, j + 1 + SD); ATT_SBAR();
    pv_all(o, vb0 + SHM_V, pa0, pa1, pa2, pa3); partialSM(pA0, pA1, m_reg, alA);
    __syncthreads(); ATT_SWRITE(1, SO);
    ATT_RESC(alA); __syncthreads();
  }
  ATT_SBAR(); qkt<DQK>(pB0, pB1, K_lds + SHM_K, qr, r32, hi); ATT_BM(pB0, pB1, NT - 1);
  finishSM(pA0, pA1, alA, l_reg, pa0, pa1, pa2, pa3); ATT_SBAR();
  pv_all(o, vb0, pa0, pa1, pa2, pa3); partialSM(pB0, pB1, m_reg, alB);
  __syncthreads(); ATT_RESC(alB);
  finishSM(pB0, pB1, alB, l_reg, pa0, pa1, pa2, pa3); ATT_SBAR();
  pv_all(o, vb0 + SHM_V, pa0, pa1, pa2, pa3);
  l_out = l_reg;
#undef ATT_SLOAD
#undef ATT_SWRITE
#undef ATT_RESC
#undef ATT_BM
}
__device__ __forceinline__ void attn_normalize(f32x16 (&o)[4], float l_reg, char* lds) {
  int tid_l = threadIdx.x; asm volatile("" : "+v"(tid_l));
  const int tid = tid_l, wid = tid >> 6, lane = tid & 63, r32 = lane & 31, hi = lane >> 5;
  float* li_l = (float*)(lds + LDS_WS) + wid * 64;
  if (hi == 0) li_l[r32] = l_reg; asm volatile("s_waitcnt lgkmcnt(0)" ::: "memory");
#pragma unroll
  for (int r = 0; r < 16; ++r) { const float rl = __builtin_amdgcn_rcpf(li_l[crow(r, hi)]);
#pragma unroll
    for (int d = 0; d < 4; ++d) o[d][r] *= rl; }
  asm volatile("s_waitcnt lgkmcnt(0)" ::: "memory");
}
#undef ATT_SBAR
}
#define GAS __attribute__((address_space(1)))
#define LAS __attribute__((address_space(3)))
typedef unsigned short bf16;
typedef unsigned v4u __attribute__((ext_vector_type(4)));
typedef float f32x4 __attribute__((ext_vector_type(4)));
typedef short bf16x8 __attribute__((ext_vector_type(8)));
typedef GAS unsigned gu32;
typedef GAS unsigned long long gu64;
#define RLX_AGENT __ATOMIC_RELAXED, __HIP_MEMORY_SCOPE_AGENT
#define LDS_WAIT() asm volatile("s_waitcnt lgkmcnt(0)" ::: "memory")
#define VM_WAIT() asm volatile("s_waitcnt vmcnt(0)" ::: "memory")
__device__ __forceinline__ unsigned long long rt() { return __builtin_amdgcn_s_memrealtime(); }
__device__ __forceinline__ unsigned f2bf(float f) { unsigned u = __builtin_bit_cast(unsigned, f); return (u + 0x7fffu + ((u >> 16) & 1u)) >> 16; }
__device__ __forceinline__ unsigned pk2(float lo, float hi) { return f2bf(lo) | (f2bf(hi) << 16); }

#define XB_TMO      128
#define XB_XCNT(j)  (256  + 64 * (j))
#define XB_XSUB(j)  (1280 + 64 * (j))
#define XB_XGEN(j)  (2304 + 64 * (j))
#define XB_TOP      3328
#define XB_TOPGEN   3392
#define XCD_BAR_WORDS 3456
#define XB_SPIN_CAP (1u << 18)

__device__ __forceinline__ unsigned xb_ld(unsigned* p)              { return __hip_atomic_load(p, __ATOMIC_RELAXED, __HIP_MEMORY_SCOPE_AGENT); }
__device__ __forceinline__ unsigned xb_add(unsigned* p, unsigned v) { return __hip_atomic_fetch_add(p, v, __ATOMIC_RELAXED, __HIP_MEMORY_SCOPE_AGENT); }
__device__ __forceinline__ unsigned xb_xcc_id() { return (unsigned)__builtin_amdgcn_s_getreg((3 << 11) | 20) & 0xFu; }
#define XB_SPIN(cond, bar) do { unsigned _sp = 0; while (cond) { __builtin_amdgcn_s_sleep(1); \
    if ((++_sp & 255u) == 0u) { if (xb_ld(&(bar)[XB_TMO])) break; if (_sp > XB_SPIN_CAP) { atomicAdd(&(bar)[XB_TMO], 1u); break; } } } } while (0)

struct XcdBarrier {
    unsigned* bar; unsigned x;
    volatile LAS unsigned* st;
};

__device__ __forceinline__ XcdBarrier xcd_barrier_post(unsigned* bar, volatile LAS unsigned* st) {
    XcdBarrier b; b.bar = bar; b.x = xb_xcc_id(); b.st = st;
    if (threadIdx.x == 0) (void)xb_add(&bar[XB_XCNT(b.x)], 1u);
    return b;
}
__device__ __forceinline__ void xcd_barrier_complete(unsigned* bar, unsigned x, unsigned& nloc, unsigned& nx) {
    const unsigned G = gridDim.x * gridDim.y * gridDim.z;
    unsigned sum, cnt, mine, sp = 0u;
    for (;;) {
        sum = 0u; cnt = 0u; mine = 0u;
#pragma unroll
        for (unsigned j = 0; j < 16; ++j) { const unsigned c = xb_ld(&bar[XB_XCNT(j)]); sum += c; cnt += (c > 0u) ? 1u : 0u; mine = (j == x) ? c : mine; }
        if (sum == G) break;
        __builtin_amdgcn_s_sleep(1);
        if ((++sp & 255u) == 0u) { if (xb_ld(&bar[XB_TMO])) break; if (sp > XB_SPIN_CAP) { atomicAdd(&bar[XB_TMO], 1u); break; } }
    }
    nloc = mine > 0u ? mine : 1u; nx = cnt > 0u ? cnt : 1u;
}

__device__ __forceinline__ void xcd_barrier(const XcdBarrier& b) {
    asm volatile("s_waitcnt vmcnt(0)" ::: "memory");
    __syncthreads();
    if (threadIdx.x == 0) {
        unsigned* bar = b.bar;
        __builtin_amdgcn_s_waitcnt(0);
        unsigned nloc = b.st[0], nx = b.st[1];
        if (nloc == 0u) { xcd_barrier_complete(bar, b.x, nloc, nx); b.st[0] = nloc; b.st[1] = nx; }
        const unsigned old = xb_add(&bar[XB_XSUB(b.x)], 1u);
        const unsigned gen = old / nloc;
        if (old + 1u == (gen + 1u) * nloc) {
            __builtin_amdgcn_fence(__ATOMIC_RELEASE, "agent");
            asm volatile("s_waitcnt vmcnt(0)" ::: "memory");
            const unsigned og = xb_add(&bar[XB_TOP], 1u);
            const unsigned tg = og / nx;
            if (og + 1u == (tg + 1u) * nx) xb_add(&bar[XB_TOPGEN], 1u);
            else XB_SPIN(xb_ld(&bar[XB_TOPGEN]) == tg, bar);
            __builtin_amdgcn_fence(__ATOMIC_ACQUIRE, "agent");
            xb_add(&bar[XB_XGEN(b.x)], 1u);
            asm volatile("s_waitcnt vmcnt(0)" ::: "memory");
        } else {
            XB_SPIN(xb_ld(&bar[XB_XGEN(b.x)]) == gen, bar);
            __builtin_amdgcn_fence(__ATOMIC_ACQUIRE, "agent");
            asm volatile("s_waitcnt vmcnt(0)" ::: "memory");
        }
    }
    __syncthreads();
}
struct Args { const float* in[33]; float* out; unsigned char* ws; int ph_lo, ph_hi, li, pad; };
constexpr int N_PHASES = 17;
#ifndef MK_N_LAUNCHES
#define MK_N_LAUNCHES 1
#endif
constexpr int N_LAUNCHES = MK_N_LAUNCHES;

enum InIdx { I_XP = 0, I_XS, I_CDAK, I_CDAV, I_CCBK, I_CCBV, I_CMK, I_CMV, I_MEMP, I_T5, I_G1, I_W1G, I_W1U, I_W1D, I_GMIX, I_WIN, I_BGATE, I_LAMBDA, I_DAG, I_CBREL,
             I_WBRDA, I_WBRCB, I_WOUT, I_GCROSS, I_GMEM, I_WMKV, I_WCQ, I_WCO, I_G2, I_W2G, I_W2U, I_W2D, I_GFINAL };

__device__ __forceinline__ float wave_sum(float v) {
#pragma unroll
    for (int o = 1; o < 64; o <<= 1) v += __shfl_xor(v, o);
    return v;
}
__device__ __forceinline__ void tr_item(const float* W, int ldw, int N, bf16* WT, int pitch, int koff, int il, int half, LAS float* scr, int item, int lane) {
    const int nblk = N / 32, kb = item / nblk, nb = item % nblk, k0 = 64 * kb, n0 = 32 * nb;
#pragma unroll 8
    for (int i = 0; i < 32; ++i) { const int kk = 2 * i + (lane >> 5); scr[kk * 33 + (lane & 31)] = W[(size_t)(k0 + kk) * ldw + n0 + (lane & 31)]; }
    LDS_WAIT(); asm volatile("" ::: "memory");
    const int c = lane & 7;
#pragma unroll
    for (int j = 0; j < 4; ++j) { const int n = (lane >> 3) + 8 * j; const LAS float* s = scr + (8 * c) * 33 + n;
        v4u o; o.x = pk2(s[0 * 33], s[1 * 33]); o.y = pk2(s[2 * 33], s[3 * 33]); o.z = pk2(s[4 * 33], s[5 * 33]); o.w = pk2(s[6 * 33], s[7 * 33]);
        const int nn = n0 + n, drow = il ? ((nn >> 7) * 256 + half * 128 + (nn & 127)) : nn;
        *(GAS v4u*)(WT + (size_t)drow * pitch + koff + k0 + 8 * c) = o; }
    LDS_WAIT(); asm volatile("" ::: "memory");
}
__device__ __forceinline__ void rms_row_to_bf16(const float* xrow, const float* g, bf16* orow, int lane) {
    const GAS f32x4* xr = (const GAS f32x4*)xrow + lane; const GAS f32x4* gr = (const GAS f32x4*)g + lane;
    f32x4 v[8]; float s = 0.f;
#pragma unroll
    for (int j = 0; j < 8; ++j) { v[j] = xr[64 * j]; s += (v[j].x * v[j].x + v[j].y * v[j].y) + (v[j].z * v[j].z + v[j].w * v[j].w); }
    const float rs = 1.f / sqrtf(wave_sum(s) * (1.f / DM) + EPS);
    GAS unsigned long long* o8 = (GAS unsigned long long*)orow + lane;
#pragma unroll
    for (int j = 0; j < 8; ++j) { const f32x4 gg = gr[64 * j];
        o8[64 * j] = (unsigned long long)pk2(v[j].x * rs * gg.x, v[j].y * rs * gg.y) | ((unsigned long long)pk2(v[j].z * rs * gg.z, v[j].w * rs * gg.w) << 32); }
}
__device__ __forceinline__ void cvt_row1024(const float* src, bf16* dst, float* fcopy, int lane) {
    const GAS f32x4* s = (const GAS f32x4*)src + lane; GAS unsigned long long* d = (GAS unsigned long long*)dst + lane;
#pragma unroll
    for (int j = 0; j < 4; ++j) { const f32x4 v = s[64 * j]; d[64 * j] = (unsigned long long)pk2(v.x, v.y) | ((unsigned long long)pk2(v.z, v.w) << 32);
        if (fcopy) ((GAS f32x4*)fcopy)[lane + 64 * j] = v; }
}
__device__ __forceinline__ int t5_bucket(int rel) {
    const int base = rel > 0 ? 16 : 0, n = rel < 0 ? -rel : rel;
    if (n < 8) return base + n;
    const float nf = (float)n;
    int large = 8 + (int)(logf(nf / 8.f) / 2.772588722239781f * 8.f);
    large = large < 15 ? large : 15;
    return base + large;
}

struct Frame {
    LAS unsigned char* lds; volatile LAS unsigned* MISC; gu32* ctl;
    int tid, lane, wave, vcu, G;
};

__device__ __forceinline__ void p0_prologue(Frame& F, const Args& a) {
    LAS float* scr = (LAS float*)(F.lds + RING_OFF + F.wave * 16384);
    const int gw = F.vcu * NWAVES + F.wave, NGW = F.G * NWAVES;
    unsigned char* ws = a.ws;
    constexpr int I_FFN = 32 * 176, I_FFD = 88 * 64, I_QKV = 32 * 192, I_G = 32 * 64, I_BR = 16 * 64, I_O = 32 * 64, I_MKV = 32 * 32, I_CQ = 32 * 16, I_CO = 8 * 64;
    constexpr int NITEMS = 6 * I_FFN + I_QKV + 2 * I_G + 2 * I_BR + I_O + I_MKV + I_CQ + I_CO;
    static_assert(I_FFN == I_FFD, "items");
    for (int it = gw; it < NITEMS; it += NGW) {
        int r = it;
        if (r < I_FFN) { tr_item(a.in[I_W1G], FF, FF, (bf16*)(ws + WS_W1GU), DM, 0, 1, 0, scr, r, F.lane); continue; } r -= I_FFN;
        if (r < I_FFN) { tr_item(a.in[I_W1U], FF, FF, (bf16*)(ws + WS_W1GU), DM, 0, 1, 1, scr, r, F.lane); continue; } r -= I_FFN;
        if (r < I_FFD) { tr_item(a.in[I_W1D], DM, DM, (bf16*)(ws + WS_W1D), FF, 0, 0, 0, scr, r, F.lane); continue; } r -= I_FFD;
        if (r < I_FFN) { tr_item(a.in[I_W2G], FF, FF, (bf16*)(ws + WS_W2GU), DM, 0, 1, 0, scr, r, F.lane); continue; } r -= I_FFN;
        if (r < I_FFN) { tr_item(a.in[I_W2U], FF, FF, (bf16*)(ws + WS_W2GU), DM, 0, 1, 1, scr, r, F.lane); continue; } r -= I_FFN;
        if (r < I_FFD) { tr_item(a.in[I_W2D], DM, DM, (bf16*)(ws + WS_W2D), FF, 0, 0, 0, scr, r, F.lane); continue; } r -= I_FFD;
        if (r < I_QKV) { tr_item(a.in[I_WIN], 10240, 6144, (bf16*)(ws + WS_WQKV), DM, 0, 0, 0, scr, r, F.lane); continue; } r -= I_QKV;
        if (r < I_G) { tr_item(a.in[I_WIN] + 6144, 10240, 2048, (bf16*)(ws + WS_WG), DM, 0, 1, 0, scr, r, F.lane); continue; } r -= I_G;
        if (r < I_G) { tr_item(a.in[I_WIN] + 8192, 10240, 2048, (bf16*)(ws + WS_WG), DM, 0, 1, 1, scr, r, F.lane); continue; } r -= I_G;
        if (r < I_BR) { tr_item(a.in[I_WBRDA], DM, DM, (bf16*)(ws + WS_WBR), DM, 0, 0, 0, scr, r, F.lane); continue; } r -= I_BR;
        if (r < I_BR) { tr_item(a.in[I_WBRCB], DM, DM, (bf16*)(ws + WS_WBR), DM, 1024, 0, 0, scr, r, F.lane); continue; } r -= I_BR;
        if (r < I_O) { tr_item(a.in[I_WOUT], DM, DM, (bf16*)(ws + WS_WO), DM, 0, 0, 0, scr, r, F.lane); continue; } r -= I_O;
        if (r < I_MKV) { tr_item(a.in[I_WMKV], 1024, 1024, (bf16*)(ws + WS_WMKV), DM, 0, 0, 0, scr, r, F.lane); continue; } r -= I_MKV;
        if (r < I_CQ) { tr_item(a.in[I_WCQ], XW, XW, (bf16*)(ws + WS_WCQ), DM, 0, 0, 0, scr, r, F.lane); continue; } r -= I_CQ;
        tr_item(a.in[I_WCO], DM, DM, (bf16*)(ws + WS_WCO), XW, 0, 0, 0, scr, r, F.lane);
    }
    for (int m = gw; m < MTOT + NBP * NMEM; m += NGW) {
        if (m < MP) rms_row_to_bf16(a.in[I_XP] + (size_t)m * DM, a.in[I_G1], (bf16*)(ws + WS_XN) + (size_t)m * DM, F.lane);
        else if (m < MTOT) rms_row_to_bf16(a.in[I_XS] + (size_t)(m - MP) * DM, a.in[I_G1], (bf16*)(ws + WS_XN) + (size_t)m * DM, F.lane);
        else rms_row_to_bf16(a.in[I_MEMP] + (size_t)(m - MTOT) * DM, a.in[I_GMEM], (bf16*)(ws + WS_XM) + (size_t)(m - MTOT) * DM, F.lane);
    }
    constexpr int R_DA = DB * PAST, R_CB = DB * CBR, R_MEM = DB * NMEM * XW / 1024;
    for (int r0 = gw; r0 < 2 * R_DA + 2 * R_CB + 2 * R_MEM; r0 += NGW) {
        int r = r0;
        if (r < 2 * R_DA) { const int v = r >= R_DA; r -= v * R_DA; const int b = r >> 10, t = r & 1023;
            cvt_row1024(a.in[v ? I_CDAV : I_CDAK] + (size_t)r * 1024, (bf16*)(ws + (v ? WS_VDAS : WS_KDAS)) + (size_t)(b * KDAS_ROWS + t) * 1024, nullptr, F.lane); continue; }
        r -= 2 * R_DA;
        if (r < 2 * R_CB) { const int v = r >= R_CB; r -= v * R_CB; const int b = r >> 9, t = r & 511;
            float* fc = t >= DT ? a.out + (v ? O_CBVS : O_CBKS) + (size_t)(b * CBR + t - DT) * 1024 : nullptr;
            cvt_row1024(a.in[v ? I_CCBV : I_CCBK] + (size_t)r * 1024, (bf16*)(ws + (v ? WS_VCBS : WS_KCBS)) + (size_t)(b * KCBS_ROWS + t) * 1024, fc, F.lane); continue; }
        r -= 2 * R_CB;
        { const int v = r >= R_MEM; r -= v * R_MEM;
          cvt_row1024(a.in[v ? I_CMV : I_CMK] + (size_t)r * 1024, (bf16*)(ws + (v ? WS_MVS : WS_MKS)) + (size_t)r * 1024, nullptr, F.lane); }
    }
    if (blockIdx.x == 0) {
        float* lut = (float*)(ws + WS_LUT);
        for (int i = F.tid; i < 2 * 8 * 320; i += NWAVES * 64) { const int ty = i / 2560, h = (i / 320) & 7, e = i % 320, rel = e - 256;
            float v;
            if (ty == 0) v = a.in[I_T5][t5_bucket(rel) * 8 + h];
            else { const int idx = (rel < -128 ? -128 : (rel > 128 ? 128 : rel)) + 128; v = a.in[I_CBREL][idx * 8 + h]; }
            lut[i] = v * LOG2E; }
        if (F.wave == 0) { const float* lp = a.in[I_LAMBDA]; const float s1 = wave_sum(lp[F.lane] * lp[64 + F.lane]), s2 = wave_sum(lp[128 + F.lane] * lp[192 + F.lane]);
            if (F.lane == 0) *(float*)(ws + WS_LUT + 32768) = expf(s1) - expf(s2) + LAM_INIT; }
    }
}

__device__ __forceinline__ void rstd_phase(Frame& F, unsigned char* ws) {
    const float* ssq = (const float*)(ws + WS_SSQ); float* rstd = (float*)(ws + WS_RSTD);
    for (int row = F.vcu * (NWAVES * 64) + F.tid; row < MTOT; row += F.G * NWAVES * 64) {
        const f32x4* p = (const f32x4*)(ssq + (size_t)row * 32); float s = 0.f;
#pragma unroll
        for (int k = 0; k < 8; ++k) { const f32x4 v = p[k]; s += (v.x + v.y) + (v.z + v.w); }
        rstd[row] = 1.f / sqrtf(s * (1.f / DM) + EPS);
    }
}
__device__ __forceinline__ void final_phase(Frame& F, unsigned char* ws, float* outp, const float* g) {
    const float* ssq = (const float*)(ws + WS_SSQ);
    const int gw = F.vcu * NWAVES + F.wave, NGW = F.G * NWAVES;
    for (int row = gw; row < MTOT; row += NGW) {
        const float part = F.lane < 32 ? ssq[(size_t)row * 32 + F.lane] : 0.f;
        const float rs = 1.f / sqrtf(wave_sum(part) * (1.f / DM) + EPS);
        GAS f32x4* y = (GAS f32x4*)(outp + O_Y + (size_t)row * DM) + F.lane; const GAS f32x4* gg = (const GAS f32x4*)g + F.lane;
#pragma unroll
        for (int j = 0; j < 8; ++j) { const f32x4 v = y[64 * j], gv = gg[64 * j]; y[64 * j] = v * rs * gv; }
    }
}

#ifndef NO_DIFF
#define NO_DIFF 0
#endif
#ifndef NO_BAND
#define NO_BAND 0
#endif
#ifndef ATT_SD_DIFF
#define ATT_SD_DIFF 1
#endif
#ifndef ATT_SD_BAND
#define ATT_SD_BAND 1
#endif
using att::f32x16;
__device__ __forceinline__ void load_lut(Frame& F, const float* glut, char* lds) {
    __syncthreads();
    if (F.tid < 320) ((float*)(lds + att::LDS_LUT))[F.tid] = glut[F.tid];
    __syncthreads();
}
constexpr int LDS_OSTAGE = 69632;
__device__ __forceinline__ void store_o_bf16(const f32x16 (&o)[4], bf16* Ow, int ld, char* lds, int wid, int lane) {
    asm volatile("" : "+v"(lane));
    const int r32 = lane & 31, hi = lane >> 5;
    bf16* stg = (bf16*)(lds + LDS_OSTAGE + wid * 4096);
#pragma unroll
    for (int hf = 0; hf < 2; ++hf) {
#pragma unroll
        for (int r = 0; r < 16; ++r) { const int orow = att::crow(r, hi);
#pragma unroll
            for (int dd = 0; dd < 2; ++dd) stg[orow * 64 + dd * 32 + r32] = (bf16)f2bf(o[2 * hf + dd][r]); }
        asm volatile("s_waitcnt lgkmcnt(0)" ::: "memory");
        bf16* gp = Ow + (size_t)(lane >> 3) * ld + hf * 64 + (lane & 7) * 8;
#pragma unroll
        for (int i = 0; i < 4; ++i) { const v4u v = *(const v4u*)(stg + (i * 8 + (lane >> 3)) * 64 + (lane & 7) * 8); *(v4u*)gp = v; gp += (size_t)8 * ld; }
        asm volatile("s_waitcnt lgkmcnt(0)" ::: "memory");
    }
}
__device__ __forceinline__ void diff_unit(Frame& F, unsigned char* ws, const float* dag, char* lds, bool sample, int b, int h, int qb) {
    bf16* QO = (bf16*)(ws + WS_QO);
    const int wid = F.wave, lane = F.lane, r32 = lane & 31, hi = lane >> 5;
    const float lam = *(const float*)(ws + WS_LUT + 32768);
    const float* lut = (const float*)(lds + att::LDS_LUT);
    load_lut(F, (const float*)(ws + WS_LUT) + h * 320, lds);
    att::TileArgs T;
    size_t qrow; const bf16 *Kb, *Vb;
    if (!sample) { qrow = (size_t)b * SEQ + qb * 256 + wid * 32; Kb = (const bf16*)(ws + WS_KDAP) + (size_t)b * SEQ * 1024 + h * 128; Vb = (const bf16*)(ws + WS_VDAP) + (size_t)b * SEQ * 1024 + h * 128;
        T.t0 = 0; T.NT = 4 * qb + 4; T.tmax = T.NT - 1; T.wlo = 0; T.whi = 4 * qb + (wid >> 1); T.relw = -(qb * 256 + wid * 32); }
    else { qrow = (size_t)MP + b * DT + (wid & 1) * 32; Kb = (const bf16*)(ws + WS_KDAS) + (size_t)b * KDAS_ROWS * 1024 + h * 128; Vb = (const bf16*)(ws + WS_VDAS) + (size_t)b * KDAS_ROWS * 1024 + h * 128;
        T.t0 = 0; T.NT = 18; T.tmax = 16; T.wlo = 0; T.whi = 16; T.relw = -(PAST + (wid & 1) * 32); }
    T.ldq = DM; T.ldk = 1024; T.ldv = 1024; T.Vh = Vb;
    f32x4* stash = (f32x4*)(ws + WS_STASH) + ((size_t)blockIdx.x * 512 + F.tid) * 16;
    f32x16 o[4]; float l;
#pragma unroll 1
    for (int map = 0; map < 2; ++map) {
        T.Qw = QO + qrow * DM + h * 128 + map * 64; T.Kh = Kb + map * 64;
        att::attn_tiles<64, true, ATT_SD_DIFF>(T, lut, lds, o, l); att::attn_normalize(o, l, lds);
        if (map == 0) {
#pragma unroll
            for (int d = 0; d < 4; ++d)
#pragma unroll
                for (int q = 0; q < 4; ++q) stash[d * 4 + q] = (f32x4){o[d][4 * q], o[d][4 * q + 1], o[d][4 * q + 2], o[d][4 * q + 3]};
        }
    }
    float ss[16];
#pragma unroll
    for (int r = 0; r < 16; ++r) ss[r] = 0.f;
#pragma unroll
    for (int d = 0; d < 4; ++d)
#pragma unroll
        for (int q = 0; q < 4; ++q) { const f32x4 s4 = stash[d * 4 + q];
#pragma unroll
            for (int e = 0; e < 4; ++e) { const int r = 4 * q + e; const float v = s4[e] - lam * o[d][r]; o[d][r] = v; ss[r] += v * v; } }
#pragma unroll
    for (int r = 0; r < 16; ++r) { float s = ss[r]; s += __shfl_xor(s, 1); s += __shfl_xor(s, 2); s += __shfl_xor(s, 4); s += __shfl_xor(s, 8); s += __shfl_xor(s, 16);
        ss[r] = (1.f - LAM_INIT) / sqrtf(s * (1.f / 128.f) + EPS); }
#pragma unroll
    for (int d = 0; d < 4; ++d) { const float g = dag[d * 32 + r32];
#pragma unroll
        for (int r = 0; r < 16; ++r) o[d][r] *= ss[r] * g; }
    if (!sample || wid < 2) store_o_bf16(o, QO + qrow * DM + h * 128, DM, lds, wid, lane);
}
__device__ __forceinline__ void band_unit(Frame& F, unsigned char* ws, char* lds, bool sample, int b, int h, int qb) {
    bf16* QO = (bf16*)(ws + WS_QO);
    const int wid = F.wave, lane = F.lane;
    const float* lut = (const float*)(lds + att::LDS_LUT);
    load_lut(F, (const float*)(ws + WS_LUT) + 2560 + h * 320, lds);
    att::TileArgs T; size_t qrow;
    if (!sample) { qrow = (size_t)b * SEQ + qb * 256 + wid * 32; const int c0 = 4 * qb, c = c0 + (wid >> 1);
        T.Kh = (const bf16*)(ws + WS_KCBP) + (size_t)b * SEQ * 1024 + h * 128; T.Vh = (const bf16*)(ws + WS_VCBP) + (size_t)b * SEQ * 1024 + h * 128;
        T.t0 = c0 >= 8 ? c0 - 8 : 0; T.tmax = c0 + 3; T.NT = T.tmax - T.t0 + 1; T.wlo = c >= 8 ? c - 8 : 0; T.whi = c; T.relw = -(qb * 256 + wid * 32); }
    else { qrow = (size_t)MP + b * DT + (wid & 1) * 32;
        T.Kh = (const bf16*)(ws + WS_KCBS) + (size_t)b * KCBS_ROWS * 1024 + h * 128; T.Vh = (const bf16*)(ws + WS_VCBS) + (size_t)b * KCBS_ROWS * 1024 + h * 128;
        T.t0 = 0; T.NT = 10; T.tmax = 8; T.wlo = 0; T.whi = 8; T.relw = (PAST - CBR) - (PAST + (wid & 1) * 32); }
    T.ldq = DM; T.ldk = 1024; T.ldv = 1024; T.Qw = QO + qrow * DM + 1024 + h * 128;
    f32x16 o[4]; float l;
    att::attn_tiles<128, true, ATT_SD_BAND>(T, lut, lds, o, l); att::attn_normalize(o, l, lds);
    if (!sample || wid < 2) store_o_bf16(o, QO + qrow * DM + 1024 + h * 128, DM, lds, wid, lane);
}
__device__ __forceinline__ void cross_unit(Frame& F, unsigned char* ws, char* lds, bool sample, int b, int h, int qb) {
    bf16* QX = (bf16*)(ws + WS_QX);
    const int wid = F.wave, lane = F.lane;
    __syncthreads();
    att::TileArgs T; size_t qrow;
    if (!sample) { qrow = (size_t)b * SEQ + qb * 256 + wid * 32; T.Kh = (const bf16*)(ws + WS_MKP) + (size_t)b * NMEM * XW + h * 128; T.Vh = (const bf16*)(ws + WS_MVP) + (size_t)b * NMEM * XW + h * 128; }
    else { qrow = (size_t)MP + b * DT + (wid & 1) * 32; T.Kh = (const bf16*)(ws + WS_MKS) + (size_t)b * NMEM * XW + h * 128; T.Vh = (const bf16*)(ws + WS_MVS) + (size_t)b * NMEM * XW + h * 128; }
    T.t0 = 0; T.NT = 4; T.tmax = 3; T.wlo = 0; T.whi = 3; T.relw = 0; T.ldq = XW; T.ldk = XW; T.ldv = XW; T.Qw = QX + qrow * XW + h * 128;
    f32x16 o[4]; float l;
    att::attn_tiles<128, false, 2>(T, nullptr, lds, o, l); att::attn_normalize(o, l, lds);
    if (!sample || wid < 2) store_o_bf16(o, QX + qrow * XW + h * 128, XW, lds, wid, lane);
}

constexpr int PT_OFF = MISC_OFF + 128;
__device__ __forceinline__ unsigned long long ldp(LAS unsigned char* lds, int idx) {
    volatile LAS unsigned* p = (volatile LAS unsigned*)(lds + PT_OFF) + 2 * idx;
    const unsigned lo = __builtin_amdgcn_readfirstlane(p[0]), hi = __builtin_amdgcn_readfirstlane(p[1]);
    return ((unsigned long long)hi << 32) | lo;
}
__global__ void __launch_bounds__(NWAVES * 64, 2) mega_fwd(Args args) {
    extern __shared__ __attribute__((aligned(16))) unsigned char lds[];
    Frame F;
    F.lds = (LAS unsigned char*)lds; F.MISC = (volatile LAS unsigned*)(F.lds + MISC_OFF);
    F.tid = threadIdx.x; F.lane = F.tid & 63; F.wave = __builtin_amdgcn_readfirstlane(F.tid >> 6);
    F.G = gridDim.x; { const int bx = blockIdx.x; F.vcu = (F.G % 8 == 0) ? (bx % 8) * (F.G / 8) + bx / 8 : bx; }
    F.ctl = (gu32*)(args.ws + WS_CTL);
    for (int u = F.tid; u < (LDS_BYTES - LDSCTL_OFF) / 4; u += NWAVES * 64) ((LAS unsigned*)(F.lds + LDSCTL_OFF))[u] = 0u;
    __syncthreads();
    if (F.tid == 0) { volatile LAS unsigned long long* PT = (volatile LAS unsigned long long*)(F.lds + PT_OFF);
        PT[0] = (unsigned long long)args.out; PT[1] = (unsigned long long)args.ws; PT[2] = (unsigned long long)args.in[I_XP]; PT[3] = (unsigned long long)args.in[I_XS];
        PT[4] = (unsigned long long)args.in[I_GMIX]; PT[5] = (unsigned long long)args.in[I_BGATE]; PT[6] = (unsigned long long)args.in[I_GCROSS]; PT[7] = (unsigned long long)args.in[I_G2];
        PT[8] = (unsigned long long)args.in[I_DAG]; PT[9] = (unsigned long long)args.in[I_GFINAL]; }
    __syncthreads();
#define LDP(T, idx) ((T)ldp(F.lds, (idx)))
    XcdBarrier bar; bar.bar = (unsigned*)(F.ctl + CW_BAR); bar.x = 0; bar.st = nullptr;
    if (N_LAUNCHES == 1) bar = xcd_barrier_post((unsigned*)(F.ctl + CW_BAR), F.MISC + 8);
#define GRID_BAR() do { if (N_LAUNCHES == 1) xcd_barrier(bar); } while (0)
    const int lo = args.ph_lo, hi = args.ph_hi;
#ifndef PH_MASK
#define PH_MASK 0x1ffff
#endif
#define IN(k) (((PH_MASK >> (k)) & 1) && lo <= (k) && (k) < hi)
#define BOTH(k) (IN(k) && IN((k) + 1))
#define IDS() do { int t_ = threadIdx.x; asm volatile("" : "+v"(t_)); F.tid = t_; F.lane = t_ & 63; } while (0)
    const int G = F.G, bx = (int)blockIdx.x;
    LAS unsigned char* ring = F.lds + RING_OFF;

    if (IN(0)) { IDS(); p0_prologue(F, args); if (BOTH(0)) GRID_BAR(); }
    if (IN(1)) {
        unsigned char* ws = LDP(unsigned char*, 1);
        { pg8::Gemm g{(const bf16*)(ws + WS_XN), (const bf16*)(ws + WS_W1GU), MTOT, 2 * FF, DM}; pg8::StaticOrder S; S.init(MTOT, 2 * FF, G, bx);
          pg8::EpiSwiGLU E{(bf16*)(ws + WS_A), FF, nullptr};
          pg8::gemm_phase<pg8::EpiSwiGLU, pg8::StaticOrder, true, true>(ring, g, S, E); }
        if (bx >= G - 8) { float* out = LDP(float*, 0);
          pg8::Gemm g{(const bf16*)(ws + WS_XM), (const bf16*)(ws + WS_WMKV), NBP * NMEM, 1024, DM}; pg8::StaticOrder S; S.init(NBP * NMEM, 1024, G, bx - (G - 8));
          pg8::EpiMemKV E{(bf16*)(ws + WS_MKP), (bf16*)(ws + WS_MVP), out};
          pg8::gemm_phase<pg8::EpiMemKV, pg8::StaticOrder, true, true>(ring, g, S, E); }
        if (BOTH(1)) GRID_BAR();
    }
    if (IN(2)) {
        unsigned char* ws = LDP(unsigned char*, 1); float* out = LDP(float*, 0);
        pg8::Gemm g{(const bf16*)(ws + WS_A), (const bf16*)(ws + WS_W1D), MTOT, DM, FF}; pg8::StaticOrder S; S.init(MTOT, DM, G, bx);
        pg8::EpiResid E{LDP(const float*, 2), LDP(const float*, 3) - (size_t)MP * DM, out + O_Y, 0.5f, LDP(const float*, 4), (bf16*)(ws + WS_XN), (float*)(ws + WS_SSQ)};
        pg8::gemm_phase<pg8::EpiResid, pg8::StaticOrder, true, true>(ring, g, S, E);
        if (BOTH(2)) GRID_BAR();
    }
    if (IN(3)) { IDS(); rstd_phase(F, LDP(unsigned char*, 1)); if (BOTH(3)) GRID_BAR(); }
    if (IN(4)) {
        unsigned char* ws = LDP(unsigned char*, 1); float* out = LDP(float*, 0);
        pg8::Gemm g{(const bf16*)(ws + WS_XN), (const bf16*)(ws + WS_WQKV), MTOT, 6144, DM}; pg8::StaticOrder S; S.init(MTOT, 6144, G, bx);
        pg8::EpiQKV E{(const float*)(ws + WS_RSTD), (bf16*)(ws + WS_QO), (bf16*)(ws + WS_KDAP), (bf16*)(ws + WS_KDAS), (bf16*)(ws + WS_KCBS), out};
        pg8::gemm_phase<pg8::EpiQKV, pg8::StaticOrder, true, true>(ring, g, S, E);
        if (BOTH(4)) GRID_BAR();
    }
    if (IN(5)) {
        IDS();
        unsigned char* ws = LDP(unsigned char*, 1); const float* dag = LDP(const float*, 8);
        char* al = (char*)lds + RING_OFF;
        for (int u = F.vcu; u < 1280; u += G) { const bool smp = u >= 1024; const int v = u & 255, i = u >> 8, bh = v >> 4, s = v & 15;
            const int qb = i == 0 ? s : i == 1 ? 31 - s : i == 2 ? 32 + s : 63 - s;
            if (!NO_DIFF) diff_unit(F, ws, dag, al, smp, smp ? (v >> 3) : (bh >> 3), smp ? (v & 7) : (bh & 7), smp ? 0 : qb); }
        for (int u = F.vcu; u < 1280; u += G) { const bool smp = u >= 1024; const int v = u & 255, i = u >> 8, bh = v >> 4;
            if (!NO_BAND) band_unit(F, ws, al, smp, smp ? (v >> 3) : (bh >> 3), smp ? (v & 7) : (bh & 7), smp ? 0 : (v & 15) * 4 + i); }
        __syncthreads();
        if (BOTH(5)) GRID_BAR();
    }
    if (IN(6)) {
        unsigned char* ws = LDP(unsigned char*, 1);
        pg8::Gemm g{(const bf16*)(ws + WS_XN), (const bf16*)(ws + WS_WG), MTOT, 4096, DM}; pg8::StaticOrder S; S.init(MTOT, 4096, G, bx);
        pg8::EpiGates E{(const float*)(ws + WS_RSTD), LDP(const float*, 5), (bf16*)(ws + WS_GR), (bf16*)(ws + WS_GB)};
        pg8::gemm_phase<pg8::EpiGates, pg8::StaticOrder, true, true>(ring, g, S, E);
        if (BOTH(6)) GRID_BAR();
    }
    if (IN(7)) {
        unsigned char* ws = LDP(unsigned char*, 1);
        pg8::Gemm g{(const bf16*)(ws + WS_QO), (const bf16*)(ws + WS_WBR), MTOT, DM, DM}; pg8::StaticOrder S; S.init(MTOT, DM, G, bx);
        pg8::EpiMix E{(const bf16*)(ws + WS_GR), (const bf16*)(ws + WS_GB), (bf16*)(ws + WS_MIX)};
        pg8::gemm_phase<pg8::EpiMix, pg8::StaticOrder, true, true>(ring, g, S, E);
        if (BOTH(7)) GRID_BAR();
    }
    if (IN(8)) {
        unsigned char* ws = LDP(unsigned char*, 1); float* out = LDP(float*, 0);
        pg8::Gemm g{(const bf16*)(ws + WS_MIX), (const bf16*)(ws + WS_WO), MTOT, DM, DM}; pg8::StaticOrder S; S.init(MTOT, DM, G, bx);
        pg8::EpiResid E{out + O_Y, out + O_Y, out + O_Y, 1.0f, LDP(const float*, 6), (bf16*)(ws + WS_XN), (float*)(ws + WS_SSQ)};
        pg8::gemm_phase<pg8::EpiResid, pg8::StaticOrder, true, true>(ring, g, S, E);
        if (BOTH(8)) GRID_BAR();
    }
    if (IN(9)) { IDS(); rstd_phase(F, LDP(unsigned char*, 1)); if (BOTH(9)) GRID_BAR(); }
    if (IN(10)) {
        unsigned char* ws = LDP(unsigned char*, 1);
        pg8::Gemm g{(const bf16*)(ws + WS_XN), (const bf16*)(ws + WS_WCQ), MTOT, XW, DM}; pg8::StaticOrder S; S.init(MTOT, XW, G, bx);
        pg8::EpiScaleBf16 E{(const float*)(ws + WS_RSTD), (bf16*)(ws + WS_QX), XW, SC_CB};
        pg8::gemm_phase<pg8::EpiScaleBf16, pg8::StaticOrder, true, true>(ring, g, S, E);
        if (BOTH(10)) GRID_BAR();
    }
    if (IN(11)) {
        IDS();
        unsigned char* ws = LDP(unsigned char*, 1);
        char* al = (char*)lds + RING_OFF;
        for (int u = F.vcu; u < 640; u += G) {
            const bool smp = u >= 512;
            cross_unit(F, ws, al, smp, smp ? ((u - 512) >> 2) : (u >> 8), smp ? ((u - 512) & 3) : ((u >> 6) & 3), smp ? 0 : (u & 63));
        }
        __syncthreads();
        if (BOTH(11)) GRID_BAR();
    }
    if (IN(12)) {
        unsigned char* ws = LDP(unsigned char*, 1); float* out = LDP(float*, 0);
        pg8::Gemm g{(const bf16*)(ws + WS_QX), (const bf16*)(ws + WS_WCO), MTOT, DM, XW}; pg8::StaticOrder S; S.init(MTOT, DM, G, bx);
        pg8::EpiResid E{out + O_Y, out + O_Y, out + O_Y, 1.0f, LDP(const float*, 7), (bf16*)(ws + WS_XN), (float*)(ws + WS_SSQ)};
        pg8::gemm_phase<pg8::EpiResid, pg8::StaticOrder, true, true>(ring, g, S, E);
        if (BOTH(12)) GRID_BAR();
    }
    if (IN(13)) { IDS(); rstd_phase(F, LDP(unsigned char*, 1)); if (BOTH(13)) GRID_BAR(); }
    if (IN(14)) {
        unsigned char* ws = LDP(unsigned char*, 1);
        pg8::Gemm g{(const bf16*)(ws + WS_XN), (const bf16*)(ws + WS_W2GU), MTOT, 2 * FF, DM}; pg8::StaticOrder S; S.init(MTOT, 2 * FF, G, bx);
        pg8::EpiSwiGLU E{(bf16*)(ws + WS_A), FF, (const float*)(ws + WS_RSTD)};
        pg8::gemm_phase<pg8::EpiSwiGLU, pg8::StaticOrder, true, true>(ring, g, S, E);
        if (BOTH(14)) GRID_BAR();
    }
    if (IN(15)) {
        unsigned char* ws = LDP(unsigned char*, 1); float* out = LDP(float*, 0);
        pg8::Gemm g{(const bf16*)(ws + WS_A), (const bf16*)(ws + WS_W2D), MTOT, DM, FF}; pg8::StaticOrder S; S.init(MTOT, DM, G, bx);
        pg8::EpiResid E{out + O_Y, out + O_Y, out + O_Y, 0.5f, nullptr, nullptr, (float*)(ws + WS_SSQ)};
        pg8::gemm_phase<pg8::EpiResid, pg8::StaticOrder, true, true>(ring, g, S, E);
        if (BOTH(15)) GRID_BAR();
    }
    if (IN(16)) { IDS(); final_phase(F, LDP(unsigned char*, 1), LDP(float*, 0), LDP(const float*, 9)); }
#undef IN
#undef BOTH
#undef GRID_BAR
#undef LDP
#undef IDS
}

extern "C" void kernel_launch(void* const* d_in, const int* in_sizes, int n_in, void* d_out, int out_size, void* d_ws, size_t ws_size, hipStream_t stream) {
    static int grid = 0;
    if (grid == 0) {
        if (n_in != 33 || (size_t)out_size != O_TOTAL || ws_size < WS_END) { fprintf(stderr, "kernel_launch: shape mismatch: n_in %d out %d ws %zu (need 33, %zu, >= %zu)\n", n_in, out_size, ws_size, (size_t)O_TOTAL, (size_t)WS_END); grid = -1; return; }
        int dev = 0, cus = 0, per_cu = 0;
        if (hipGetDevice(&dev) != hipSuccess || hipDeviceGetAttribute(&cus, hipDeviceAttributeMultiprocessorCount, dev) != hipSuccess) { grid = -1; return; }
        if (hipFuncSetAttribute((const void*)mega_fwd, hipFuncAttributeMaxDynamicSharedMemorySize, LDS_BYTES) != hipSuccess) { fprintf(stderr, "kernel_launch: hipFuncSetAttribute failed\n"); grid = -1; return; }
        if (hipOccupancyMaxActiveBlocksPerMultiprocessor(&per_cu, (const void*)mega_fwd, NWAVES * 64, LDS_BYTES) != hipSuccess || per_cu < 1)
            fprintf(stderr, "kernel_launch: note: occupancy query reports %d workgroups per CU\n", per_cu);
        (void)hipGetLastError();
        grid = cus;
    }
    if (grid < 0) return;
    if (hipMemsetAsync((char*)d_ws + WS_CTL, 0, CTL_ZERO_BYTES, stream) != hipSuccess) return;
    Args a{};
    for (int i = 0; i < 33; ++i) a.in[i] = (const float*)d_in[i];
    a.out = (float*)d_out; a.ws = (unsigned char*)d_ws;
    if (N_LAUNCHES == 1) { a.ph_lo = 0; a.ph_hi = N_PHASES; a.li = 0; hipLaunchKernelGGL(mega_fwd, dim3(grid), dim3(NWAVES * 64), LDS_BYTES, stream, a); }
    else for (int p = 0; p < N_PHASES; ++p) { a.ph_lo = p; a.ph_hi = p + 1; a.li = p; hipLaunchKernelGGL(mega_fwd, dim3(grid), dim3(NWAVES * 64), LDS_BYTES, stream, a); }
    const hipError_t le = hipPeekAtLastError();
    if (le != hipSuccess) fprintf(stderr, "kernel_launch: launch failed: %s\n", hipGetErrorName(le));
}
```

```cpp
#include <hip/hip_runtime.h>
#include <cstdio>
#include <cstdint>
#include <cmath>

constexpr int DM = 2048, SEQ = 16384, NBP = 2, MP = NBP * SEQ, DB = 32, DT = 64, MS = DB * DT, MTOT = MP + MS;
constexpr int PAST = 1024, FF = 5632, NMEM = 256, XW = 512, CBR = 512;
constexpr int KDAS_ROWS = PAST + DT  , KCBS_ROWS = CBR + DT  ;
constexpr float EPS = 1e-6f, LOG2E = 1.4426950408889634f;
constexpr float SC_DA = 0.125f * LOG2E, SC_CB = 0.08838834764831845f * LOG2E;
constexpr float LAM_INIT = 0.2f;

constexpr size_t MiB = 1u << 20;
constexpr size_t WS_CTL = 0, CTL_ZERO_BYTES = 1 * MiB;
constexpr size_t WS_SSQ = 1 * MiB;
constexpr size_t WS_RSTD = 6 * MiB;
constexpr size_t WS_LUT = 6 * MiB + 512 * 1024;
constexpr size_t WS_XM = 7 * MiB;
constexpr size_t WS_MKP = 9 * MiB, WS_MVP = 9 * MiB + 512 * 1024;
constexpr size_t WS_MKS = 10 * MiB, WS_MVS = 18 * MiB;
constexpr size_t WS_W1GU = 26 * MiB, WS_W1D = 70 * MiB, WS_WQKV = 92 * MiB, WS_WG = 116 * MiB, WS_WBR = 132 * MiB, WS_WO = 140 * MiB;
constexpr size_t WS_WMKV = 148 * MiB, WS_WCQ = 152 * MiB, WS_WCO = 154 * MiB, WS_W2GU = 156 * MiB, WS_W2D = 200 * MiB;
constexpr size_t WS_XN = 222 * MiB;
constexpr size_t WS_QX = 358 * MiB;
constexpr size_t WS_STASH = WS_QX;
constexpr size_t WS_R = 392 * MiB;
constexpr size_t WS_A = WS_R;
constexpr size_t WS_QO = WS_R;
constexpr size_t WS_KDAP = 528 * MiB, WS_VDAP = 592 * MiB, WS_KCBP = 656 * MiB, WS_VCBP = 720 * MiB;
constexpr size_t WS_KDAS = 784 * MiB, WS_VDAS = 852 * MiB;
constexpr size_t WS_KCBS = 920 * MiB, WS_VCBS = 956 * MiB;
constexpr size_t WS_GR = 528 * MiB, WS_GB = 664 * MiB;
constexpr size_t WS_MIX = 800 * MiB;
constexpr size_t WS_END = 992 * MiB;
static_assert(WS_A + (size_t)MTOT * FF * 2 <= WS_KDAS, "A1/A2 must not reach the sample K/V buffers");
static_assert(WS_GB + (size_t)MTOT * DM * 2 <= WS_MIX && WS_MIX + (size_t)MTOT * DM * 2 <= WS_END, "ws map");
static_assert(WS_VCBS + (size_t)DB * KCBS_ROWS * 1024 * 2 <= WS_END, "ws map");
static_assert(WS_XN + (size_t)MTOT * DM * 2 <= WS_QX && WS_QX + (size_t)MTOT * XW * 2 <= WS_R, "ws map");

constexpr size_t O_Y = 0, O_DAKP = (size_t)MTOT * DM, O_DAVP = O_DAKP + (size_t)MP * 1024, O_CBKP = O_DAVP + (size_t)MP * 1024, O_CBVP = O_CBKP + (size_t)NBP * CBR * 1024;
constexpr size_t O_MKP = O_CBVP + (size_t)NBP * CBR * 1024, O_MVP = O_MKP + (size_t)NBP * NMEM * XW, O_DAKS = O_MVP + (size_t)NBP * NMEM * XW, O_DAVS = O_DAKS + (size_t)MS * 1024;
constexpr size_t O_CBKS = O_DAVS + (size_t)MS * 1024, O_CBVS = O_CBKS + (size_t)DB * CBR * 1024, O_TOTAL = O_CBVS + (size_t)DB * CBR * 1024;
static_assert(O_TOTAL == 178782208, "output size");

constexpr int CW_TMO = 0, CW_CODE = 1, CW_BAR = 4096;

constexpr int RING_OFF = 0, RING_BYTES = 131072, LDSCTL_OFF = 137216  , MISC_OFF = LDSCTL_OFF + 320, LDS_BYTES = 147456;
constexpr int NWAVES = 8;
namespace pg8 {
#define PG8_LAS __attribute__((address_space(3)))
typedef unsigned short bf16_t;
typedef short bf16x8 __attribute__((ext_vector_type(8)));
typedef float f32x4 __attribute__((ext_vector_type(4)));
typedef unsigned u32x4 __attribute__((ext_vector_type(4)));
constexpr int BM = 256, BK = 64, HALF = 128, HTB = HALF * BK * 2  , STAGE_BYTES = 8 * HTB, NXCD = 8, WGM = 4;

__host__ __device__ __forceinline__ int lds_byte(int r, int c) { const int st = (r >> 4) * 2 + (c >> 5), rr = r & 15, cc = c & 31, ob = rr * 64 + cc * 2; return st * 1024 + (ob ^ (((ob >> 9) & 1) << 5)); }
__host__ __device__ __forceinline__ void stage_rc(int b, int& R, int& C) { const int st = b / 1024, sb = b % 1024, swz = sb ^ (((sb >> 9) & 1) << 5); R = (st >> 1) * 16 + swz / 64; C = (st & 1) * 32 + (swz % 64) / 2; }
__host__ __device__ __forceinline__ int perm32(int rho) { const int n = rho >> 4, i = rho & 15; return 8 * (i >> 2) + 4 * n + (i & 3); }

#ifndef PN_ROT
#define PN_ROT 0
#endif
struct Unit { int pm, pn; };
struct Gemm { const bf16_t* A; const bf16_t* Bt; int M, N, K; int ld = 0; int ablk = 0; };
struct OneUnit { Unit u; __host__ __device__ bool next(int i, Unit& o) const { if (i) return false; o = u; return true; } __device__ __forceinline__ void a_ready(const Unit&) const {} __device__ __forceinline__ void done(const Unit&) const {} };

struct StaticOrder {
    int nM, nN, nwg, G, c; int rev = 0; int wgm = WGM;
    __host__ __device__ void init(int M, int N, int G_, int c_, int rev_ = 0, int wgm_ = WGM) { nM = M / BM; nN = N / BM; nwg = nM * nN; G = G_; c = c_; rev = rev_; wgm = wgm_; }
    __host__ __device__ bool next(int i, Unit& u) const {
        const long L = (long)i * G + c; if (L >= nwg) return false;
        int wgid = (int)L; { const int q = nwg / NXCD, r = nwg % NXCD, xcd = wgid % NXCD, off = wgid / NXCD; wgid = (xcd < r ? xcd * (q + 1) : r * (q + 1) + (xcd - r) * q) + off; }
        const int nig = wgm * nN, gid = wgid / nig, fm = gid * wgm, gsz = (nM - fm) < wgm ? (nM - fm) : wgm;
        u.pm = fm + ((wgid % nig) % gsz); u.pn = (wgid % nig) / gsz; if (rev) u.pm = nM - 1 - u.pm;
        if (PN_ROT) u.pn = (u.pn + gid * PN_ROT) % nN;
        return true;
    }
    __device__ __forceinline__ void a_ready(const Unit&) const {}
    __device__ __forceinline__ void done(const Unit&) const {}
};

__device__ __forceinline__ unsigned cvt_pk_bf16(float lo, float hi) { unsigned r; asm volatile("v_cvt_pk_bf16_f32 %0, %1, %2" : "=v"(r) : "v"(lo), "v"(hi)); return r; }
typedef float f32x2 __attribute__((ext_vector_type(2)));
#define GAS_ __attribute__((address_space(1)))
__device__ __forceinline__ float sigm(float x) { return __builtin_amdgcn_rcpf(1.f + __builtin_amdgcn_exp2f(-1.4426950408889634f * x)); }
__device__ __forceinline__ u32x4 pack8(const f32x4 a, const f32x4 b) { u32x4 w; w.x = cvt_pk_bf16(a[0], a[1]); w.y = cvt_pk_bf16(a[2], a[3]); w.z = cvt_pk_bf16(b[0], b[1]); w.w = cvt_pk_bf16(b[2], b[3]); return w; }
__device__ __forceinline__ void unpack8(const u32x4 w, f32x4& a, f32x4& b) {
    a[0] = __uint_as_float(w.x << 16); a[1] = __uint_as_float(w.x & 0xffff0000u); a[2] = __uint_as_float(w.y << 16); a[3] = __uint_as_float(w.y & 0xffff0000u);
    b[0] = __uint_as_float(w.z << 16); b[1] = __uint_as_float(w.z & 0xffff0000u); b[2] = __uint_as_float(w.w << 16); b[3] = __uint_as_float(w.w & 0xffff0000u); }

struct EpiSwiGLU {
    static constexpr bool PERM = true, AFTER_DRAIN = false, MIDK = false;
    bf16_t* O; int ldc; const float* rstd; int blk;
    __device__ __forceinline__ void operator()(const f32x4 (&acc)[2][2][4][2], const Unit& u, int wr, int wc, int fr, int fq) const {
        asm volatile("" : "+v"(fr), "+v"(fq));
        const int row0 = u.pm * BM + wr * 64 + fr, col0 = u.pn * HALF + wc * 32 + 8 * fq;
#pragma unroll
        for (int ai = 0; ai < 2; ++ai)
#pragma unroll
            for (int m = 0; m < 4; ++m) {
                const int row = row0 + ai * HALF + m * 16; const float rs = rstd ? ((const GAS_ float*)rstd)[row] : 1.f;
                f32x4 o[2];
#pragma unroll
                for (int n = 0; n < 2; ++n) { const f32x4 g = acc[ai][0][m][n] * rs, up = acc[ai][1][m][n] * rs;
#pragma unroll
                    for (int e = 0; e < 4; ++e) o[n][e] = g[e] * sigm(g[e]) * up[e]; }
                if (blk) *(GAS_ u32x4*)(O + (size_t)(row >> 8) * ((size_t)BM * ldc) + (size_t)(col0 >> 6) * (BM * BK) + (row & 255) * BK + (col0 & 63)) = pack8(o[0], o[1]);
                else *(GAS_ u32x4*)(O + (size_t)row * ldc + col0) = pack8(o[0], o[1]);
            }
    }
};

struct EpiResidX {
    static constexpr bool PERM = true, AFTER_DRAIN = false, MIDK = false;
    const float* base_p; const float* base_s; float alpha; const float* gnext; bf16_t* HG; float* ssq;
    __device__ __forceinline__ void operator()(const f32x4 (&acc)[2][2][4][2], const Unit& u, int wr, int wc, int fr, int fq) const {
        asm volatile("" : "+v"(fr), "+v"(fq));
        const int row0 = u.pm * BM + wr * 64 + fr, col0 = u.pn * BM + wc * 32 + 8 * fq;
        const float* base = (u.pm < MP / BM) ? base_p : base_s;
        f32x4 gn[2][2];
#pragma unroll
        for (int bj = 0; bj < 2; ++bj)
#pragma unroll
            for (int n = 0; n < 2; ++n) gn[bj][n] = *(const GAS_ f32x4*)(gnext + col0 + bj * HALF + 4 * n);
#pragma unroll
        for (int ai = 0; ai < 2; ++ai) {
#pragma unroll
            for (int mh = 0; mh < 2; ++mh) {
                f32x4 xb[2][2][2];
#pragma unroll
                for (int mm = 0; mm < 2; ++mm)
#pragma unroll
                    for (int bj = 0; bj < 2; ++bj)
#pragma unroll
                        for (int n = 0; n < 2; ++n) xb[mm][bj][n] = *(const GAS_ f32x4*)(base + (size_t)(row0 + ai * HALF + (2 * mh + mm) * 16) * DM + col0 + bj * HALF + 4 * n);
#pragma unroll
                for (int mm = 0; mm < 2; ++mm) { const int m = 2 * mh + mm;
                    const int row = row0 + ai * HALF + m * 16; const size_t off = (size_t)row * DM + col0; float ss = 0.f;
#pragma unroll
                    for (int bj = 0; bj < 2; ++bj) { f32x4 v[2];
#pragma unroll
                        for (int n = 0; n < 2; ++n) { v[n] = xb[mm][bj][n] + acc[ai][bj][m][n] * alpha; ss += (v[n][0] * v[n][0] + v[n][1] * v[n][1]) + (v[n][2] * v[n][2] + v[n][3] * v[n][3]); }
                        *(GAS_ u32x4*)(HG + off + bj * HALF) = pack8(v[0] * gn[bj][0], v[1] * gn[bj][1]); }
                    ss += __shfl_xor(ss, 16); ss += __shfl_xor(ss, 32);
                    if (fq == 0) ((GAS_ float*)ssq)[(size_t)row * 32 + u.pn * 4 + wc] = ss;
                }
            }
        }
    }
};
template <bool OUT_F32> struct EpiResidH {
    static constexpr bool PERM = true, AFTER_DRAIN = false, MIDK = false;
    bf16_t* HG; const float* gprev; const float* gnext; float* outf; float alpha; float* ssq;
    __device__ __forceinline__ void operator()(const f32x4 (&acc)[2][2][4][2], const Unit& u, int wr, int wc, int fr, int fq) const {
        asm volatile("" : "+v"(fr), "+v"(fq));
        const int row0 = u.pm * BM + wr * 64 + fr, col0 = u.pn * BM + wc * 32 + 8 * fq;
        f32x4 rg[2][2], gn[2][2];
#pragma unroll
        for (int bj = 0; bj < 2; ++bj)
#pragma unroll
            for (int n = 0; n < 2; ++n) { const f32x4 g = *(const GAS_ f32x4*)(gprev + col0 + bj * HALF + 4 * n);
#pragma unroll
                for (int e = 0; e < 4; ++e) rg[bj][n][e] = 1.0f / g[e];
                gn[bj][n] = OUT_F32 ? (f32x4){0.f, 0.f, 0.f, 0.f} : *(const GAS_ f32x4*)(gnext + col0 + bj * HALF + 4 * n); }
#pragma unroll
        for (int ai = 0; ai < 2; ++ai) {
            u32x4 hb[4][2];
#pragma unroll
            for (int m = 0; m < 4; ++m)
#pragma unroll
                for (int bj = 0; bj < 2; ++bj) hb[m][bj] = *(const GAS_ u32x4*)(HG + (size_t)(row0 + ai * HALF + m * 16) * DM + col0 + bj * HALF);
#pragma unroll
            for (int m = 0; m < 4; ++m) {
                const int row = row0 + ai * HALF + m * 16; const size_t off = (size_t)row * DM + col0; float ss = 0.f;
#pragma unroll
                for (int bj = 0; bj < 2; ++bj) { f32x4 h0, h1; unpack8(hb[m][bj], h0, h1);
                    const f32x4 v0 = h0 * rg[bj][0] + acc[ai][bj][m][0] * alpha, v1 = h1 * rg[bj][1] + acc[ai][bj][m][1] * alpha;
                    ss += (v0[0] * v0[0] + v0[1] * v0[1]) + (v0[2] * v0[2] + v0[3] * v0[3]) + (v1[0] * v1[0] + v1[1] * v1[1]) + (v1[2] * v1[2] + v1[3] * v1[3]);
                    if (OUT_F32) { *(GAS_ f32x4*)(outf + off + bj * HALF) = v0; *(GAS_ f32x4*)(outf + off + bj * HALF + 4) = v1; }
                    else *(GAS_ u32x4*)(HG + off + bj * HALF) = pack8(v0 * gn[bj][0], v1 * gn[bj][1]); }
                ss += __shfl_xor(ss, 16); ss += __shfl_xor(ss, 32);
                if (fq == 0) ((GAS_ float*)ssq)[(size_t)row * 32 + u.pn * 4 + wc] = ss;
            }
        }
    }
};

struct EpiQKV {
    static constexpr bool PERM = true, AFTER_DRAIN = false, MIDK = false;
    const float* rstd; bf16_t* QO; bf16_t* KVP; bf16_t* KVS_DA; bf16_t* KVS_CB; float* out;
    __device__ __forceinline__ void operator()(const f32x4 (&acc)[2][2][4][2], const Unit& u, int wr, int wc, int fr, int fq) const {
        asm volatile("" : "+v"(fr), "+v"(fq));
        const int reg = u.pn >> 2, cin0 = (u.pn & 3) * BM + wc * 32 + 8 * fq, row0 = u.pm * BM + wr * 64 + fr;
        const bool prompt = u.pm < MP / BM;
        const float sc = reg == 0 ? SC_DA : (reg == 3 ? SC_CB : 1.f);
        const int kv = reg == 1 ? 0 : reg == 2 ? 1 : reg == 4 ? 2 : 3;
        const bool cb = reg >= 4;
#pragma unroll
        for (int ai = 0; ai < 2; ++ai)
#pragma unroll
            for (int m = 0; m < 4; ++m) {
                const int row = row0 + ai * HALF + m * 16; const float rs = ((const GAS_ float*)rstd)[row];
                bf16_t* bd; float* fd = nullptr;
                if (reg == 0) bd = QO + (size_t)row * DM + cin0;
                else if (reg == 3) bd = QO + (size_t)row * DM + 1024 + cin0;
                else if (prompt) {
                    bd = KVP + (size_t)kv * (32u * 1024u * 1024u) + (size_t)row * 1024 + cin0;
                    if (!cb) fd = out + (kv == 0 ? O_DAKP : O_DAVP) + (size_t)row * 1024 + cin0;
                    else { const int t = row & (SEQ - 1), b = row >> 14; if (t >= SEQ - CBR) fd = out + (kv == 2 ? O_CBKP : O_CBVP) + (size_t)(b * CBR + t - (SEQ - CBR)) * 1024 + cin0; }
                } else {
                    const int s = row - MP, b = s >> 6, t = s & 63;
                    if (!cb) { bd = KVS_DA + (size_t)kv * (34u * 1024u * 1024u) + (size_t)(b * KDAS_ROWS + PAST + t) * 1024 + cin0;
                               fd = out + (kv == 0 ? O_DAKS : O_DAVS) + (size_t)s * 1024 + cin0; }
                    else { bd = KVS_CB + (size_t)(kv - 2) * (18u * 1024u * 1024u) + (size_t)(b * KCBS_ROWS + CBR + t) * 1024 + cin0;
                           fd = out + (kv == 2 ? O_CBKS : O_CBVS) + (size_t)(b * CBR + (CBR - DT) + t) * 1024 + cin0; }
                }
#pragma unroll
                for (int bj = 0; bj < 2; ++bj) { const f32x4 v0 = acc[ai][bj][m][0] * rs, v1 = acc[ai][bj][m][1] * rs;
                    *(GAS_ u32x4*)(bd + bj * HALF) = pack8(v0 * sc, v1 * sc);
                    if (fd) { *(GAS_ f32x4*)(fd + bj * HALF) = v0; *(GAS_ f32x4*)(fd + bj * HALF + 4) = v1; } }
            }
    }
};

struct EpiGates {
    static constexpr bool PERM = true, AFTER_DRAIN = false, MIDK = false;
    const float* rstd; const float* bgate; bf16_t* GR; bf16_t* GB;
    __device__ __forceinline__ void operator()(const f32x4 (&acc)[2][2][4][2], const Unit& u, int wr, int wc, int fr, int fq) const {
        asm volatile("" : "+v"(fr), "+v"(fq));
        const int row0 = u.pm * BM + wr * 64 + fr, col0 = u.pn * HALF + wc * 32 + 8 * fq;
        f32x4 ba[2], bb[2];
#pragma unroll
        for (int n = 0; n < 2; ++n) { ba[n] = *(const GAS_ f32x4*)(bgate + col0 + 4 * n); bb[n] = *(const GAS_ f32x4*)(bgate + DM + col0 + 4 * n); }
#pragma unroll
        for (int ai = 0; ai < 2; ++ai)
#pragma unroll
            for (int m = 0; m < 4; ++m) {
                const int row = row0 + ai * HALF + m * 16; const float rs = ((const GAS_ float*)rstd)[row];
                f32x4 r[2], g[2];
#pragma unroll
                for (int n = 0; n < 2; ++n) { const f32x4 za = acc[ai][0][m][n] * rs + ba[n], zb = acc[ai][1][m][n] * rs + bb[n];
#pragma unroll
                    for (int e = 0; e < 4; ++e) { const float xa = fminf(fmaxf(za[e], -30.f), 30.f), xb = fminf(fmaxf(zb[e], -30.f), 30.f);
                        const float ea = 1.f + __builtin_amdgcn_exp2f(-1.4426950408889634f * xa), eb = 1.f + __builtin_amdgcn_exp2f(-1.4426950408889634f * xb);
                        g[n][e] = __builtin_amdgcn_rcpf(eb); r[n][e] = eb * __builtin_amdgcn_rcpf(ea); } }
                *(GAS_ u32x4*)(GR + (size_t)row * DM + col0) = pack8(r[0], r[1]);
                *(GAS_ u32x4*)(GB + (size_t)row * DM + col0) = pack8(g[0], g[1]);
            }
    }
};

struct EpiMix {
    static constexpr bool PERM = true, AFTER_DRAIN = false, MIDK = true;
    const bf16_t* GR; const bf16_t* GB; bf16_t* MIX;
    __device__ __forceinline__ void midk(f32x4 (&acc)[2][2][4][2], const Unit& u, int wr, int wc, int fr, int fq) const {
        asm volatile("" : "+v"(fr), "+v"(fq));
        const int row0 = u.pm * BM + wr * 64 + fr, col0 = u.pn * BM + wc * 32 + 8 * fq;
#pragma unroll
        for (int ai = 0; ai < 2; ++ai) { u32x4 w[4][2];
#pragma unroll
            for (int m = 0; m < 4; ++m)
#pragma unroll
                for (int bj = 0; bj < 2; ++bj) w[m][bj] = *(const GAS_ u32x4*)(GR + (size_t)(row0 + ai * HALF + m * 16) * DM + col0 + bj * HALF);
#pragma unroll
            for (int m = 0; m < 4; ++m)
#pragma unroll
                for (int bj = 0; bj < 2; ++bj) { f32x4 a, b; unpack8(w[m][bj], a, b); acc[ai][bj][m][0] *= a; acc[ai][bj][m][1] *= b; } }
    }
    __device__ __forceinline__ void operator()(const f32x4 (&acc)[2][2][4][2], const Unit& u, int wr, int wc, int fr, int fq) const {
        asm volatile("" : "+v"(fr), "+v"(fq));
        const int row0 = u.pm * BM + wr * 64 + fr, col0 = u.pn * BM + wc * 32 + 8 * fq;
#pragma unroll
        for (int ai = 0; ai < 2; ++ai) { u32x4 w[4][2];
#pragma unroll
            for (int m = 0; m < 4; ++m)
#pragma unroll
                for (int bj = 0; bj < 2; ++bj) w[m][bj] = *(const GAS_ u32x4*)(GB + (size_t)(row0 + ai * HALF + m * 16) * DM + col0 + bj * HALF);
#pragma unroll
            for (int m = 0; m < 4; ++m)
#pragma unroll
                for (int bj = 0; bj < 2; ++bj) { f32x4 a, b; unpack8(w[m][bj], a, b);
                    *(GAS_ u32x4*)(MIX + (size_t)(row0 + ai * HALF + m * 16) * DM + col0 + bj * HALF) = pack8(acc[ai][bj][m][0] * a, acc[ai][bj][m][1] * b); } }
    }
};

struct EpiSlab {
    static constexpr bool PERM = true, AFTER_DRAIN = false, MIDK = false;
    float* slab;
    __device__ __forceinline__ void operator()(const f32x4 (&acc)[2][2][4][2], const Unit& u, int wr, int wc, int fr, int fq) const {
        asm volatile("" : "+v"(fr), "+v"(fq));
        const int r0 = wr * 64 + fr, c0 = wc * 32 + 8 * fq;
#pragma unroll
        for (int ai = 0; ai < 2; ++ai)
#pragma unroll
            for (int m = 0; m < 4; ++m)
#pragma unroll
                for (int bj = 0; bj < 2; ++bj) { GAS_ float* p = (GAS_ float*)slab + (size_t)(r0 + ai * HALF + m * 16) * BM + c0 + bj * HALF;
                    *(GAS_ f32x4*)p = acc[ai][bj][m][0]; *(GAS_ f32x4*)(p + 4) = acc[ai][bj][m][1]; }
    }
};
struct EpiScaleBf16 {
    static constexpr bool PERM = true, AFTER_DRAIN = false, MIDK = false;
    const float* rstd; bf16_t* O; int ldc; float sc;
    __device__ __forceinline__ void operator()(const f32x4 (&acc)[2][2][4][2], const Unit& u, int wr, int wc, int fr, int fq) const {
        asm volatile("" : "+v"(fr), "+v"(fq));
        const int row0 = u.pm * BM + wr * 64 + fr, col0 = u.pn * BM + wc * 32 + 8 * fq;
#pragma unroll
        for (int ai = 0; ai < 2; ++ai)
#pragma unroll
            for (int m = 0; m < 4; ++m) { const int row = row0 + ai * HALF + m * 16; const float rs = ((const GAS_ float*)rstd)[row] * sc;
#pragma unroll
                for (int bj = 0; bj < 2; ++bj) *(GAS_ u32x4*)(O + (size_t)row * ldc + col0 + bj * HALF) = pack8(acc[ai][bj][m][0] * rs, acc[ai][bj][m][1] * rs); }
    }
};

struct EpiMemKV {
    static constexpr bool PERM = true, AFTER_DRAIN = false, MIDK = false;
    bf16_t* MKP; bf16_t* MVP; float* out;
    __device__ __forceinline__ void operator()(const f32x4 (&acc)[2][2][4][2], const Unit& u, int wr, int wc, int fr, int fq) const {
        asm volatile("" : "+v"(fr), "+v"(fq));
        const int row0 = u.pm * BM + wr * 64 + fr, col0 = (u.pn & 1) * BM + wc * 32 + 8 * fq; const bool isv = u.pn >= 2;
        bf16_t* B = isv ? MVP : MKP; float* F = out + (isv ? O_MVP : O_MKP);
#pragma unroll
        for (int ai = 0; ai < 2; ++ai)
#pragma unroll
            for (int m = 0; m < 4; ++m) { const size_t off = (size_t)(row0 + ai * HALF + m * 16) * XW + col0;
#pragma unroll
                for (int bj = 0; bj < 2; ++bj) { *(GAS_ u32x4*)(B + off + bj * HALF) = pack8(acc[ai][bj][m][0], acc[ai][bj][m][1]);
                    *(GAS_ f32x4*)(F + off + bj * HALF) = acc[ai][bj][m][0]; *(GAS_ f32x4*)(F + off + bj * HALF + 4) = acc[ai][bj][m][1]; } }
    }
};
template <class Epi, class Sched, bool ALIGN_EPI = false, bool SP2 = false>
__device__ __forceinline__ void gemm_phase(PG8_LAS unsigned char* lds, const Gemm g, const Sched& S, const Epi& E) {
    int tid_l = threadIdx.x; asm volatile("" : "+v"(tid_l));
    const int tid = tid_l, wid = __builtin_amdgcn_readfirstlane(tid >> 6), lane = tid & 63, wr = wid >> 2, wc = wid & 3, fr = lane & 15, fq = lane >> 4;
    const int K = g.ld ? g.ld : g.K  , nt = g.K / BK;
    unsigned voffA[2], voffB[2];
#pragma unroll
    for (int i = 0; i < 2; ++i) { int R, C; stage_rc(tid * 16 + i * 8192, R, C); const int Rb = Epi::PERM ? ((R & ~31) + perm32(R & 31)) : R;
        voffA[i] = (unsigned)(R * (g.ablk ? BK : K) + C) * 2u; voffB[i] = (unsigned)(Rb * K + C) * 2u; }
    const size_t kstep = (size_t)(BK * 2);
    const size_t hstep = (size_t)HALF * K * 2;
    const size_t tstep = 2 * hstep;
    const size_t kstepA = g.ablk ? (size_t)BM * BK * 2 : kstep, hstepA = g.ablk ? (size_t)HALF * BK * 2 : hstep;
    const unsigned ldsw = (unsigned)wid * 1024u;
    const int aoff = lds_byte(wr * 64 + fr, fq * 8), boff = lds_byte(wc * 32 + fr, fq * 8);
#define PG8_SA(b, h) (((b) * 2 + (h)) * HTB)
#define PG8_SB(b, h) ((4 + (b) * 2 + (h)) * HTB)
#define PG8_STAGE(bufoff, gbase, voff) do { _Pragma("unroll") for (int _i = 0; _i < 2; ++_i) \
        __builtin_amdgcn_global_load_lds((const unsigned*)((const char*)(gbase) + (voff)[_i]), (PG8_LAS unsigned*)(lds + (bufoff) + ldsw + _i * 8192), 16, 0, 0); } while (0)
#define PG8_LDA(dst, b, h) do { _Pragma("unroll") for (int m = 0; m < 4; ++m) _Pragma("unroll") for (int k = 0; k < 2; ++k) dst[m][k] = *(const PG8_LAS bf16x8*)(lds + PG8_SA(b, h) + aoff + m * 2048 + k * 1024); } while (0)
#define PG8_LDB(dst, b, h) do { _Pragma("unroll") for (int n = 0; n < 2; ++n) _Pragma("unroll") for (int k = 0; k < 2; ++k) dst[n][k] = *(const PG8_LAS bf16x8*)(lds + PG8_SB(b, h) + boff + n * 2048 + k * 1024); } while (0)
#define PG8_MMA(ai, bj, At, Bt) do { __builtin_amdgcn_s_setprio(1); _Pragma("unroll") for (int m = 0; m < 4; ++m) _Pragma("unroll") for (int n = 0; n < 2; ++n) _Pragma("unroll") for (int k = 0; k < 2; ++k) \
        acc[ai][bj][m][n] = __builtin_amdgcn_mfma_f32_16x16x32_bf16(Bt[n][k], At[m][k], acc[ai][bj][m][n], 0, 0, 0); __builtin_amdgcn_s_setprio(0); } while (0)
#define PG8_WAIT_V(n) asm volatile("s_waitcnt vmcnt(" #n ")" ::: "memory")
#define PG8_WAIT_L(n) asm volatile("s_waitcnt lgkmcnt(" #n ")" ::: "memory")
#define PG8_BAR __builtin_amdgcn_s_barrier()
#define PG8_SCHED __builtin_amdgcn_sched_barrier(0)
    Unit cur, nxt; int ui = 0;
    if (!S.next(0, cur)) return;
    f32x4 acc[2][2][4][2];
#pragma unroll
    for (int a = 0; a < 2; ++a)
#pragma unroll
        for (int b = 0; b < 2; ++b)
#pragma unroll
            for (int m = 0; m < 4; ++m)
#pragma unroll
                for (int n = 0; n < 2; ++n) acc[a][b][m][n] = (f32x4){0.f, 0.f, 0.f, 0.f};
    bf16x8 At[4][2], B0[2][2], B1[2][2];
    const char* cA = (const char*)g.A + (size_t)cur.pm * tstep; const char* cB = (const char*)g.Bt + (size_t)cur.pn * tstep;
    S.a_ready(cur);
    if constexpr (SP2) {
        PG8_STAGE(PG8_SB(0, 0), cB, voffB); PG8_STAGE(PG8_SB(0, 1), cB + hstep, voffB); PG8_STAGE(PG8_SA(0, 0), cA, voffA); PG8_STAGE(PG8_SA(0, 1), cA + hstepA, voffA);
        if (wr == 1) PG8_BAR;
        PG8_WAIT_V(2); PG8_BAR;
        PG8_STAGE(PG8_SB(1, 0), cB + kstep, voffB); PG8_STAGE(PG8_SA(1, 0), cA + kstepA, voffA); PG8_STAGE(PG8_SB(1, 1), cB + hstep + kstep, voffB);
        PG8_WAIT_V(6); PG8_BAR;
    } else {
        PG8_STAGE(PG8_SB(0, 0), cB, voffB); PG8_STAGE(PG8_SA(0, 0), cA, voffA); PG8_STAGE(PG8_SB(0, 1), cB + hstep, voffB); PG8_STAGE(PG8_SA(0, 1), cA + hstepA, voffA);
        if (wr == 1) PG8_BAR;
        PG8_WAIT_V(4); PG8_BAR;
        PG8_STAGE(PG8_SB(1, 0), cB + kstep, voffB); PG8_STAGE(PG8_SA(1, 0), cA + kstepA, voffA); PG8_STAGE(PG8_SB(1, 1), cB + hstep + kstep, voffB);
        PG8_WAIT_V(6); PG8_BAR;
    }
    for (;;) {
        const bool has_next = S.next(ui + 1, nxt);
        const char* nA = has_next ? (const char*)g.A + (size_t)nxt.pm * tstep : cA; const char* nB = has_next ? (const char*)g.Bt + (size_t)nxt.pn * tstep : cB;
        for (int t = 0; t < nt; t += 2) {
            const bool last = (t == nt - 2);
            const char* a1 = cA + (size_t)(t + 1) * kstepA;
            const char* a2 = last ? nA : cA + (size_t)(t + 2) * kstepA; const char* b2 = last ? nB : cB + (size_t)(t + 2) * kstep;
            const char* a3 = a2 + kstepA; const char* b3 = b2 + kstep;
            if (last && has_next) S.a_ready(nxt);
            if constexpr (Epi::MIDK) { if (t == nt / 2) E.midk(acc, cur, wr, wc, fr, fq); }
            if constexpr (SP2) {
            PG8_LDB(B0, 0, 0); PG8_LDB(B1, 0, 1); PG8_SCHED; PG8_LDA(At, 0, 0); PG8_STAGE(PG8_SA(1, 1), a1 + hstepA, voffA);
            PG8_WAIT_V(8); PG8_WAIT_L(0); PG8_BAR; PG8_MMA(0, 0, At, B0); PG8_MMA(0, 1, At, B1); PG8_BAR; PG8_SCHED;
            PG8_LDA(At, 0, 1); PG8_STAGE(PG8_SB(0, 0), b2, voffB); PG8_STAGE(PG8_SB(0, 1), b2 + hstep, voffB); PG8_STAGE(PG8_SA(0, 0), a2, voffA);
            PG8_WAIT_V(8); PG8_WAIT_L(0); PG8_BAR; PG8_MMA(1, 0, At, B0); PG8_MMA(1, 1, At, B1); PG8_BAR; PG8_SCHED;
            PG8_LDB(B0, 1, 0); PG8_LDB(B1, 1, 1); PG8_SCHED; PG8_LDA(At, 1, 0); PG8_STAGE(PG8_SA(0, 1), a2 + hstepA, voffA);
            PG8_WAIT_V(8); PG8_WAIT_L(0); PG8_BAR; PG8_MMA(0, 0, At, B0); PG8_MMA(0, 1, At, B1); PG8_BAR; PG8_SCHED;
            PG8_LDA(At, 1, 1); PG8_STAGE(PG8_SB(1, 0), b3, voffB); PG8_STAGE(PG8_SB(1, 1), b3 + hstep, voffB); PG8_STAGE(PG8_SA(1, 0), a3, voffA);
            PG8_WAIT_V(8); PG8_WAIT_L(0); PG8_BAR; PG8_MMA(1, 0, At, B0); PG8_MMA(1, 1, At, B1); PG8_BAR; PG8_SCHED;
            } else {
            PG8_LDB(B0, 0, 0); PG8_SCHED; PG8_LDA(At, 0, 0); PG8_STAGE(PG8_SA(1, 1), a1 + hstepA, voffA);
            PG8_WAIT_L(8); PG8_BAR; PG8_WAIT_L(0); PG8_MMA(0, 0, At, B0); PG8_BAR; PG8_SCHED;
            PG8_LDB(B1, 0, 1); PG8_STAGE(PG8_SB(0, 0), b2, voffB);
            PG8_BAR; PG8_WAIT_L(0); PG8_MMA(0, 1, At, B1); PG8_BAR;
            PG8_LDA(At, 0, 1); PG8_STAGE(PG8_SA(0, 0), a2, voffA);
            PG8_BAR; PG8_WAIT_L(0); PG8_MMA(1, 0, At, B0); PG8_BAR; PG8_SCHED;
            PG8_STAGE(PG8_SB(0, 1), b2 + hstep, voffB);
            PG8_WAIT_V(6); PG8_BAR; PG8_MMA(1, 1, At, B1); PG8_BAR;
            PG8_LDB(B0, 1, 0); PG8_SCHED; PG8_LDA(At, 1, 0); PG8_STAGE(PG8_SA(0, 1), a2 + hstepA, voffA);
            PG8_WAIT_L(8); PG8_BAR; PG8_WAIT_L(0); PG8_MMA(0, 0, At, B0); PG8_BAR; PG8_SCHED;
            PG8_LDB(B1, 1, 1); PG8_STAGE(PG8_SB(1, 0), b3, voffB);
            PG8_BAR; PG8_WAIT_L(0); PG8_MMA(0, 1, At, B1); PG8_BAR;
            PG8_LDA(At, 1, 1); PG8_STAGE(PG8_SA(1, 0), a3, voffA);
            PG8_BAR; PG8_WAIT_L(0); PG8_MMA(1, 0, At, B0); PG8_BAR; PG8_SCHED;
            PG8_STAGE(PG8_SB(1, 1), b3 + hstep, voffB);
            PG8_WAIT_V(6); PG8_BAR; PG8_MMA(1, 1, At, B1); PG8_BAR;
            }
        }
        if constexpr (ALIGN_EPI) { if (wr == 0) PG8_BAR; }
        if constexpr (!Epi::AFTER_DRAIN) { E(acc, cur, wr, wc, fr, fq); S.done(cur); }
        if (!has_next) break;
#pragma unroll
        for (int a = 0; a < 2; ++a)
#pragma unroll
            for (int b = 0; b < 2; ++b)
#pragma unroll
                for (int m = 0; m < 4; ++m)
#pragma unroll
                    for (int n = 0; n < 2; ++n) acc[a][b][m][n] = (f32x4){0.f, 0.f, 0.f, 0.f};
        cur = nxt; cA = nA; cB = nB; ++ui;
        if constexpr (ALIGN_EPI) { if (wr == 1) PG8_BAR; }
    }
    PG8_WAIT_V(0);
    if constexpr (!ALIGN_EPI) { if (wr == 0) PG8_BAR; }
    PG8_BAR;
    if constexpr (Epi::AFTER_DRAIN) { E.fused(acc, cur, wr, wc, fr, fq, lds, wid, lane); S.done(cur); }
#undef PG8_SA
#undef PG8_SB
#undef PG8_STAGE
#undef PG8_LDA
#undef PG8_LDB
#undef PG8_MMA
#undef PG8_WAIT_V
#undef PG8_WAIT_L
#undef PG8_BAR
#undef PG8_SCHED
}
}

namespace att {
typedef unsigned short bf16;
using bf16x8 = __attribute__((ext_vector_type(8))) short;
using s16x4  = __attribute__((ext_vector_type(4))) short;
using f32x16 = __attribute__((ext_vector_type(16))) float;
using u32x4  = __attribute__((ext_vector_type(4))) unsigned;
constexpr int NW = 8, QBLK = 32, KVBLK = 64, DV = 128;
constexpr float THR = 8.f;
constexpr int LDS_V = 0, LDS_K = 65536, LDS_WS = 114688, LDS_LUT = 114688 + 2048, LDS_OSTAGE = 0, LDS_ATT_BYTES = LDS_LUT + 320 * 4;
#define ATT_SBAR() __builtin_amdgcn_sched_barrier(0)
#define ATT_GCP const __attribute__((address_space(1))) char*
#define ATT_GVP const __attribute__((address_space(1))) bf16x8*
__device__ __forceinline__ int crow(int r, int hi) { return (r & 3) + 8 * (r >> 2) + 4 * hi; }
__device__ __forceinline__ unsigned cvtpk(float lo, float hi) { unsigned r; asm volatile("v_cvt_pk_bf16_f32 %0, %1, %2" : "=v"(r) : "v"(lo), "v"(hi)); return r; }
template <int DQK> __device__ __forceinline__ int kswz(int row, int colB) { return row * (DQK * 2) + (colB ^ ((row & 7) << 4)); }

__device__ __forceinline__ int v_st(int k, int c) { const int kk = (k & ~0xC) | ((k & 4) << 1) | ((k & 8) >> 1); return ((kk >> 3) * 4 + (c >> 5)) * 512 + ((kk & 7) * 32 + (c & 31)) * 2; }
__device__ __forceinline__ int v_rd_base(int lane) { return ((lane & 3) << 3) | (((lane >> 2) & 3) << 6) | (((lane >> 4) & 1) << 5) | (((lane >> 5) & 1) << 8); }
constexpr int v_rd_off(int d0, int ks, int half) { return d0 * 512 + ks * 4096 + half * 2048; }
template <int OFF> __device__ __forceinline__ s16x4 tr_read(int vb) { s16x4 r; asm volatile("ds_read_b64_tr_b16 %0, %1 offset:%2" : "=&v"(r) : "v"(vb), "i"(OFF) : "memory"); return r; }
template <int KS> __device__ __forceinline__ void pv_ks(f32x16* o, int vb, bf16x8 pa) {
  const s16x4 l0 = tr_read<v_rd_off(0, KS, 0)>(vb), h0 = tr_read<v_rd_off(0, KS, 1)>(vb), l1 = tr_read<v_rd_off(1, KS, 0)>(vb), h1 = tr_read<v_rd_off(1, KS, 1)>(vb);
  const s16x4 l2 = tr_read<v_rd_off(2, KS, 0)>(vb), h2 = tr_read<v_rd_off(2, KS, 1)>(vb), l3 = tr_read<v_rd_off(3, KS, 0)>(vb), h3 = tr_read<v_rd_off(3, KS, 1)>(vb);
  asm volatile("s_waitcnt lgkmcnt(0)" ::: "memory"); ATT_SBAR();
#define ATT_PK(L, H) (bf16x8){L[0], L[1], L[2], L[3], H[0], H[1], H[2], H[3]}
  o[0] = __builtin_amdgcn_mfma_f32_32x32x16_bf16(pa, ATT_PK(l0, h0), o[0], 0, 0, 0);
  o[1] = __builtin_amdgcn_mfma_f32_32x32x16_bf16(pa, ATT_PK(l1, h1), o[1], 0, 0, 0);
  o[2] = __builtin_amdgcn_mfma_f32_32x32x16_bf16(pa, ATT_PK(l2, h2), o[2], 0, 0, 0);
  o[3] = __builtin_amdgcn_mfma_f32_32x32x16_bf16(pa, ATT_PK(l3, h3), o[3], 0, 0, 0);
#undef ATT_PK
}
template <int KS> __device__ __forceinline__ void pv_ks_t(f32x16* o, int vb, bf16x8 pb) {
  const s16x4 l0 = tr_read<v_rd_off(0, KS, 0)>(vb), h0 = tr_read<v_rd_off(0, KS, 1)>(vb), l1 = tr_read<v_rd_off(1, KS, 0)>(vb), h1 = tr_read<v_rd_off(1, KS, 1)>(vb);
  const s16x4 l2 = tr_read<v_rd_off(2, KS, 0)>(vb), h2 = tr_read<v_rd_off(2, KS, 1)>(vb), l3 = tr_read<v_rd_off(3, KS, 0)>(vb), h3 = tr_read<v_rd_off(3, KS, 1)>(vb);
  asm volatile("s_waitcnt lgkmcnt(0)" ::: "memory"); ATT_SBAR();
#define ATT_PK(L, H) (bf16x8){L[0], L[1], L[2], L[3], H[0], H[1], H[2], H[3]}
  o[0] = __builtin_amdgcn_mfma_f32_32x32x16_bf16(ATT_PK(l0, h0), pb, o[0], 0, 0, 0);
  o[1] = __builtin_amdgcn_mfma_f32_32x32x16_bf16(ATT_PK(l1, h1), pb, o[1], 0, 0, 0);
  o[2] = __builtin_amdgcn_mfma_f32_32x32x16_bf16(ATT_PK(l2, h2), pb, o[2], 0, 0, 0);
  o[3] = __builtin_amdgcn_mfma_f32_32x32x16_bf16(ATT_PK(l3, h3), pb, o[3], 0, 0, 0);
#undef ATT_PK
}
__device__ __forceinline__ void pv_all_t(f32x16* o, int vb, bf16x8 pb0, bf16x8 pb1, bf16x8 pb2, bf16x8 pb3) {
  pv_ks_t<0>(o, vb, pb0); pv_ks_t<1>(o, vb, pb1); pv_ks_t<2>(o, vb, pb2); pv_ks_t<3>(o, vb, pb3);
}
__device__ __forceinline__ void pv_all(f32x16* o, int vb, bf16x8 pa0, bf16x8 pa1, bf16x8 pa2, bf16x8 pa3) {
  pv_ks<0>(o, vb, pa0); pv_ks<1>(o, vb, pa1); pv_ks<2>(o, vb, pa2); pv_ks<3>(o, vb, pa3);
}
template <int DQK> __device__ __forceinline__ void qkt(f32x16& p0, f32x16& p1, const char* Ks, const bf16x8* qr, int r32, int hi, const f32x16& c0) {
  p0 = c0; p1 = c0;
#pragma unroll
  for (int d0 = 0; d0 < DQK / 16; ++d0) { const int cb = (d0 * 16 + hi * 8) * 2;
    const bf16x8 b0 = *reinterpret_cast<const bf16x8*>(Ks + kswz<DQK>(r32, cb));
    const bf16x8 b1 = *reinterpret_cast<const bf16x8*>(Ks + kswz<DQK>(32 + r32, cb));
    p0 = __builtin_amdgcn_mfma_f32_32x32x16_bf16(b0, qr[d0], p0, 0, 0, 0);
    p1 = __builtin_amdgcn_mfma_f32_32x32x16_bf16(b1, qr[d0], p1, 0, 0, 0); }
}
template <bool BIAS> __device__ __forceinline__ float bias_mask(f32x16& p0, f32x16& p1, bool valid, bool far, float cfar, const float* lut, int relb, int hi) {
  if (__builtin_expect(__builtin_amdgcn_readfirstlane((int)!valid) != 0, 0)) {
#pragma unroll
    for (int r = 0; r < 16; ++r) { p0[r] = -INFINITY; p1[r] = -INFINITY; }
    asm volatile("" : "+v"(p0), "+v"(p1));
    return 0.f;
  }
  if (BIAS) {
    if (far) return cfar;
    int rb = relb + 4 * hi; asm volatile("" : "+v"(rb));
#pragma unroll
    for (int r = 0; r < 16; ++r) { const int i0 = rb + (r & 3) + 8 * (r >> 2);
      p0[r] += lut[min(max(i0, 0), 319)]; p1[r] += lut[min(max(i0 + 32, 0), 319)];
      if ((r & 3) == 3) asm volatile("" ::: "memory"); }
  }
  return 0.f;
}
__device__ __forceinline__ void partialSM(f32x16& p0, f32x16& p1, float badd, float& m_reg, float& alpha) {
  float pmax = p0[0];
#pragma unroll
  for (int r = 1; r < 16; ++r) pmax = fmaxf(pmax, p0[r]);
#pragma unroll
  for (int r = 0; r < 16; ++r) pmax = fmaxf(pmax, p1[r]);
  { auto rr = __builtin_amdgcn_permlane32_swap(__float_as_uint(pmax), __float_as_uint(pmax), false, false);
    pmax = fmaxf(__uint_as_float(rr[0]), __uint_as_float(rr[1])); }
  pmax += badd;
  float mn;
  if (__builtin_expect(__all(pmax - m_reg <= THR), 1)) { mn = m_reg; alpha = 1.f; }
  else { mn = fmaxf(m_reg, pmax); alpha = __builtin_amdgcn_exp2f(m_reg - mn); m_reg = mn; }
  const float sub = mn - badd;
  p0 = p0 - sub; p1 = p1 - sub;
#pragma unroll
  for (int r = 0; r < 16; ++r) p0[r] = __builtin_amdgcn_exp2f(p0[r]);
}
#define ATT_MX3(a, b, c) __builtin_fmaxf(__builtin_fmaxf((a), (b)), (c))
__device__ __forceinline__ float rowmax32(const f32x16& p0, const f32x16& p1) {
  float a = ATT_MX3(p0[0], p0[1], p1[0]), b = ATT_MX3(p0[2], p0[3], p1[1]); a = ATT_MX3(a, p1[2], p1[3]);
#pragma unroll
  for (int r = 4; r < 16; r += 4) { a = ATT_MX3(a, p0[r], p0[r + 1]); b = ATT_MX3(b, p0[r + 2], p0[r + 3]); a = ATT_MX3(a, p1[r], p1[r + 1]); b = ATT_MX3(b, p1[r + 2], p1[r + 3]); }
  float m = __builtin_fmaxf(a, b);
  auto rr = __builtin_amdgcn_permlane32_swap(__float_as_uint(m), __float_as_uint(m), false, false);
  return __builtin_fmaxf(__uint_as_float(rr[0]), __uint_as_float(rr[1]));
}
template <bool FIRST> __device__ __forceinline__ void partialSM_negc(f32x16& p0, f32x16& p1, float& m_reg, float& alpha) {
  const float pmax = rowmax32(p0, p1);
  alpha = 1.f;
  if (FIRST) { const float dl = pmax > -INFINITY ? pmax : 0.f; m_reg += dl; p0 = p0 - dl; p1 = p1 - dl; }
  else if (!__builtin_expect(__all(pmax <= THR), 1)) { const float dl = __builtin_fmaxf(pmax, 0.f); alpha = __builtin_amdgcn_exp2f(-dl); m_reg += dl; p0 = p0 - dl; p1 = p1 - dl; }
#pragma unroll
  for (int r = 0; r < 16; ++r) p0[r] = __builtin_amdgcn_exp2f(p0[r]);
}
__device__ __forceinline__ void finishSM(f32x16& p0, f32x16& p1, float alpha, float& l_reg, bf16x8& pa0, bf16x8& pa1, bf16x8& pa2, bf16x8& pa3) {
#pragma unroll
  for (int r = 0; r < 16; ++r) p1[r] = __builtin_amdgcn_exp2f(p1[r]);
  float ps = 0;
#pragma unroll
  for (int r = 0; r < 16; ++r) ps += p0[r];
#pragma unroll
  for (int r = 0; r < 16; ++r) ps += p1[r];
  { auto rr = __builtin_amdgcn_permlane32_swap(__float_as_uint(ps), __float_as_uint(ps), false, false);
    ps = __uint_as_float(rr[0]) + __uint_as_float(rr[1]); }
  l_reg = l_reg * alpha + ps;
#define ATT_PK4(P, BASE, OUT) do { unsigned a0 = cvtpk(P[BASE + 0], P[BASE + 1]), a1 = cvtpk(P[BASE + 2], P[BASE + 3]);   \
    unsigned b0 = cvtpk(P[BASE + 4], P[BASE + 5]), b1 = cvtpk(P[BASE + 6], P[BASE + 7]);                              \
    auto r0 = __builtin_amdgcn_permlane32_swap(a0, b0, false, false); auto r1 = __builtin_amdgcn_permlane32_swap(a1, b1, false, false); \
    u32x4 w = {r0[0], r1[0], r0[1], r1[1]}; OUT = *reinterpret_cast<bf16x8*>(&w); } while (0)
  ATT_PK4(p0, 0, pa0); ATT_PK4(p0, 8, pa1); ATT_PK4(p1, 0, pa2); ATT_PK4(p1, 8, pa3);
#undef ATT_PK4
}

__device__ __forceinline__ void glds16(const void* gsrc, unsigned lds_dst) { unsigned keep;
  asm volatile("s_mov_b32 %0, m0\n\ts_mov_b32 m0, %2\n\ts_nop 0\n\tglobal_load_lds_dwordx4 %1, off\n\ts_mov_b32 m0, %0" : "=&s"(keep) : "v"(gsrc), "s"(lds_dst) : "memory"); }
__device__ __forceinline__ void glds16s(const void* sbase, unsigned voff, unsigned lds_dst) { unsigned keep;
  asm volatile("s_mov_b32 %0, m0\n\ts_mov_b32 m0, %3\n\ts_nop 0\n\tglobal_load_lds_dwordx4 %1, %2\n\ts_mov_b32 m0, %0" : "=&s"(keep) : "v"(voff), "s"(sbase), "s"(lds_dst) : "memory"); }
struct TileArgs {
  const bf16* Qw; int ldq;
  const bf16* Kh; int ldk;
  const bf16* Vh; int ldv;
  int t0, NT, tmax;
  int wlo, whi;
  int relw;
  int abl;
};

template <int DQK, bool BIAS, int SD, bool SKIPW = false>
__device__ __forceinline__ void attn_tiles(const TileArgs& A, const float* lut, char* lds, f32x16 (&o)[4], float& l_out) {
  int tid_l = threadIdx.x; asm volatile("" : "+v"(tid_l));
  const int tid = tid_l, wid = tid >> 6, lane = tid & 63, r32 = lane & 31, hi = lane >> 5;
  char* V_lds = lds + LDS_V; char* K_lds = lds + LDS_K;
  constexpr int SHM_V = KVBLK * DV * 2, SHM_K = KVBLK * DQK * 2;
  float* ws = (float*)(lds + LDS_WS) + wid * 64; float* al_l = ws + 32;
  float m_reg = -1e30f, l_reg = 0.f; o[0] = f32x16{}; o[1] = f32x16{}; o[2] = f32x16{}; o[3] = f32x16{};
  bf16x8 qr[DQK / 16];
  { ATT_GCP Qp = (ATT_GCP)A.Qw + (unsigned)((r32 * A.ldq + hi * 8) * 2);
#pragma unroll
    for (int d0 = 0; d0 < DQK / 16; ++d0) qr[d0] = *(ATT_GVP)(Qp + d0 * 32); }
  const int vb0 = (int)(uintptr_t)V_lds + v_rd_base(lane);
  const float cfar = BIAS ? lut[0] : 0.f;
  const int ldk = A.ldk, ldv = A.ldv; const bf16* Kh = A.Kh; const bf16* Vh = A.Vh; const int t0 = A.t0, tmax = A.tmax;
  unsigned voV, voK;
  { const int sst = 2 * wid + (lane >> 5), kk = 8 * (sst >> 2) + ((lane & 31) >> 2), kq = (DQK == 64) ? kk : ((kk & ~0xC) | ((kk & 4) << 1) | ((kk & 8) >> 1));
    voV = (unsigned)(kq * ldv + 32 * (sst & 3) + 8 * (lane & 3)) * 2u; }
  if (DQK == 64) { const int row = 8 * wid + (lane >> 3), ch = (lane & 7) ^ (row & 7); voK = (unsigned)(row * ldk + 8 * ch) * 2u; }
  else { const int row = 4 * wid + (lane >> 4), ch = (lane & 15) ^ (row & 7); voK = (unsigned)(row * ldk + 8 * ch) * 2u; }
  const unsigned ldsV = (unsigned)(uintptr_t)V_lds + (unsigned)wid * 1024u, ldsK = (unsigned)(uintptr_t)K_lds + (unsigned)wid * 1024u;
  constexpr int NDMA = (DQK == 64) ? 3 : 4;
#define ATT_DMA(j) do { const int tl_ = min(t0 + (j), tmax); const char* vt_ = (const char*)Vh + (size_t)tl_ * (KVBLK * 2) * ldv; const char* kt_ = (const char*)Kh + (size_t)tl_ * (KVBLK * 2) * ldk;   \
    const unsigned dv_ = (unsigned)__builtin_amdgcn_readfirstlane(ldsV + (unsigned)(((j) & 3) * SHM_V)), dk_ = (unsigned)__builtin_amdgcn_readfirstlane(ldsK + (unsigned)(((j) % 3) * SHM_K));   \
    if (DQK == 64) { glds16s(vt_, voV, dv_); glds16s(vt_ + (size_t)64 * ldv, voV, dv_ + 8192u); glds16s(kt_, voK, dk_); }       \
    else { glds16(vt_ + voV, dv_); glds16(vt_ + (size_t)64 * ldv + voV, dv_ + 8192u); glds16(kt_ + voK, dk_); glds16(kt_ + (size_t)64 * ldk + voK, dk_ + 8192u); } } while (0)
#define ATT_WAITBAR(j) do { if ((j) + 2 < NT) { if (DQK == 64) asm volatile("s_waitcnt vmcnt(3) lgkmcnt(0)\n\ts_barrier" ::: "memory"); else asm volatile("s_waitcnt vmcnt(4) lgkmcnt(0)\n\ts_barrier" ::: "memory"); }   \
    else asm volatile("s_waitcnt vmcnt(0) lgkmcnt(0)\n\ts_barrier" ::: "memory"); } while (0)
#define ATT_RESC(a) do { if (__any((a) != 1.f)) { if (hi == 0) al_l[r32] = (a); asm volatile("s_waitcnt lgkmcnt(0)" ::: "memory"); \
    _Pragma("unroll") for (int d = 0; d < 4; ++d) _Pragma("unroll") for (int r = 0; r < 16; ++r) o[d][r] *= al_l[crow(r, hi)]; } } while (0)
#define ATT_BM(P0, P1, j, BADD) do { const int t_ = t0 + (j); const bool valid_ = (t_ >= A.wlo) && (t_ <= A.whi); const int rk_ = A.relw + t_ * KVBLK;   \
    BADD = bias_mask<BIAS>(P0, P1, valid_, (rk_ + 63 <= -128), NEGC ? 0.f : cfar, lut, rk_ - r32 + 256, hi); } while (0)
#define ATT_PRE(j) do { if constexpr (NEGC) { const int rk_ = A.relw + (t0 + (j)) * KVBLK; const float cf_ = ((BIAS && (rk_ + 63 <= -128)) ? cfar : 0.f) - m_reg;   \
    if (__any(cf_ != ccur)) { ccur = cf_; _Pragma("unroll") for (int r = 0; r < 16; ++r) negc[r] = cf_; asm volatile("" : "+v"(negc)); } } } while (0)
#define ATT_PSM(P0, P1, AL) do { if constexpr (NEGC) partialSM_negc<false>(P0, P1, m_reg, AL); else partialSM(P0, P1, badd, m_reg, AL); } while (0)
#define ATT_VALID(j) ((!SKIPW || act) && (__builtin_amdgcn_readfirstlane((int)(((t0 + (j)) >= A.wlo) && ((t0 + (j)) <= A.whi))) != 0))
#define ATT_STEP(PC0, PC1, ALC, PP0, PP1, ALP, j) do {                                                                \
    if ((j) + 2 < NT && !(abl & 1)) ATT_DMA((j) + 2);                                                                 \
    const bool cv_ = ATT_VALID(j), pv_ = ATT_VALID((j) - 1);                                                          \
    if (cv_) { ATT_PRE(j); ATT_SBAR(); qkt<DQK>(PC0, PC1, K_lds + ((j) % 3) * SHM_K, qr, r32, hi, negc); }            \
    if (pv_) { finishSM(PP0, PP1, ALP, l_reg, pa0, pa1, pa2, pa3); ATT_SBAR(); pv_all(o, vb0 + (((j) + 3) & 3) * SHM_V, pa0, pa1, pa2, pa3); }   \
    if (cv_) { ATT_BM(PC0, PC1, j, badd); ATT_PSM(PC0, PC1, ALC); ATT_RESC(ALC); }                                    \
    ATT_WAITBAR(j); } while (0)
#define ATT_PIN(x) asm volatile("" : "+v"(x))
#define ATT_KLD(D0, B0, B1) do { const int cb_ = ((D0) * 16 + hi * 8) * 2; B0 = *reinterpret_cast<const bf16x8*>(kb_ + kswz<64>(r32, cb_)); B1 = *reinterpret_cast<const bf16x8*>(kb_ + kswz<64>(32 + r32, cb_)); } while (0)
#define ATT_PKT(P, BASE, OUT) do { u32x4 w_ = {cvtpk(P[BASE + 0], P[BASE + 1]), cvtpk(P[BASE + 2], P[BASE + 3]), cvtpk(P[BASE + 4], P[BASE + 5]), cvtpk(P[BASE + 6], P[BASE + 7])}; OUT = *reinterpret_cast<bf16x8*>(&w_); } while (0)
#define ATT_G1(D0, PC0, PC1, PP, PB, PAK, CB0, CB1, NB0, NB1) do { if ((D0) < 3) ATT_KLD((D0) + 1, NB0, NB1);          \
    PC0 = __builtin_amdgcn_mfma_f32_32x32x16_bf16(CB0, qr[D0], (D0) == 0 ? negc : PC0, 0, 0, 0);                         \
    sacc_ += PP[PB + 0]; sacc_ += PP[PB + 1]; sacc_ += PP[PB + 2]; sacc_ += PP[PB + 3]; ATT_PIN(sacc_);                 \
    const unsigned a0_ = cvtpk(PP[PB + 0], PP[PB + 1]), a1_ = cvtpk(PP[PB + 2], PP[PB + 3]); ATT_SBAR();                \
    PC1 = __builtin_amdgcn_mfma_f32_32x32x16_bf16(CB1, qr[D0], (D0) == 0 ? negc : PC1, 0, 0, 0);                         \
    sacc_ += PP[PB + 4]; sacc_ += PP[PB + 5]; sacc_ += PP[PB + 6]; sacc_ += PP[PB + 7]; ATT_PIN(sacc_);                 \
    const unsigned b0c_ = cvtpk(PP[PB + 4], PP[PB + 5]), b1c_ = cvtpk(PP[PB + 6], PP[PB + 7]);                          \
    u32x4 w_ = {a0_, a1_, b0c_, b1c_}; PAK = *reinterpret_cast<bf16x8*>(&w_); ATT_SBAR(); } while (0)
#define ATT_TRIG(PP0, PP1, PC0, PC1, HAVE_CUR) do { if (!__builtin_expect(__all(sacc_ <= 16384.f), 1)) {                                        \
      float full_; { auto rr_ = __builtin_amdgcn_permlane32_swap(__float_as_uint(sacc_), __float_as_uint(sacc_), false, false); full_ = __uint_as_float(rr_[0]) + __uint_as_float(rr_[1]); }   \
      const bool big_ = full_ > 16384.f;                                      \
      const float al_ = big_ ? __builtin_amdgcn_rcpf(full_) : 1.f, dl_ = big_ ? __builtin_amdgcn_logf(full_) : 0.f;                            \
      PP0 = PP0 * al_; PP1 = PP1 * al_; sacc_ *= al_; l_reg *= al_; m_reg += dl_;                                                              \
      _Pragma("unroll") for (int d_ = 0; d_ < 4; ++d_) o[d_] = o[d_] * al_;                                                                     \
      if (HAVE_CUR) { PC0 = PC0 - dl_; PC1 = PC1 - dl_; }                                                                                      \
      ATT_PKT(PP0, 0, pa0); ATT_PKT(PP0, 8, pa1); ATT_PKT(PP1, 0, pa2); ATT_PKT(PP1, 8, pa3); } } while (0)
#define ATT_B1(PC0, PC1, PP0, PP1, j) do { const char* kb_ = K_lds + ((j) % 3) * SHM_K; float sacc_ = 0.f; bf16x8 ke0_, ke1_, ko0_, ko1_;   \
    ATT_KLD(0, ke0_, ke1_); ATT_SBAR();                                                                                 \
    ATT_G1(0, PC0, PC1, PP0, 0, pa0, ke0_, ke1_, ko0_, ko1_); ATT_G1(1, PC0, PC1, PP0, 8, pa1, ko0_, ko1_, ke0_, ke1_); \
    ATT_G1(2, PC0, PC1, PP1, 0, pa2, ke0_, ke1_, ko0_, ko1_); ATT_G1(3, PC0, PC1, PP1, 8, pa3, ko0_, ko1_, ke0_, ke1_); \
    ATT_TRIG(PP0, PP1, PC0, PC1, true); l_reg += sacc_; } while (0)
#define ATT_PKV(L, H) (bf16x8){L[0], L[1], L[2], L[3], H[0], H[1], H[2], H[3]}
#define ATT_EX2(X, B) do { X[B] = __builtin_amdgcn_exp2f(X[B]); X[(B) + 1] = __builtin_amdgcn_exp2f(X[(B) + 1]); ATT_PIN(X); ATT_SBAR(); } while (0)
#define ATT_VRD(KS, S) do { S##l0 = tr_read<v_rd_off(0, KS, 0)>(vb_); S##h0 = tr_read<v_rd_off(0, KS, 1)>(vb_); S##l1 = tr_read<v_rd_off(1, KS, 0)>(vb_); S##h1 = tr_read<v_rd_off(1, KS, 1)>(vb_);   \
    S##l2 = tr_read<v_rd_off(2, KS, 0)>(vb_); S##h2 = tr_read<v_rd_off(2, KS, 1)>(vb_); S##l3 = tr_read<v_rd_off(3, KS, 0)>(vb_); S##h3 = tr_read<v_rd_off(3, KS, 1)>(vb_); } while (0)
#define ATT_VMF(S, PAK, X, XB) do {                                                                                     \
    o[0] = __builtin_amdgcn_mfma_f32_32x32x16_bf16(ATT_PKV(S##l0, S##h0), PAK, o[0], 0, 0, 0); ATT_EX2(X, XB);          \
    o[1] = __builtin_amdgcn_mfma_f32_32x32x16_bf16(ATT_PKV(S##l1, S##h1), PAK, o[1], 0, 0, 0); ATT_EX2(X, (XB) + 2);    \
    o[2] = __builtin_amdgcn_mfma_f32_32x32x16_bf16(ATT_PKV(S##l2, S##h2), PAK, o[2], 0, 0, 0); ATT_EX2(X, (XB) + 4);    \
    o[3] = __builtin_amdgcn_mfma_f32_32x32x16_bf16(ATT_PKV(S##l3, S##h3), PAK, o[3], 0, 0, 0); ATT_EX2(X, (XB) + 6); } while (0)
#define ATT_LW8() do { asm volatile("s_waitcnt lgkmcnt(8)" ::: "memory"); ATT_SBAR(); } while (0)
#define ATT_LW0() do { asm volatile("s_waitcnt lgkmcnt(0)" ::: "memory"); ATT_SBAR(); } while (0)
#define ATT_B2(PC0, PC1, j) do { const int vb_ = vb0 + (((j) + 3) & 3) * SHM_V;                                         \
    s16x4 fa_l0, fa_h0, fa_l1, fa_h1, fa_l2, fa_h2, fa_l3, fa_h3, fb_l0, fb_h0, fb_l1, fb_h1, fb_l2, fb_h2, fb_l3, fb_h3;   \
    ATT_VRD(0, fa_); ATT_VRD(1, fb_); ATT_LW8(); ATT_VMF(fa_, pa0, PC0, 0);                                             \
    ATT_VRD(2, fa_); ATT_LW8(); ATT_VMF(fb_, pa1, PC0, 8);                                                              \
    ATT_VRD(3, fb_); ATT_LW8(); ATT_VMF(fa_, pa2, PC1, 0);                                                              \
    ATT_LW0(); ATT_VMF(fb_, pa3, PC1, 8); } while (0)
#define ATT_ISTEP(PC0, PC1, PP0, PP1, j) do {                                                                           \
    if ((j) + 2 < NT) ATT_DMA((j) + 2);                                                                                 \
    if (!SKIPW || act) {                                                                                                \
      ATT_PRE(j); ATT_SBAR(); ATT_B1(PC0, PC1, PP0, PP1, j);                                                            \
      ATT_BM(PC0, PC1, j, badd); ATT_SBAR();                                                                            \
      ATT_B2(PC0, PC1, j); }                                                                                            \
    ATT_WAITBAR(j); } while (0)
  f32x16 pA0 = f32x16{}, pA1 = f32x16{}, pB0 = f32x16{}, pB1 = f32x16{}; float alA = 1.f, alB = 1.f; bf16x8 pa0 = bf16x8{}, pa1 = bf16x8{}, pa2 = bf16x8{}, pa3 = bf16x8{}; const int NT = A.NT; const int abl = A.abl;
  const bool act = !SKIPW || (__builtin_amdgcn_readfirstlane(wid) < 2);
  float badd; constexpr bool NEGC = (DQK == 64);
  asm volatile("s_waitcnt vmcnt(0) lgkmcnt(0)\n\ts_barrier" ::: "memory");
  ATT_DMA(0); ATT_DMA(1);
  if (wid >= 4) __builtin_amdgcn_s_setprio(1);
  f32x16 negc = f32x16{}; float ccur = 0.f;
  if constexpr (NEGC) { m_reg = 0.f; float z_ = 0.f; asm volatile("" : "+v"(z_));
#pragma unroll
    for (int r = 0; r < 16; ++r) negc[r] = z_;
    asm volatile("" : "+v"(negc)); }
  asm volatile("s_waitcnt vmcnt(0)\n\ts_barrier" ::: "memory");
  if (2 < NT) ATT_DMA(2);
  if (!SKIPW || act) { ATT_PRE(0); qkt<DQK>(pA0, pA1, K_lds, qr, r32, hi, negc); ATT_BM(pA0, pA1, 0, badd); }
  if constexpr (NEGC) {
    if (!SKIPW || act) {
      partialSM_negc<true>(pA0, pA1, m_reg, alA);
#pragma unroll
      for (int r = 0; r < 16; ++r) pA1[r] = __builtin_amdgcn_exp2f(pA1[r]);
    }
    ATT_WAITBAR(0);
    for (int j = 1; j + 1 < NT; j += 2) {
      ATT_ISTEP(pB0, pB1, pA0, pA1, j);
      ATT_ISTEP(pA0, pA1, pB0, pB1, j + 1);
    }
    ATT_ISTEP(pB0, pB1, pA0, pA1, NT - 1);
    if (!SKIPW || act) { float sacc_ = 0.f;
#pragma unroll
      for (int r = 0; r < 16; ++r) sacc_ += pB0[r];
#pragma unroll
      for (int r = 0; r < 16; ++r) sacc_ += pB1[r];
      ATT_PKT(pB0, 0, pa0); ATT_PKT(pB0, 8, pa1); ATT_PKT(pB1, 0, pa2); ATT_PKT(pB1, 8, pa3);
      ATT_TRIG(pB0, pB1, pA0, pA1, false); l_reg += sacc_;
    }
    ATT_SBAR();
    if (!SKIPW || act) pv_all_t(o, vb0 + ((NT - 1) & 3) * SHM_V, pa0, pa1, pa2, pa3);
  } else {
    if (ATT_VALID(0)) partialSM(pA0, pA1, badd, m_reg, alA);
    ATT_WAITBAR(0);
    for (int j = 1; j + 1 < NT; j += 2) {
      ATT_STEP(pB0, pB1, alB, pA0, pA1, alA, j);
      ATT_STEP(pA0, pA1, alA, pB0, pB1, alB, j + 1);
    }
    ATT_STEP(pB0, pB1, alB, pA0, pA1, alA, NT - 1);
    if (ATT_VALID(NT - 1)) { finishSM(pB0, pB1, alB, l_reg, pa0, pa1, pa2, pa3); ATT_SBAR();
      pv_all(o, vb0 + ((NT - 1) & 3) * SHM_V, pa0, pa1, pa2, pa3); }
  }
  __builtin_amdgcn_s_setprio(0);
  l_out = l_reg;
#undef ATT_DMA
#undef ATT_WAITBAR
#undef ATT_RESC
#undef ATT_BM
#undef ATT_STEP
#undef ATT_VALID
#undef ATT_PIN
#undef ATT_KLD
#undef ATT_G1
#undef ATT_B1
#undef ATT_PKV
#undef ATT_EX2
#undef ATT_VRD
#undef ATT_VMF
#undef ATT_LW8
#undef ATT_LW0
#undef ATT_B2
#undef ATT_PKT
#undef ATT_TRIG
#undef ATT_ISTEP
#undef ATT_PRE
#undef ATT_PSM
}
__device__ __forceinline__ void attn_normalize_t(f32x16 (&o)[4], float l_part) {
  auto rr = __builtin_amdgcn_permlane32_swap(__float_as_uint(l_part), __float_as_uint(l_part), false, false);
  const float rl = __builtin_amdgcn_rcpf(__uint_as_float(rr[0]) + __uint_as_float(rr[1]));
#pragma unroll
  for (int d = 0; d < 4; ++d) o[d] = o[d] * rl;
}
__device__ __forceinline__ void attn_normalize(f32x16 (&o)[4], float l_reg, char* lds) {
  int tid_l = threadIdx.x; asm volatile("" : "+v"(tid_l));
  const int tid = tid_l, wid = tid >> 6, lane = tid & 63, r32 = lane & 31, hi = lane >> 5;
  float* li_l = (float*)(lds + LDS_WS) + wid * 64;
  if (hi == 0) li_l[r32] = l_reg; asm volatile("s_waitcnt lgkmcnt(0)" ::: "memory");
#pragma unroll
  for (int r = 0; r < 16; ++r) { const float rl = __builtin_amdgcn_rcpf(li_l[crow(r, hi)]);
#pragma unroll
    for (int d = 0; d < 4; ++d) o[d][r] *= rl; }
  asm volatile("s_waitcnt lgkmcnt(0)" ::: "memory");
}
#undef ATT_SBAR
#undef ATT_GCP
#undef ATT_GVP
}
#define GAS __attribute__((address_space(1)))
#define LAS __attribute__((address_space(3)))
typedef unsigned short bf16;
typedef unsigned v4u __attribute__((ext_vector_type(4)));
typedef float f32x4 __attribute__((ext_vector_type(4)));
typedef short bf16x8 __attribute__((ext_vector_type(8)));
typedef GAS unsigned gu32;
typedef GAS unsigned long long gu64;
#define RLX_AGENT __ATOMIC_RELAXED, __HIP_MEMORY_SCOPE_AGENT
#define LDS_WAIT() asm volatile("s_waitcnt lgkmcnt(0)" ::: "memory")
#define VM_WAIT() asm volatile("s_waitcnt vmcnt(0)" ::: "memory")
__device__ __forceinline__ unsigned long long rt() { return __builtin_amdgcn_s_memrealtime(); }
__device__ __forceinline__ unsigned f2bf(float f) { unsigned u = __builtin_bit_cast(unsigned, f); return (u + 0x7fffu + ((u >> 16) & 1u)) >> 16; }
__device__ __forceinline__ unsigned pk2(float lo, float hi) { return f2bf(lo) | (f2bf(hi) << 16); }

#define XB_TMO      128
#define XB_XCNT(j)  (256  + 64 * (j))
#define XB_XSUB(j)  (1280 + 64 * (j))
#define XB_XGEN(j)  (2304 + 64 * (j))
#define XB_TOP      3328
#define XB_TOPGEN   3392
#define XCD_BAR_WORDS 3456
#define XB_SPIN_CAP (1u << 18)

__device__ __forceinline__ unsigned xb_ld(unsigned* p)              { return __hip_atomic_load(p, __ATOMIC_RELAXED, __HIP_MEMORY_SCOPE_AGENT); }
__device__ __forceinline__ unsigned xb_add(unsigned* p, unsigned v) { return __hip_atomic_fetch_add(p, v, __ATOMIC_RELAXED, __HIP_MEMORY_SCOPE_AGENT); }
__device__ __forceinline__ unsigned xb_xcc_id() { return (unsigned)__builtin_amdgcn_s_getreg((3 << 11) | 20) & 0xFu; }
#define XB_SPIN(cond, bar) do { unsigned _sp = 0; while (cond) { __builtin_amdgcn_s_sleep(1); \
    if ((++_sp & 255u) == 0u) { if (xb_ld(&(bar)[XB_TMO])) break; if (_sp > XB_SPIN_CAP) { atomicAdd(&(bar)[XB_TMO], 1u); break; } } } } while (0)

struct XcdBarrier {
    unsigned* bar; unsigned x;
    volatile LAS unsigned* st;
};

__device__ __forceinline__ XcdBarrier xcd_barrier_post(unsigned* bar, volatile LAS unsigned* st) {
    XcdBarrier b; b.bar = bar; b.x = xb_xcc_id(); b.st = st;
    if (threadIdx.x == 0) (void)xb_add(&bar[XB_XCNT(b.x)], 1u);
    return b;
}
__device__ __forceinline__ void xcd_barrier_complete(unsigned* bar, unsigned x, unsigned& nloc, unsigned& nx) {
    const unsigned G = gridDim.x * gridDim.y * gridDim.z;
    unsigned sum, cnt, mine, sp = 0u;
    for (;;) {
        sum = 0u; cnt = 0u; mine = 0u;
#pragma unroll
        for (unsigned j = 0; j < 16; ++j) { const unsigned c = xb_ld(&bar[XB_XCNT(j)]); sum += c; cnt += (c > 0u) ? 1u : 0u; mine = (j == x) ? c : mine; }
        if (sum == G) break;
        __builtin_amdgcn_s_sleep(1);
        if ((++sp & 255u) == 0u) { if (xb_ld(&bar[XB_TMO])) break; if (sp > XB_SPIN_CAP) { atomicAdd(&bar[XB_TMO], 1u); break; } }
    }
    nloc = mine > 0u ? mine : 1u; nx = cnt > 0u ? cnt : 1u;
}

__device__ __forceinline__ void xcd_barrier(const XcdBarrier& b) {
    asm volatile("s_waitcnt vmcnt(0)" ::: "memory");
    __syncthreads();
    if (threadIdx.x == 0) {
        unsigned* bar = b.bar;
        __builtin_amdgcn_s_waitcnt(0);
        unsigned nloc = b.st[0], nx = b.st[1];
        if (nloc == 0u) { xcd_barrier_complete(bar, b.x, nloc, nx); b.st[0] = nloc; b.st[1] = nx; }
        const unsigned old = xb_add(&bar[XB_XSUB(b.x)], 1u);
        const unsigned gen = old / nloc;
        if (old + 1u == (gen + 1u) * nloc) {
            __builtin_amdgcn_fence(__ATOMIC_RELEASE, "agent");
            asm volatile("s_waitcnt vmcnt(0)" ::: "memory");
            const unsigned og = xb_add(&bar[XB_TOP], 1u);
            const unsigned tg = og / nx;
            if (og + 1u == (tg + 1u) * nx) xb_add(&bar[XB_TOPGEN], 1u);
            else XB_SPIN(xb_ld(&bar[XB_TOPGEN]) == tg, bar);
            __builtin_amdgcn_fence(__ATOMIC_ACQUIRE, "agent");
            xb_add(&bar[XB_XGEN(b.x)], 1u);
            asm volatile("s_waitcnt vmcnt(0)" ::: "memory");
        } else {
            XB_SPIN(xb_ld(&bar[XB_XGEN(b.x)]) == gen, bar);
            __builtin_amdgcn_fence(__ATOMIC_ACQUIRE, "agent");
            asm volatile("s_waitcnt vmcnt(0)" ::: "memory");
        }
    }
    __syncthreads();
}
struct Args { const float* in[33]; float* out; unsigned char* ws; int ph_lo, ph_hi, li, pad; };
constexpr int N_PHASES = 17;
#ifndef MK_N_LAUNCHES
#define MK_N_LAUNCHES 1
#endif
constexpr int N_LAUNCHES = MK_N_LAUNCHES;

enum InIdx { I_XP = 0, I_XS, I_CDAK, I_CDAV, I_CCBK, I_CCBV, I_CMK, I_CMV, I_MEMP, I_T5, I_G1, I_W1G, I_W1U, I_W1D, I_GMIX, I_WIN, I_BGATE, I_LAMBDA, I_DAG, I_CBREL,
             I_WBRDA, I_WBRCB, I_WOUT, I_GCROSS, I_GMEM, I_WMKV, I_WCQ, I_WCO, I_G2, I_W2G, I_W2U, I_W2D, I_GFINAL };

__device__ __forceinline__ float wave_sum(float v) {
#pragma unroll
    for (int o = 1; o < 64; o <<= 1) v += __shfl_xor(v, o);
    return v;
}
__device__ __forceinline__ void tr_item(const float* W, int ldw, int N, bf16* WT, int pitch, int koff, int il, int half, LAS float* scr, int item, int lane) {
    const int nblk = N / 32, kb = item / nblk, nb = item % nblk, k0 = 64 * kb, n0 = 32 * nb;
#pragma unroll 8
    for (int i = 0; i < 32; ++i) { const int kk = 2 * i + (lane >> 5); scr[kk * 33 + (lane & 31)] = W[(size_t)(k0 + kk) * ldw + n0 + (lane & 31)]; }
    LDS_WAIT(); asm volatile("" ::: "memory");
    const int c = lane & 7;
#pragma unroll
    for (int j = 0; j < 4; ++j) { const int n = (lane >> 3) + 8 * j; const LAS float* s = scr + (8 * c) * 33 + n;
        v4u o; o.x = pk2(s[0 * 33], s[1 * 33]); o.y = pk2(s[2 * 33], s[3 * 33]); o.z = pk2(s[4 * 33], s[5 * 33]); o.w = pk2(s[6 * 33], s[7 * 33]);
        const int nn = n0 + n, drow = il ? ((nn >> 7) * 256 + half * 128 + (nn & 127)) : nn;
        *(GAS v4u*)(WT + (size_t)drow * pitch + koff + k0 + 8 * c) = o; }
    LDS_WAIT(); asm volatile("" ::: "memory");
}
__device__ __forceinline__ void rms_row_to_bf16(const float* xrow, const float* g, bf16* orow, int lane) {
    const GAS f32x4* xr = (const GAS f32x4*)xrow + lane; const GAS f32x4* gr = (const GAS f32x4*)g + lane;
    f32x4 v[8]; float s = 0.f;
#pragma unroll
    for (int j = 0; j < 8; ++j) { v[j] = xr[64 * j]; s += (v[j].x * v[j].x + v[j].y * v[j].y) + (v[j].z * v[j].z + v[j].w * v[j].w); }
    const float rs = 1.f / sqrtf(wave_sum(s) * (1.f / DM) + EPS);
    GAS unsigned long long* o8 = (GAS unsigned long long*)orow + lane;
#pragma unroll
    for (int j = 0; j < 8; ++j) { const f32x4 gg = gr[64 * j];
        o8[64 * j] = (unsigned long long)pk2(v[j].x * rs * gg.x, v[j].y * rs * gg.y) | ((unsigned long long)pk2(v[j].z * rs * gg.z, v[j].w * rs * gg.w) << 32); }
}
__device__ __forceinline__ void cvt_row1024(const float* src, bf16* dst, float* fcopy, int lane) {
    const GAS f32x4* s = (const GAS f32x4*)src + lane; GAS unsigned long long* d = (GAS unsigned long long*)dst + lane;
#pragma unroll
    for (int j = 0; j < 4; ++j) { const f32x4 v = s[64 * j]; d[64 * j] = (unsigned long long)pk2(v.x, v.y) | ((unsigned long long)pk2(v.z, v.w) << 32);
        if (fcopy) ((GAS f32x4*)fcopy)[lane + 64 * j] = v; }
}
__device__ __forceinline__ int t5_bucket(int rel) {
    const int base = rel > 0 ? 16 : 0, n = rel < 0 ? -rel : rel;
    if (n < 8) return base + n;
    const float nf = (float)n;
    int large = 8 + (int)(logf(nf / 8.f) / 2.772588722239781f * 8.f);
    large = large < 15 ? large : 15;
    return base + large;
}

struct Frame {
    LAS unsigned char* lds; volatile LAS unsigned* MISC; gu32* ctl;
    int tid, lane, wave, vcu, G;
};

constexpr int I_FFN = 32 * 176, I_FFD = 88 * 64, I_QKV = 32 * 192, I_G = 32 * 64, I_BR = 16 * 64, I_O = 32 * 64, I_MKV = 32 * 32, I_CQ = 32 * 16, I_CO = 8 * 64;
constexpr int N_EARLY = 2 * I_FFN + I_MKV, N_W1D = N_EARLY + I_FFD, N_W2 = N_W1D + 2 * I_FFN + I_FFD, NITEMS = 6 * I_FFN + I_QKV + 2 * I_G + 2 * I_BR + I_O + I_MKV + I_CQ + I_CO;
static_assert(I_FFN == I_FFD, "items");
__device__ __forceinline__ void tr_items(const Args& a, LAS float* scr, int first, int last, int gw, int NGW, int lane) {
    unsigned char* ws = a.ws;
    for (int it = first + gw; it < last; it += NGW) {
        int r = it;
        if (r < I_FFN) { tr_item(a.in[I_W1G], FF, FF, (bf16*)(ws + WS_W1GU), DM, 0, 1, 0, scr, r, lane); continue; } r -= I_FFN;
        if (r < I_FFN) { tr_item(a.in[I_W1U], FF, FF, (bf16*)(ws + WS_W1GU), DM, 0, 1, 1, scr, r, lane); continue; } r -= I_FFN;
        if (r < I_MKV) { tr_item(a.in[I_WMKV], 1024, 1024, (bf16*)(ws + WS_WMKV), DM, 0, 0, 0, scr, r, lane); continue; } r -= I_MKV;
        if (r < I_FFD) { tr_item(a.in[I_W1D], DM, DM, (bf16*)(ws + WS_W1D), FF, 0, 0, 0, scr, r, lane); continue; } r -= I_FFD;
        if (r < I_FFN) { tr_item(a.in[I_W2G], FF, FF, (bf16*)(ws + WS_W2GU), DM, 0, 1, 0, scr, r, lane); continue; } r -= I_FFN;
        if (r < I_FFN) { tr_item(a.in[I_W2U], FF, FF, (bf16*)(ws + WS_W2GU), DM, 0, 1, 1, scr, r, lane); continue; } r -= I_FFN;
        if (r < I_FFD) { tr_item(a.in[I_W2D], DM, DM, (bf16*)(ws + WS_W2D), FF, 0, 0, 0, scr, r, lane); continue; } r -= I_FFD;
        if (r < I_QKV) { tr_item(a.in[I_WIN], 10240, 6144, (bf16*)(ws + WS_WQKV), DM, 0, 0, 0, scr, r, lane); continue; } r -= I_QKV;
        if (r < I_G) { tr_item(a.in[I_WIN] + 6144, 10240, 2048, (bf16*)(ws + WS_WG), DM, 0, 1, 0, scr, r, lane); continue; } r -= I_G;
        if (r < I_G) { tr_item(a.in[I_WIN] + 8192, 10240, 2048, (bf16*)(ws + WS_WG), DM, 0, 1, 1, scr, r, lane); continue; } r -= I_G;
        if (r < I_BR) { tr_item(a.in[I_WBRDA], DM, DM, (bf16*)(ws + WS_WBR), DM, 0, 0, 0, scr, r, lane); continue; } r -= I_BR;
        if (r < I_BR) { tr_item(a.in[I_WBRCB], DM, DM, (bf16*)(ws + WS_WBR), DM, 1024, 0, 0, scr, r, lane); continue; } r -= I_BR;
        if (r < I_O) { tr_item(a.in[I_WOUT], DM, DM, (bf16*)(ws + WS_WO), DM, 0, 0, 0, scr, r, lane); continue; } r -= I_O;
        if (r < I_CQ) { tr_item(a.in[I_WCQ], XW, XW, (bf16*)(ws + WS_WCQ), DM, 0, 0, 0, scr, r, lane); continue; } r -= I_CQ;
        tr_item(a.in[I_WCO], DM, DM, (bf16*)(ws + WS_WCO), XW, 0, 0, 0, scr, r, lane);
    }
}
__device__ __forceinline__ void cache_rows(const Args& a, int gw, int NGW, int lane) {
    unsigned char* ws = a.ws;
    constexpr int R_DA = DB * PAST, R_CB = DB * CBR, R_MEM = DB * NMEM * XW / 1024;
    for (int r0 = gw; r0 < 2 * R_DA + 2 * R_CB + 2 * R_MEM; r0 += NGW) {
        int r = r0;
        if (r < 2 * R_DA) { const int v = r >= R_DA; r -= v * R_DA; const int b = r >> 10, t = r & 1023;
            cvt_row1024(a.in[v ? I_CDAV : I_CDAK] + (size_t)r * 1024, (bf16*)(ws + (v ? WS_VDAS : WS_KDAS)) + (size_t)(b * KDAS_ROWS + t) * 1024, nullptr, lane); continue; }
        r -= 2 * R_DA;
        if (r < 2 * R_CB) { const int v = r >= R_CB; r -= v * R_CB; const int b = r >> 9, t = r & 511;
            float* fc = t >= DT ? a.out + (v ? O_CBVS : O_CBKS) + (size_t)(b * CBR + t - DT) * 1024 : nullptr;
            cvt_row1024(a.in[v ? I_CCBV : I_CCBK] + (size_t)r * 1024, (bf16*)(ws + (v ? WS_VCBS : WS_KCBS)) + (size_t)(b * KCBS_ROWS + t) * 1024, fc, lane); continue; }
        r -= 2 * R_CB;
        { const int v = r >= R_MEM; r -= v * R_MEM;
          cvt_row1024(a.in[v ? I_CMV : I_CMK] + (size_t)r * 1024, (bf16*)(ws + (v ? WS_MVS : WS_MKS)) + (size_t)r * 1024, nullptr, lane); }
    }
}
#ifndef DIFF_XCD32
#define DIFF_XCD32 0
#endif
#ifndef WGM_QKV
#define WGM_QKV 4
#endif
#ifndef WGM_GU
#define WGM_GU 4
#endif
#ifndef A_BLOCKED
#define A_BLOCKED 0
#endif
#ifndef PANEL_REV
#define PANEL_REV 0
#endif
#ifndef DEFER_CVT
#define DEFER_CVT 1
#endif
__device__ __forceinline__ void p0_prologue(Frame& F, const Args& a) {
    LAS float* scr = (LAS float*)(F.lds + RING_OFF + F.wave * 16384);
    const int gw = F.vcu * NWAVES + F.wave, NGW = F.G * NWAVES;
    unsigned char* ws = a.ws;
    tr_items(a, scr, 0, DEFER_CVT ? N_EARLY : NITEMS, gw, NGW, F.lane);
    for (int m = gw; m < MTOT + NBP * NMEM; m += NGW) {
        if (m < MP) rms_row_to_bf16(a.in[I_XP] + (size_t)m * DM, a.in[I_G1], (bf16*)(ws + WS_XN) + (size_t)m * DM, F.lane);
        else if (m < MTOT) rms_row_to_bf16(a.in[I_XS] + (size_t)(m - MP) * DM, a.in[I_G1], (bf16*)(ws + WS_XN) + (size_t)m * DM, F.lane);
        else rms_row_to_bf16(a.in[I_MEMP] + (size_t)(m - MTOT) * DM, a.in[I_GMEM], (bf16*)(ws + WS_XM) + (size_t)(m - MTOT) * DM, F.lane);
    }
    if (!DEFER_CVT) cache_rows(a, gw, NGW, F.lane);
    if (blockIdx.x == 0) {
        float* lut = (float*)(ws + WS_LUT);
        for (int i = F.tid; i < 2 * 8 * 320; i += NWAVES * 64) { const int ty = i / 2560, h = (i / 320) & 7, e = i % 320, rel = e - 256;
            float v;
            if (ty == 0) v = a.in[I_T5][t5_bucket(rel) * 8 + h];
            else { const int idx = (rel < -128 ? -128 : (rel > 128 ? 128 : rel)) + 128; v = a.in[I_CBREL][idx * 8 + h]; }
            lut[i] = v * LOG2E; }
        if (F.wave == 0) { const float* lp = a.in[I_LAMBDA]; const float s1 = wave_sum(lp[F.lane] * lp[64 + F.lane]), s2 = wave_sum(lp[128 + F.lane] * lp[192 + F.lane]);
            if (F.lane == 0) *(float*)(ws + WS_LUT + 32768) = expf(s1) - expf(s2) + LAM_INIT; }
    }
}

__device__ __forceinline__ void rstd_phase(Frame& F, unsigned char* ws, int nrows) {
    const float* ssq = (const float*)(ws + WS_SSQ); float* rstd = (float*)(ws + WS_RSTD);
    for (int row = F.vcu * (NWAVES * 64) + F.tid; row < nrows; row += F.G * NWAVES * 64) {
        const f32x4* p = (const f32x4*)(ssq + (size_t)row * 32); float s = 0.f;
#pragma unroll
        for (int k = 0; k < 8; ++k) { const f32x4 v = p[k]; s += (v.x + v.y) + (v.z + v.w); }
        rstd[row] = 1.f / sqrtf(s * (1.f / DM) + EPS);
    }
}
__device__ __forceinline__ void final_phase(Frame& F, unsigned char* ws, float* outp, int nrows) {
    const float* ssq = (const float*)(ws + WS_SSQ); const bf16* XN = (const bf16*)(ws + WS_XN);
    const int gw = F.vcu * NWAVES + F.wave, NGW = F.G * NWAVES;
    for (int row = gw; row < nrows; row += NGW) {
        const GAS v4u* x = (const GAS v4u*)(XN + (size_t)row * DM) + F.lane; GAS f32x4* y = (GAS f32x4*)(outp + O_Y + (size_t)row * DM) + 2 * F.lane;
        v4u w[4];
#pragma unroll
        for (int j = 0; j < 4; ++j) w[j] = x[64 * j];
        const float part = F.lane < 32 ? ((const GAS float*)ssq)[(size_t)row * 32 + F.lane] : 0.f;
        const float rs = 1.f / sqrtf(wave_sum(part) * (1.f / DM) + EPS);
#pragma unroll
        for (int j = 0; j < 4; ++j) { f32x4 a, b;
            a[0] = __uint_as_float(w[j].x << 16); a[1] = __uint_as_float(w[j].x & 0xffff0000u); a[2] = __uint_as_float(w[j].y << 16); a[3] = __uint_as_float(w[j].y & 0xffff0000u);
            b[0] = __uint_as_float(w[j].z << 16); b[1] = __uint_as_float(w[j].z & 0xffff0000u); b[2] = __uint_as_float(w[j].w << 16); b[3] = __uint_as_float(w[j].w & 0xffff0000u);
            y[128 * j] = a * rs; y[128 * j + 1] = b * rs; }
    }
}
constexpr size_t WS_SLAB15 = 864 * MiB;
static_assert(WS_SLAB15 >= WS_A + (size_t)MTOT * FF * 2 && WS_SLAB15 + 4 * 64 * 65536 * 4 <= WS_END, "slab region");
template <int MODE  >
__device__ __forceinline__ f32x4 fixup_v(const float* slab, const bf16* XN, const float* xs, const float* gprev, float alpha, int s, int pn, int lane) {
    const int row = MP + s, tt = (s >> 8) + 8 * pn, col = pn * 256 + lane * 4;
    const GAS f32x4* sp = (const GAS f32x4*)(slab + (size_t)tt * 65536 + (s & 255) * 256 + lane * 4);
    const f32x4 a = (sp[0] + sp[(size_t)64 * 65536 / 4]) + (sp[(size_t)2 * 64 * 65536 / 4] + sp[(size_t)3 * 64 * 65536 / 4]);
    f32x4 b;
    if (MODE == 0) b = *(const GAS f32x4*)(xs + (size_t)s * DM + col);
    else { const unsigned long long w = *(const GAS unsigned long long*)(XN + (size_t)row * DM + col); const f32x4 gp = *(const GAS f32x4*)(gprev + col);
        b[0] = __uint_as_float((unsigned)w << 16) / gp[0]; b[1] = __uint_as_float((unsigned)w & 0xffff0000u) / gp[1];
        b[2] = __uint_as_float((unsigned)(w >> 32) << 16) / gp[2]; b[3] = __uint_as_float((unsigned)(w >> 32) & 0xffff0000u) / gp[3]; }
    return b + a * alpha;
}
template <int MODE, bool FINAL>
__device__ __forceinline__ void fixup_rows(Frame& F, unsigned char* ws, const float* slab, const float* xs, const float* gprev, const float* gnext, float alpha, float* outy) {
    const int gw = F.vcu * NWAVES + F.wave, NGW = F.G * NWAVES, lane = F.lane;
    bf16* XN = (bf16*)(ws + WS_XN); float* rstd = (float*)(ws + WS_RSTD);
    for (int s = gw; s < MS; s += NGW) { const int row = MP + s;
        float ss = 0.f;
#pragma unroll 1
        for (int pn = 0; pn < 8; ++pn) { const f32x4 v = fixup_v<MODE>(slab, XN, xs, gprev, alpha, s, pn, lane); ss += (v[0] * v[0] + v[1] * v[1]) + (v[2] * v[2] + v[3] * v[3]); }
        const float rs = 1.f / sqrtf(wave_sum(ss) * (1.f / DM) + EPS);
#pragma unroll 1
        for (int pn = 0; pn < 8; ++pn) { const f32x4 v = fixup_v<MODE>(slab, XN, xs, gprev, alpha, s, pn, lane); const int col = pn * 256 + lane * 4; const f32x4 gnx = *(const GAS f32x4*)(gnext + col);
            if (FINAL) *(GAS f32x4*)(outy + (size_t)row * DM + col) = v * rs * gnx;
            else { const f32x4 o = v * gnx; *(GAS unsigned long long*)(XN + (size_t)row * DM + col) = (unsigned long long)pk2(o[0], o[1]) | ((unsigned long long)pk2(o[2], o[3]) << 32); } }
        if (!FINAL && lane == 0) rstd[row] = rs;
    }
}
#ifndef ABL_BITS
#define ABL_BITS 0
#endif
#ifndef NO_DIFF
#define NO_DIFF 0
#endif
#ifndef NO_BAND
#define NO_BAND 0
#endif
#ifndef ATT_SD_DIFF
#define ATT_SD_DIFF 1
#endif
#ifndef ATT_SD_BAND
#define ATT_SD_BAND 1
#endif
using att::f32x16;
__device__ __forceinline__ void load_lut(Frame& F, const float* glut, char* lds) {
    __syncthreads();
    int t_ = threadIdx.x; asm volatile("" : "+v"(t_));
    if (t_ < 320) ((float*)(lds + att::LDS_LUT))[t_] = glut[t_];
    __syncthreads();
}
__device__ __forceinline__ void store_o_bf16(const f32x16 (&o)[4], bf16* Ow, int ld, char* lds, int wid) {
    int lane = threadIdx.x; asm volatile("" : "+v"(lane)); lane &= 63;
    const int r32 = lane & 31, hi = lane >> 5;
    bf16* stg = (bf16*)(lds + att::LDS_OSTAGE + wid * 4096);
#pragma unroll
    for (int hf = 0; hf < 2; ++hf) {
#pragma unroll
        for (int r = 0; r < 16; ++r) { const int orow = att::crow(r, hi);
#pragma unroll
            for (int dd = 0; dd < 2; ++dd) stg[orow * 64 + dd * 32 + r32] = (bf16)f2bf(o[2 * hf + dd][r]); }
        asm volatile("s_waitcnt lgkmcnt(0)" ::: "memory");
        bf16* gp = Ow + (size_t)(lane >> 3) * ld + hf * 64 + (lane & 7) * 8;
#pragma unroll
        for (int i = 0; i < 4; ++i) { const v4u v = *(const v4u*)(stg + (i * 8 + (lane >> 3)) * 64 + (lane & 7) * 8); *(v4u*)gp = v; gp += (size_t)8 * ld; }
        asm volatile("s_waitcnt lgkmcnt(0)" ::: "memory");
    }
}
__device__ __forceinline__ void store_ot_bf16(const f32x16 (&o)[4], bf16* Ow, int ld, char* lds, int wid) {
    int lane = threadIdx.x; asm volatile("" : "+v"(lane)); lane &= 63;
    const int q = lane & 31, hi = lane >> 5;
    bf16* stg = (bf16*)(lds + att::LDS_OSTAGE + wid * 4096);
#pragma unroll
    for (int hf = 0; hf < 2; ++hf) {
#pragma unroll
        for (int dd = 0; dd < 2; ++dd)
#pragma unroll
            for (int r = 0; r < 16; ++r) stg[q * 64 + dd * 32 + att::crow(r, hi)] = (bf16)f2bf(o[2 * hf + dd][r]);
        asm volatile("s_waitcnt lgkmcnt(0)" ::: "memory");
        bf16* gp = Ow + (size_t)(lane >> 3) * ld + hf * 64 + (lane & 7) * 8;
#pragma unroll
        for (int i = 0; i < 4; ++i) { const v4u v = *(const v4u*)(stg + (i * 8 + (lane >> 3)) * 64 + (lane & 7) * 8); *(v4u*)gp = v; gp += (size_t)8 * ld; }
        asm volatile("s_waitcnt lgkmcnt(0)" ::: "memory");
    }
}
template <bool sample>
__device__ __forceinline__ void diff_unit(Frame& F, unsigned char* ws, const float* dag, char* lds, int b, int h, int qb, bool dostore = true) {
    bf16* QO = (bf16*)(ws + WS_QO);
    const int wid = F.wave;
    const float lam = *(const float*)(ws + WS_LUT + 32768);
    const float* lut = (const float*)(lds + att::LDS_LUT);
    load_lut(F, (const float*)(ws + WS_LUT) + h * 320, lds);
    att::TileArgs T; T.abl = dostore ? 0 : ABL_BITS;
    size_t qrow; const bf16 *Kb, *Vb;
    if (!sample) { qrow = (size_t)b * SEQ + qb * 256 + wid * 32; Kb = (const bf16*)(ws + WS_KDAP) + (size_t)b * SEQ * 1024 + h * 128; Vb = (const bf16*)(ws + WS_VDAP) + (size_t)b * SEQ * 1024 + h * 128;
        T.t0 = 0; T.NT = 4 * qb + 4; T.tmax = T.NT - 1; T.wlo = 0; T.whi = 4 * qb + (wid >> 1); T.relw = -(qb * 256 + wid * 32); }
    else { qrow = (size_t)MP + b * DT + (wid & 1) * 32; Kb = (const bf16*)(ws + WS_KDAS) + (size_t)b * KDAS_ROWS * 1024 + h * 128; Vb = (const bf16*)(ws + WS_VDAS) + (size_t)b * KDAS_ROWS * 1024 + h * 128;
        T.t0 = 0; T.NT = 18; T.tmax = 16; T.wlo = 0; T.whi = 16; T.relw = -(PAST + (wid & 1) * 32); }
    T.ldq = DM; T.ldk = 1024; T.ldv = 1024; T.Vh = Vb;
    f32x16 o[4]; float l;
#pragma unroll 1
    for (int map = 0; map < 2; ++map) {
        T.Qw = QO + qrow * DM + h * 128 + map * 64; T.Kh = Kb + map * 64;
        att::attn_tiles<64, true, ATT_SD_DIFF, sample>(T, lut, lds, o, l);
        att::attn_normalize_t(o, l);
        if (map == 0) { int t_ = threadIdx.x; asm volatile("" : "+v"(t_));
            f32x4* stash = (f32x4*)(ws + WS_STASH) + ((size_t)blockIdx.x * 512 + t_) * 16;
#pragma unroll
            for (int d = 0; d < 4; ++d)
#pragma unroll
                for (int q = 0; q < 4; ++q) stash[d * 4 + q] = (f32x4){o[d][4 * q], o[d][4 * q + 1], o[d][4 * q + 2], o[d][4 * q + 3]};
        }
    }
    int t2_ = threadIdx.x; asm volatile("" : "+v"(t2_));
    const f32x4* stash = (const f32x4*)(ws + WS_STASH) + ((size_t)blockIdx.x * 512 + t2_) * 16; const int hib = (t2_ >> 5) & 1;
    float ssp = 0.f;
#pragma unroll
    for (int d = 0; d < 4; ++d)
#pragma unroll
        for (int q = 0; q < 4; ++q) { const f32x4 s4 = stash[d * 4 + q];
#pragma unroll
            for (int e = 0; e < 4; ++e) { const int r = 4 * q + e; const float v = s4[e] - lam * o[d][r]; o[d][r] = v; ssp += v * v; } }
    { auto rr = __builtin_amdgcn_permlane32_swap(__float_as_uint(ssp), __float_as_uint(ssp), false, false); ssp = __uint_as_float(rr[0]) + __uint_as_float(rr[1]); }
    const float rsn = (1.f - LAM_INIT) / sqrtf(ssp * (1.f / 128.f) + EPS);
#pragma unroll
    for (int d = 0; d < 4; ++d)
#pragma unroll
        for (int r = 0; r < 16; ++r) o[d][r] *= rsn * dag[d * 32 + (r & 3) + 8 * (r >> 2) + 4 * hib];
    __syncthreads();
    if (dostore && (!sample || wid < 2)) store_ot_bf16(o, QO + qrow * DM + h * 128, DM, lds, wid);
}
template <bool sample>
__device__ __forceinline__ void band_unit(Frame& F, unsigned char* ws, char* lds, int b, int h, int qb, bool dostore = true) {
    bf16* QO = (bf16*)(ws + WS_QO);
    const int wid = F.wave;
    const float* lut = (const float*)(lds + att::LDS_LUT);
    load_lut(F, (const float*)(ws + WS_LUT) + 2560 + h * 320, lds);
    att::TileArgs T; T.abl = 0; size_t qrow;
    if (!sample) { qrow = (size_t)b * SEQ + qb * 256 + wid * 32; const int c0 = 4 * qb, c = c0 + (wid >> 1);
        T.Kh = (const bf16*)(ws + WS_KCBP) + (size_t)b * SEQ * 1024 + h * 128; T.Vh = (const bf16*)(ws + WS_VCBP) + (size_t)b * SEQ * 1024 + h * 128;
        T.t0 = c0 >= 8 ? c0 - 8 : 0; T.tmax = c0 + 3; T.NT = T.tmax - T.t0 + 1; T.wlo = c >= 8 ? c - 8 : 0; T.whi = c; T.relw = -(qb * 256 + wid * 32); }
    else { qrow = (size_t)MP + b * DT + (wid & 1) * 32;
        T.Kh = (const bf16*)(ws + WS_KCBS) + (size_t)b * KCBS_ROWS * 1024 + h * 128; T.Vh = (const bf16*)(ws + WS_VCBS) + (size_t)b * KCBS_ROWS * 1024 + h * 128;
        T.t0 = 0; T.NT = 10; T.tmax = 8; T.wlo = 0; T.whi = 8; T.relw = (PAST - CBR) - (PAST + (wid & 1) * 32); }
    T.ldq = DM; T.ldk = 1024; T.ldv = 1024; T.Qw = QO + qrow * DM + 1024 + h * 128;
    f32x16 o[4]; float l;
    att::attn_tiles<128, true, ATT_SD_BAND, sample>(T, lut, lds, o, l); att::attn_normalize(o, l, lds);
    __syncthreads();
    if (dostore && (!sample || wid < 2)) store_o_bf16(o, QO + qrow * DM + 1024 + h * 128, DM, lds, wid);
}
__device__ __forceinline__ void cross_unit(Frame& F, unsigned char* ws, char* lds, bool sample, int b, int h, int qb, const float* qslab = nullptr) {
    bf16* QX = (bf16*)(ws + WS_QX);
    const int wid = F.wave;
    __syncthreads();
    if (sample && qslab) {
        int t = threadIdx.x; asm volatile("" : "+v"(t));
        const int r = t >> 3, cg = (t & 7) * 16, s = b * DT + r, tt = (s >> 8) + 8 * (h >> 1);
        const GAS f32x4* sp = (const GAS f32x4*)(qslab + (size_t)tt * 65536 + (s & 255) * 256 + (h & 1) * 128 + cg);
        const float sc = ((const GAS float*)(ws + WS_RSTD))[MP + s] * SC_CB;
        f32x4 a[4];
#pragma unroll
        for (int q = 0; q < 4; ++q) a[q] = (((sp[q] + sp[q + (size_t)16 * 65536 / 4]) + (sp[q + (size_t)2 * 16 * 65536 / 4] + sp[q + (size_t)3 * 16 * 65536 / 4]))
                                          + ((sp[q + (size_t)4 * 16 * 65536 / 4] + sp[q + (size_t)5 * 16 * 65536 / 4]) + (sp[q + (size_t)6 * 16 * 65536 / 4] + sp[q + (size_t)7 * 16 * 65536 / 4]))) * sc;
        v4u o0, o1; o0.x = pk2(a[0][0], a[0][1]); o0.y = pk2(a[0][2], a[0][3]); o0.z = pk2(a[1][0], a[1][1]); o0.w = pk2(a[1][2], a[1][3]);
        o1.x = pk2(a[2][0], a[2][1]); o1.y = pk2(a[2][2], a[2][3]); o1.z = pk2(a[3][0], a[3][1]); o1.w = pk2(a[3][2], a[3][3]);
        GAS v4u* d = (GAS v4u*)(QX + (size_t)(MP + s) * XW + h * 128 + cg); d[0] = o0; d[1] = o1;
        asm volatile("s_waitcnt vmcnt(0)" ::: "memory"); __syncthreads();
    }
    att::TileArgs T; T.abl = 0; size_t qrow;
    if (!sample) { qrow = (size_t)b * SEQ + qb * 256 + wid * 32; T.Kh = (const bf16*)(ws + WS_MKP) + (size_t)b * NMEM * XW + h * 128; T.Vh = (const bf16*)(ws + WS_MVP) + (size_t)b * NMEM * XW + h * 128; }
    else { qrow = (size_t)MP + b * DT + (wid & 1) * 32; T.Kh = (const bf16*)(ws + WS_MKS) + (size_t)b * NMEM * XW + h * 128; T.Vh = (const bf16*)(ws + WS_MVS) + (size_t)b * NMEM * XW + h * 128; }
    T.t0 = 0; T.NT = 4; T.tmax = 3; T.wlo = 0; T.whi = 3; T.relw = 0; T.ldq = XW; T.ldk = XW; T.ldv = XW; T.Qw = QX + qrow * XW + h * 128;
    f32x16 o[4]; float l;
    att::attn_tiles<128, false, 2>(T, nullptr, lds, o, l); att::attn_normalize(o, l, lds);
    __syncthreads();
    if (!sample || wid < 2) store_o_bf16(o, QX + qrow * XW + h * 128, XW, lds, wid);
}

constexpr int PT_OFF = MISC_OFF + 128;
__device__ __forceinline__ unsigned long long ldp(LAS unsigned char* lds, int idx) {
    volatile LAS unsigned* p = (volatile LAS unsigned*)(lds + PT_OFF) + 2 * idx;
    const unsigned lo = __builtin_amdgcn_readfirstlane(p[0]), hi = __builtin_amdgcn_readfirstlane(p[1]);
    return ((unsigned long long)hi << 32) | lo;
}
__global__ void __launch_bounds__(NWAVES * 64, 2) mega_fwd(Args args) {
    extern __shared__ __attribute__((aligned(16))) unsigned char lds[];
    Frame F;
    F.lds = (LAS unsigned char*)lds; F.MISC = (volatile LAS unsigned*)(F.lds + MISC_OFF);
    F.tid = threadIdx.x; F.lane = F.tid & 63; F.wave = __builtin_amdgcn_readfirstlane(F.tid >> 6);
    F.G = gridDim.x; { const int bx = blockIdx.x; F.vcu = (F.G % 8 == 0) ? (bx % 8) * (F.G / 8) + bx / 8 : bx; }
    F.ctl = (gu32*)(args.ws + WS_CTL);
    for (int u = F.tid; u < (LDS_BYTES - LDSCTL_OFF) / 4; u += NWAVES * 64) ((LAS unsigned*)(F.lds + LDSCTL_OFF))[u] = 0u;
    __syncthreads();
    if (F.tid == 0) { volatile LAS unsigned long long* PT = (volatile LAS unsigned long long*)(F.lds + PT_OFF);
        PT[0] = (unsigned long long)args.out; PT[1] = (unsigned long long)args.ws; PT[2] = (unsigned long long)args.in[I_XP]; PT[3] = (unsigned long long)args.in[I_XS];
        PT[4] = (unsigned long long)args.in[I_GMIX]; PT[5] = (unsigned long long)args.in[I_BGATE]; PT[6] = (unsigned long long)args.in[I_GCROSS]; PT[7] = (unsigned long long)args.in[I_G2];
        PT[8] = (unsigned long long)args.in[I_DAG]; PT[9] = (unsigned long long)args.in[I_GFINAL]; }
    __syncthreads();
#define LDP(T, idx) ((T)ldp(F.lds, (idx)))
    XcdBarrier bar; bar.bar = (unsigned*)(F.ctl + CW_BAR); bar.x = 0; bar.st = nullptr;
    if (N_LAUNCHES == 1) bar = xcd_barrier_post((unsigned*)(F.ctl + CW_BAR), F.MISC + 8);
#define GRID_BAR() do { if (N_LAUNCHES == 1) xcd_barrier(bar); } while (0)
    const int lo = args.ph_lo, hi = args.ph_hi;
#ifndef PH_MASK
#define PH_MASK 0x1ffff
#endif
#define IN(k) (((PH_MASK >> (k)) & 1) && lo <= (k) && (k) < hi)
#define BOTH(k) (IN(k) && IN((k) + 1))
#define IDS() do { int t_ = threadIdx.x; asm volatile("" : "+v"(t_)); F.tid = t_; F.lane = t_ & 63; } while (0)
    const int G = F.G, bx = (int)blockIdx.x;
    LAS unsigned char* ring = F.lds + RING_OFF;

    if (IN(0)) { IDS(); p0_prologue(F, args); if (BOTH(0)) GRID_BAR(); }
    if (IN(1)) {
        unsigned char* ws = LDP(unsigned char*, 1);
        { pg8::Gemm g{(const bf16*)(ws + WS_XN), (const bf16*)(ws + WS_W1GU), MTOT, 2 * FF, DM}; pg8::StaticOrder S; S.init(MTOT, 2 * FF, G, bx, 0, WGM_GU);
          pg8::EpiSwiGLU E{(bf16*)(ws + WS_A), FF, nullptr, A_BLOCKED};
          pg8::gemm_phase<pg8::EpiSwiGLU, pg8::StaticOrder, true, true>(ring, g, S, E); }
        if (bx >= G - 8) { float* out = LDP(float*, 0);
          pg8::Gemm g{(const bf16*)(ws + WS_XM), (const bf16*)(ws + WS_WMKV), NBP * NMEM, 1024, DM}; pg8::StaticOrder S; S.init(NBP * NMEM, 1024, G, bx - (G - 8));
          pg8::EpiMemKV E{(bf16*)(ws + WS_MKP), (bf16*)(ws + WS_MVP), out};
          pg8::gemm_phase<pg8::EpiMemKV, pg8::StaticOrder, true, true>(ring, g, S, E); }
        if (DEFER_CVT) {
            const int nfull = (MTOT / 256) * (2 * FF / 256) - ((MTOT / 256) * (2 * FF / 256) / G) * G;
            const int lo_b = nfull, hi_b = G - 8;
            if (hi_b > lo_b) { if (bx >= lo_b && bx < hi_b) { IDS(); tr_items(args, (LAS float*)(F.lds + RING_OFF + F.wave * 16384), N_EARLY, N_W1D, (bx - lo_b) * NWAVES + F.wave, (hi_b - lo_b) * NWAVES, F.lane); } }
            else { IDS(); tr_items(args, (LAS float*)(F.lds + RING_OFF + F.wave * 16384), N_EARLY, N_W1D, bx * NWAVES + F.wave, G * NWAVES, F.lane); }
        }
        if (BOTH(1)) GRID_BAR();
    }
    if (IN(2)) {
        unsigned char* ws = LDP(unsigned char*, 1); float* out = LDP(float*, 0);
        pg8::Gemm g{(const bf16*)(ws + WS_A), (const bf16*)(ws + WS_W1D), MTOT, DM, FF, 0, A_BLOCKED}; pg8::StaticOrder S; S.init(MTOT, DM, G, bx, PANEL_REV);
        pg8::EpiResidX E{LDP(const float*, 2), LDP(const float*, 3) - (size_t)MP * DM, 0.5f, LDP(const float*, 4), (bf16*)(ws + WS_XN), (float*)(ws + WS_SSQ)};
        pg8::gemm_phase<pg8::EpiResidX, pg8::StaticOrder, true, true>(ring, g, S, E);
        if (DEFER_CVT) {
            const int nfull = (MTOT / 256) * (DM / 256) - 4 * G;
            if (nfull >= 0 && nfull < G && bx >= nfull) { IDS(); const int gw = (bx - nfull) * NWAVES + F.wave, NGW = (G - nfull) * NWAVES;
                tr_items(args, (LAS float*)(F.lds + RING_OFF + F.wave * 16384), N_W2, NITEMS, gw, NGW, F.lane); cache_rows(args, gw, NGW, F.lane); }
            else if (nfull < 0 || nfull >= G) { IDS(); const int gw = bx * NWAVES + F.wave, NGW = G * NWAVES;
                tr_items(args, (LAS float*)(F.lds + RING_OFF + F.wave * 16384), N_W2, NITEMS, gw, NGW, F.lane); cache_rows(args, gw, NGW, F.lane); }
        }
        if (BOTH(2)) GRID_BAR();
    }
    if (IN(3)) { IDS(); rstd_phase(F, LDP(unsigned char*, 1), MTOT); if (BOTH(3)) GRID_BAR(); }
    if (IN(4)) {
        unsigned char* ws = LDP(unsigned char*, 1); float* out = LDP(float*, 0);
        pg8::Gemm g{(const bf16*)(ws + WS_XN), (const bf16*)(ws + WS_WQKV), MTOT, 6144, DM}; pg8::StaticOrder S; S.init(MTOT, 6144, G, bx, 0, WGM_QKV);
        pg8::EpiQKV E{(const float*)(ws + WS_RSTD), (bf16*)(ws + WS_QO), (bf16*)(ws + WS_KDAP), (bf16*)(ws + WS_KDAS), (bf16*)(ws + WS_KCBS), out};
        pg8::gemm_phase<pg8::EpiQKV, pg8::StaticOrder, true, true>(ring, g, S, E);
        if (BOTH(4)) GRID_BAR();
    }
    if (IN(5)) {
        IDS();
        unsigned char* ws = LDP(unsigned char*, 1); const float* dag = LDP(const float*, 8);
        char* al = (char*)lds + RING_OFF;
#ifndef DUP_DIFF
#define DUP_DIFF 0
#endif
#ifndef DUP_BAND
#define DUP_BAND 0
#endif
        for (int u = F.vcu; u < 1024; u += G) {
            const int v = u & 255, i = u >> 8, bh = v >> 4, s = v & 15; const int qb = i == 0 ? s : i == 1 ? 31 - s : i == 2 ? 32 + s : 63 - s;
            if (!NO_DIFF) diff_unit<false>(F, ws, dag, al, bh >> 3, bh & 7, qb); }
        for (int u = 1024 + F.vcu; u < 1280; u += G) {
            const int v = u & 255;
            if (!NO_DIFF) diff_unit<true>(F, ws, dag, al, v >> 3, v & 7, 0); }
        for (int u = F.vcu; u < 1024; u += G) { const int v = u & 255, i = u >> 8, bh = v >> 4;
            if (!NO_BAND) band_unit<false>(F, ws, al, bh >> 3, bh & 7, (v & 15) * 4 + i); }
        for (int u = 1024 + F.vcu; u < 1280; u += G) { const int v = u & 255;
            if (!NO_BAND) band_unit<true>(F, ws, al, v >> 3, v & 7, 0); }
        __syncthreads();
        if (BOTH(5)) GRID_BAR();
    }
    if (IN(6)) {
        unsigned char* ws = LDP(unsigned char*, 1);
        pg8::Gemm g{(const bf16*)(ws + WS_XN), (const bf16*)(ws + WS_WG), MTOT, 4096, DM}; pg8::StaticOrder S; S.init(MTOT, 4096, G, bx, PANEL_REV, WGM_QKV);
        pg8::EpiGates E{(const float*)(ws + WS_RSTD), LDP(const float*, 5), (bf16*)(ws + WS_GR), (bf16*)(ws + WS_GB)};
        pg8::gemm_phase<pg8::EpiGates, pg8::StaticOrder, true, true>(ring, g, S, E);
        if (BOTH(6)) GRID_BAR();
    }
    if (IN(7)) {
        unsigned char* ws = LDP(unsigned char*, 1);
        pg8::Gemm g{(const bf16*)(ws + WS_QO), (const bf16*)(ws + WS_WBR), MTOT, DM, DM}; pg8::StaticOrder S; S.init(MTOT, DM, G, bx);
        pg8::EpiMix E{(const bf16*)(ws + WS_GR), (const bf16*)(ws + WS_GB), (bf16*)(ws + WS_MIX)};
        pg8::gemm_phase<pg8::EpiMix, pg8::StaticOrder, true, true>(ring, g, S, E);
        if (DEFER_CVT) {
            const int nfull = (MTOT / 256) * (DM / 256) - 4 * G;
            if (nfull >= 0 && nfull < G) { if (bx >= nfull) { IDS(); tr_items(args, (LAS float*)(F.lds + RING_OFF + F.wave * 16384), N_W1D, N_W2, (bx - nfull) * NWAVES + F.wave, (G - nfull) * NWAVES, F.lane); } }
            else { IDS(); tr_items(args, (LAS float*)(F.lds + RING_OFF + F.wave * 16384), N_W1D, N_W2, bx * NWAVES + F.wave, G * NWAVES, F.lane); }
        }
        if (BOTH(7)) GRID_BAR();
    }
    if (IN(8)) {
        unsigned char* ws = LDP(unsigned char*, 1); const bool split = (G == 256);
        { pg8::Gemm g{(const bf16*)(ws + WS_MIX), (const bf16*)(ws + WS_WO), split ? MP : MTOT, DM, DM}; pg8::StaticOrder S; S.init(split ? MP : MTOT, DM, G, bx, PANEL_REV);
          pg8::EpiResidH<false> E{(bf16*)(ws + WS_XN), LDP(const float*, 4), LDP(const float*, 6), nullptr, 1.0f, (float*)(ws + WS_SSQ)};
          pg8::gemm_phase<pg8::EpiResidH<false>, pg8::StaticOrder, true, true>(ring, g, S, E); }
        if (split) { const int tt = bx >> 2, ks = bx & 3; float* slab = LDP(float*, 0) + O_Y;
          pg8::Gemm g{(const bf16*)(ws + WS_MIX) + (size_t)MP * DM + ks * (DM / 4), (const bf16*)(ws + WS_WO) + ks * (DM / 4), MS, DM, DM / 4, DM}; pg8::OneUnit S{{tt & 7, tt >> 3}};
          pg8::EpiSlab E{slab + (size_t)(ks * 64 + tt) * 65536};
          pg8::gemm_phase<pg8::EpiSlab, pg8::OneUnit, true, true>(ring, g, S, E); }
        if (BOTH(8)) GRID_BAR();
    }
    if (IN(9)) { IDS(); unsigned char* ws = LDP(unsigned char*, 1); const bool split = (G == 256); rstd_phase(F, ws, split ? MP : MTOT);
        if (split) fixup_rows<1, false>(F, ws, LDP(const float*, 0) + O_Y, nullptr, LDP(const float*, 4), LDP(const float*, 6), 1.0f, nullptr);
        if (BOTH(9)) GRID_BAR(); }
    if (IN(10)) {
        unsigned char* ws = LDP(unsigned char*, 1);
        const bool split = (G == 256);
        { pg8::Gemm g{(const bf16*)(ws + WS_XN), (const bf16*)(ws + WS_WCQ), split ? MP : MTOT, XW, DM}; pg8::StaticOrder S; S.init(split ? MP : MTOT, XW, G, bx);
          pg8::EpiScaleBf16 E{(const float*)(ws + WS_RSTD), (bf16*)(ws + WS_QX), XW, SC_CB};
          pg8::gemm_phase<pg8::EpiScaleBf16, pg8::StaticOrder, true, true>(ring, g, S, E); }
        if (split && bx < 128) { const int tt = bx >> 3, ks = bx & 7; float* slab = LDP(float*, 0) + O_Y;
          pg8::Gemm g{(const bf16*)(ws + WS_XN) + (size_t)MP * DM + ks * (DM / 8), (const bf16*)(ws + WS_WCQ) + ks * (DM / 8), MS, XW, DM / 8, DM}; pg8::OneUnit S{{tt & 7, tt >> 3}};
          pg8::EpiSlab E{slab + (size_t)(ks * 16 + tt) * 65536};
          pg8::gemm_phase<pg8::EpiSlab, pg8::OneUnit, true, true>(ring, g, S, E); }
        if (BOTH(10)) GRID_BAR();
    }
    if (IN(11)) {
        IDS();
        unsigned char* ws = LDP(unsigned char*, 1);
        char* al = (char*)lds + RING_OFF;
        for (int u = F.vcu; u < 640; u += G) {
            const bool smp = u >= 512;
            cross_unit(F, ws, al, smp, smp ? ((u - 512) >> 2) : (u >> 8), smp ? ((u - 512) & 3) : ((u >> 6) & 3), smp ? 0 : (u & 63), (G == 256) ? LDP(const float*, 0) + O_Y : nullptr);
        }
        __syncthreads();
        if (BOTH(11)) GRID_BAR();
    }
    if (IN(12)) {
        unsigned char* ws = LDP(unsigned char*, 1); const bool split = (G == 256);
        { pg8::Gemm g{(const bf16*)(ws + WS_QX), (const bf16*)(ws + WS_WCO), split ? MP : MTOT, DM, XW}; pg8::StaticOrder S; S.init(split ? MP : MTOT, DM, G, bx, PANEL_REV);
          pg8::EpiResidH<false> E{(bf16*)(ws + WS_XN), LDP(const float*, 6), LDP(const float*, 7), nullptr, 1.0f, (float*)(ws + WS_SSQ)};
          pg8::gemm_phase<pg8::EpiResidH<false>, pg8::StaticOrder, true, true>(ring, g, S, E); }
        if (split) { const int tt = bx >> 2, ks = bx & 3; float* slab = LDP(float*, 0) + O_Y;
          pg8::Gemm g{(const bf16*)(ws + WS_QX) + (size_t)MP * XW + ks * (XW / 4), (const bf16*)(ws + WS_WCO) + ks * (XW / 4), MS, DM, XW / 4, XW}; pg8::OneUnit S{{tt & 7, tt >> 3}};
          pg8::EpiSlab E{slab + (size_t)(ks * 64 + tt) * 65536};
          pg8::gemm_phase<pg8::EpiSlab, pg8::OneUnit, true, true>(ring, g, S, E); }
        if (BOTH(12)) GRID_BAR();
    }
    if (IN(13)) { IDS(); unsigned char* ws = LDP(unsigned char*, 1); const bool split = (G == 256); rstd_phase(F, ws, split ? MP : MTOT);
        if (split) fixup_rows<1, false>(F, ws, LDP(const float*, 0) + O_Y, nullptr, LDP(const float*, 6), LDP(const float*, 7), 1.0f, nullptr);
        if (BOTH(13)) GRID_BAR(); }
    if (IN(14)) {
        unsigned char* ws = LDP(unsigned char*, 1);
        pg8::Gemm g{(const bf16*)(ws + WS_XN), (const bf16*)(ws + WS_W2GU), MTOT, 2 * FF, DM}; pg8::StaticOrder S; S.init(MTOT, 2 * FF, G, bx, 0, WGM_GU);
        pg8::EpiSwiGLU E{(bf16*)(ws + WS_A), FF, (const float*)(ws + WS_RSTD), A_BLOCKED};
        pg8::gemm_phase<pg8::EpiSwiGLU, pg8::StaticOrder, true, true>(ring, g, S, E);
        if (BOTH(14)) GRID_BAR();
    }
    if (IN(15)) {
        unsigned char* ws = LDP(unsigned char*, 1); const bool split = (G == 256);
        { pg8::Gemm g{(const bf16*)(ws + WS_A), (const bf16*)(ws + WS_W2D), split ? MP : MTOT, DM, FF, 0, A_BLOCKED}; pg8::StaticOrder S; S.init(split ? MP : MTOT, DM, G, bx, PANEL_REV);
          pg8::EpiResidH<false> E{(bf16*)(ws + WS_XN), LDP(const float*, 7), LDP(const float*, 9), nullptr, 0.5f, (float*)(ws + WS_SSQ)};
          pg8::gemm_phase<pg8::EpiResidH<false>, pg8::StaticOrder, true, true>(ring, g, S, E); }
        if (split) { const int tt = bx >> 2, ks = bx & 3; float* slab = (float*)(ws + WS_SLAB15);
          pg8::Gemm g{(const bf16*)(ws + WS_A) + (size_t)MP * FF + (A_BLOCKED ? (size_t)ks * (FF / 4 / 64) * (256 * 64) : (size_t)ks * (FF / 4)), (const bf16*)(ws + WS_W2D) + ks * (FF / 4), MS, DM, FF / 4, FF, A_BLOCKED}; pg8::OneUnit S{{tt & 7, tt >> 3}};
          pg8::EpiSlab E{slab + (size_t)(ks * 64 + tt) * 65536};
          pg8::gemm_phase<pg8::EpiSlab, pg8::OneUnit, true, true>(ring, g, S, E); }
        if (BOTH(15)) GRID_BAR();
    }
    if (IN(16)) { IDS(); unsigned char* ws = LDP(unsigned char*, 1); float* out = LDP(float*, 0); const bool split = (G == 256); final_phase(F, ws, out, split ? MP : MTOT);
        if (split) fixup_rows<1, true>(F, ws, (const float*)(ws + WS_SLAB15), nullptr, LDP(const float*, 7), LDP(const float*, 9), 0.5f, out + O_Y); }
#undef IN
#undef BOTH
#undef GRID_BAR
#undef LDP
#undef IDS
}

extern "C" void kernel_launch(void* const* d_in, const int* in_sizes, int n_in, void* d_out, int out_size, void* d_ws, size_t ws_size, hipStream_t stream) {
    static int grid = 0;
    if (grid == 0) {
        if (n_in != 33 || (size_t)out_size != O_TOTAL || ws_size < WS_END) { fprintf(stderr, "kernel_launch: shape mismatch: n_in %d out %d ws %zu (need 33, %zu, >= %zu)\n", n_in, out_size, ws_size, (size_t)O_TOTAL, (size_t)WS_END); grid = -1; return; }
        int dev = 0, cus = 0, per_cu = 0;
        if (hipGetDevice(&dev) != hipSuccess || hipDeviceGetAttribute(&cus, hipDeviceAttributeMultiprocessorCount, dev) != hipSuccess) { grid = -1; return; }
        if (hipFuncSetAttribute((const void*)mega_fwd, hipFuncAttributeMaxDynamicSharedMemorySize, LDS_BYTES) != hipSuccess) { fprintf(stderr, "kernel_launch: hipFuncSetAttribute failed\n"); grid = -1; return; }
        if (hipOccupancyMaxActiveBlocksPerMultiprocessor(&per_cu, (const void*)mega_fwd, NWAVES * 64, LDS_BYTES) != hipSuccess || per_cu < 1)
            fprintf(stderr, "kernel_launch: note: occupancy query reports %d workgroups per CU\n", per_cu);
        (void)hipGetLastError();
        grid = cus;
    }
    if (grid < 0) return;
    if (hipMemsetAsync((char*)d_ws + WS_CTL, 0, CTL_ZERO_BYTES, stream) != hipSuccess) return;
    Args a{};
    for (int i = 0; i < 33; ++i) a.in[i] = (const float*)d_in[i];
    a.out = (float*)d_out; a.ws = (unsigned char*)d_ws;
    if (N_LAUNCHES == 1) { a.ph_lo = 0; a.ph_hi = N_PHASES; a.li = 0; hipLaunchKernelGGL(mega_fwd, dim3(grid), dim3(NWAVES * 64), LDS_BYTES, stream, a); }
    else for (int p = 0; p < N_PHASES; ++p) { a.ph_lo = p; a.ph_hi = p + 1; a.li = p; hipLaunchKernelGGL(mega_fwd, dim3(grid), dim3(NWAVES * 64), LDS_BYTES, stream, a); }
    const hipError_t le = hipPeekAtLastError();
    if (le != hipSuccess) fprintf(stderr, "kernel_launch: launch failed: %s\n", hipGetErrorName(le));
}
```

```cpp
#include <hip/hip_runtime.h>
#include <cstdio>
#include <cstdint>
#include <cmath>

constexpr int DM = 2048, SEQ = 16384, NBP = 2, MP = NBP * SEQ, DB = 32, DT = 64, MS = DB * DT, MTOT = MP + MS;
constexpr int PAST = 1024, FF = 5632, NMEM = 256, XW = 512, CBR = 512;
constexpr int KDAS_ROWS = PAST + DT  , KCBS_ROWS = CBR + DT  ;
constexpr float EPS = 1e-6f, LOG2E = 1.4426950408889634f;
constexpr float SC_DA = 0.125f * LOG2E, SC_CB = 0.08838834764831845f * LOG2E;
constexpr float LAM_INIT = 0.2f;

constexpr size_t MiB = 1u << 20;
constexpr size_t WS_CTL = 0, CTL_ZERO_BYTES = 1 * MiB;
constexpr size_t WS_SSQ = 1 * MiB;
constexpr size_t WS_RSTD = 6 * MiB;
constexpr size_t WS_LUT = 6 * MiB + 512 * 1024;
constexpr size_t WS_XM = 7 * MiB;
constexpr size_t WS_MKP = 9 * MiB, WS_MVP = 9 * MiB + 512 * 1024;
constexpr size_t WS_MKS = 10 * MiB, WS_MVS = 18 * MiB;
constexpr size_t WS_W1GU = 26 * MiB, WS_W1D = 70 * MiB, WS_WQKV = 92 * MiB, WS_WG = 116 * MiB, WS_WBR = 132 * MiB, WS_WO = 140 * MiB;
constexpr size_t WS_WMKV = 148 * MiB, WS_WCQ = 152 * MiB, WS_WCO = 154 * MiB, WS_W2GU = 156 * MiB, WS_W2D = 200 * MiB;
constexpr size_t WS_XN = 222 * MiB;
constexpr size_t WS_QX = 358 * MiB;
constexpr size_t WS_STASH = WS_QX;
constexpr size_t WS_R = 392 * MiB;
constexpr size_t WS_A = WS_R;
constexpr size_t WS_QO = WS_R;
constexpr size_t WS_KDAP = 528 * MiB, WS_VDAP = 592 * MiB, WS_KCBP = 656 * MiB, WS_VCBP = 720 * MiB;
constexpr size_t WS_KDAS = 784 * MiB, WS_VDAS = 852 * MiB;
constexpr size_t WS_KCBS = 920 * MiB, WS_VCBS = 956 * MiB;
constexpr size_t WS_GR = 528 * MiB, WS_GB = 664 * MiB;
constexpr size_t WS_MIX = 800 * MiB;
constexpr size_t WS_END = 992 * MiB;
static_assert(WS_A + (size_t)MTOT * FF * 2 <= WS_KDAS, "A1/A2 must not reach the sample K/V buffers");
static_assert(WS_GB + (size_t)MTOT * DM * 2 <= WS_MIX && WS_MIX + (size_t)MTOT * DM * 2 <= WS_END, "ws map");
static_assert(WS_VCBS + (size_t)DB * KCBS_ROWS * 1024 * 2 <= WS_END, "ws map");
static_assert(WS_XN + (size_t)MTOT * DM * 2 <= WS_QX && WS_QX + (size_t)MTOT * XW * 2 <= WS_R, "ws map");

constexpr size_t O_Y = 0, O_DAKP = (size_t)MTOT * DM, O_DAVP = O_DAKP + (size_t)MP * 1024, O_CBKP = O_DAVP + (size_t)MP * 1024, O_CBVP = O_CBKP + (size_t)NBP * CBR * 1024;
constexpr size_t O_MKP = O_CBVP + (size_t)NBP * CBR * 1024, O_MVP = O_MKP + (size_t)NBP * NMEM * XW, O_DAKS = O_MVP + (size_t)NBP * NMEM * XW, O_DAVS = O_DAKS + (size_t)MS * 1024;
constexpr size_t O_CBKS = O_DAVS + (size_t)MS * 1024, O_CBVS = O_CBKS + (size_t)DB * CBR * 1024, O_TOTAL = O_CBVS + (size_t)DB * CBR * 1024;
static_assert(O_TOTAL == 178782208, "output size");

constexpr int CW_TMO = 0, CW_CODE = 1, CW_BAR = 4096;

constexpr int RING_OFF = 0, RING_BYTES = 131072, LDSCTL_OFF = 137216  , MISC_OFF = LDSCTL_OFF + 320, LDS_BYTES = 147456;
constexpr int NWAVES = 8;
namespace pg8 {
#define PG8_LAS __attribute__((address_space(3)))
typedef unsigned short bf16_t;
typedef short bf16x8 __attribute__((ext_vector_type(8)));
typedef float f32x4 __attribute__((ext_vector_type(4)));
typedef unsigned u32x4 __attribute__((ext_vector_type(4)));
constexpr int BM = 256, BK = 64, HALF = 128, HTB = HALF * BK * 2  , STAGE_BYTES = 8 * HTB, NXCD = 8, WGM = 4;

__host__ __device__ __forceinline__ int lds_byte(int r, int c) { const int st = (r >> 4) * 2 + (c >> 5), rr = r & 15, cc = c & 31, ob = rr * 64 + cc * 2; return st * 1024 + (ob ^ (((ob >> 9) & 1) << 5)); }
__host__ __device__ __forceinline__ void stage_rc(int b, int& R, int& C) { const int st = b / 1024, sb = b % 1024, swz = sb ^ (((sb >> 9) & 1) << 5); R = (st >> 1) * 16 + swz / 64; C = (st & 1) * 32 + (swz % 64) / 2; }
__host__ __device__ __forceinline__ int perm32(int rho) { const int n = rho >> 4, i = rho & 15; return 8 * (i >> 2) + 4 * n + (i & 3); }

#ifndef PN_ROT
#define PN_ROT 0
#endif
struct Unit { int pm, pn; };
struct Gemm { const bf16_t* A; const bf16_t* Bt; int M, N, K; int ld = 0; int ablk = 0; };
struct OneUnit { Unit u; __host__ __device__ bool next(int i, Unit& o) const { if (i) return false; o = u; return true; } __device__ __forceinline__ void a_ready(const Unit&) const {} __device__ __forceinline__ void done(const Unit&) const {} };

struct StaticOrder {
    int nM, nN, nwg, G, c; int rev = 0; int wgm = WGM;
    __host__ __device__ void init(int M, int N, int G_, int c_, int rev_ = 0, int wgm_ = WGM) { nM = M / BM; nN = N / BM; nwg = nM * nN; G = G_; c = c_; rev = rev_; wgm = wgm_; }
    __host__ __device__ bool next(int i, Unit& u) const {
        const long L = (long)i * G + c; if (L >= nwg) return false;
        int wgid = (int)L; { const int q = nwg / NXCD, r = nwg % NXCD, xcd = wgid % NXCD, off = wgid / NXCD; wgid = (xcd < r ? xcd * (q + 1) : r * (q + 1) + (xcd - r) * q) + off; }
        const int nig = wgm * nN, gid = wgid / nig, fm = gid * wgm, gsz = (nM - fm) < wgm ? (nM - fm) : wgm;
        u.pm = fm + ((wgid % nig) % gsz); u.pn = (wgid % nig) / gsz; if (rev) u.pm = nM - 1 - u.pm;
        if (PN_ROT) u.pn = (u.pn + gid * PN_ROT) % nN;
        return true;
    }
    __device__ __forceinline__ void a_ready(const Unit&) const {}
    __device__ __forceinline__ void done(const Unit&) const {}
};

__device__ __forceinline__ unsigned cvt_pk_bf16(float lo, float hi) { unsigned r; asm volatile("v_cvt_pk_bf16_f32 %0, %1, %2" : "=v"(r) : "v"(lo), "v"(hi)); return r; }
typedef float f32x2 __attribute__((ext_vector_type(2)));
#define GAS_ __attribute__((address_space(1)))
__device__ __forceinline__ float sigm(float x) { return __builtin_amdgcn_rcpf(1.f + __builtin_amdgcn_exp2f(-1.4426950408889634f * x)); }
__device__ __forceinline__ u32x4 pack8(const f32x4 a, const f32x4 b) { u32x4 w; w.x = cvt_pk_bf16(a[0], a[1]); w.y = cvt_pk_bf16(a[2], a[3]); w.z = cvt_pk_bf16(b[0], b[1]); w.w = cvt_pk_bf16(b[2], b[3]); return w; }
__device__ __forceinline__ void unpack8(const u32x4 w, f32x4& a, f32x4& b) {
    a[0] = __uint_as_float(w.x << 16); a[1] = __uint_as_float(w.x & 0xffff0000u); a[2] = __uint_as_float(w.y << 16); a[3] = __uint_as_float(w.y & 0xffff0000u);
    b[0] = __uint_as_float(w.z << 16); b[1] = __uint_as_float(w.z & 0xffff0000u); b[2] = __uint_as_float(w.w << 16); b[3] = __uint_as_float(w.w & 0xffff0000u); }

struct EpiSwiGLU {
    static constexpr bool PERM = true, AFTER_DRAIN = false, MIDK = false;
    bf16_t* O; int ldc; const float* rstd; int blk;
    __device__ __forceinline__ void operator()(const f32x4 (&acc)[2][2][4][2], const Unit& u, int wr, int wc, int fr, int fq) const {
        asm volatile("" : "+v"(fr), "+v"(fq));
        const int row0 = u.pm * BM + wr * 64 + fr, col0 = u.pn * HALF + wc * 32 + 8 * fq;
#pragma unroll
        for (int ai = 0; ai < 2; ++ai)
#pragma unroll
            for (int m = 0; m < 4; ++m) {
                const int row = row0 + ai * HALF + m * 16; const float rs = rstd ? ((const GAS_ float*)rstd)[row] : 1.f;
                f32x4 o[2];
#pragma unroll
                for (int n = 0; n < 2; ++n) { const f32x4 g = acc[ai][0][m][n] * rs, up = acc[ai][1][m][n] * rs;
#pragma unroll
                    for (int e = 0; e < 4; ++e) o[n][e] = g[e] * sigm(g[e]) * up[e]; }
                if (blk) *(GAS_ u32x4*)(O + (size_t)(row >> 8) * ((size_t)BM * ldc) + (size_t)(col0 >> 6) * (BM * BK) + (row & 255) * BK + (col0 & 63)) = pack8(o[0], o[1]);
                else *(GAS_ u32x4*)(O + (size_t)row * ldc + col0) = pack8(o[0], o[1]);
            }
    }
};

struct EpiResidX {
    static constexpr bool PERM = true, AFTER_DRAIN = false, MIDK = false;
    const float* base_p; const float* base_s; float alpha; const float* gnext; bf16_t* HG; float* ssq;
    __device__ __forceinline__ void operator()(const f32x4 (&acc)[2][2][4][2], const Unit& u, int wr, int wc, int fr, int fq) const {
        asm volatile("" : "+v"(fr), "+v"(fq));
        const int row0 = u.pm * BM + wr * 64 + fr, col0 = u.pn * BM + wc * 32 + 8 * fq;
        const float* base = (u.pm < MP / BM) ? base_p : base_s;
        f32x4 gn[2][2];
#pragma unroll
        for (int bj = 0; bj < 2; ++bj)
#pragma unroll
            for (int n = 0; n < 2; ++n) gn[bj][n] = *(const GAS_ f32x4*)(gnext + col0 + bj * HALF + 4 * n);
#pragma unroll
        for (int ai = 0; ai < 2; ++ai) {
#pragma unroll
            for (int mh = 0; mh < 2; ++mh) {
                f32x4 xb[2][2][2];
#pragma unroll
                for (int mm = 0; mm < 2; ++mm)
#pragma unroll
                    for (int bj = 0; bj < 2; ++bj)
#pragma unroll
                        for (int n = 0; n < 2; ++n) xb[mm][bj][n] = *(const GAS_ f32x4*)(base + (size_t)(row0 + ai * HALF + (2 * mh + mm) * 16) * DM + col0 + bj * HALF + 4 * n);
#pragma unroll
                for (int mm = 0; mm < 2; ++mm) { const int m = 2 * mh + mm;
                    const int row = row0 + ai * HALF + m * 16; const size_t off = (size_t)row * DM + col0; float ss = 0.f;
#pragma unroll
                    for (int bj = 0; bj < 2; ++bj) { f32x4 v[2];
#pragma unroll
                        for (int n = 0; n < 2; ++n) { v[n] = xb[mm][bj][n] + acc[ai][bj][m][n] * alpha; ss += (v[n][0] * v[n][0] + v[n][1] * v[n][1]) + (v[n][2] * v[n][2] + v[n][3] * v[n][3]); }
                        *(GAS_ u32x4*)(HG + off + bj * HALF) = pack8(v[0] * gn[bj][0], v[1] * gn[bj][1]); }
                    ss += __shfl_xor(ss, 16); ss += __shfl_xor(ss, 32);
                    if (fq == 0) ((GAS_ float*)ssq)[(size_t)row * 32 + u.pn * 4 + wc] = ss;
                }
            }
        }
    }
};
template <bool OUT_F32> struct EpiResidH {
    static constexpr bool PERM = true, AFTER_DRAIN = false, MIDK = false;
    bf16_t* HG; const float* gprev; const float* gnext; float* outf; float alpha; float* ssq;
    __device__ __forceinline__ void operator()(const f32x4 (&acc)[2][2][4][2], const Unit& u, int wr, int wc, int fr, int fq) const {
        asm volatile("" : "+v"(fr), "+v"(fq));
        const int row0 = u.pm * BM + wr * 64 + fr, col0 = u.pn * BM + wc * 32 + 8 * fq;
        f32x4 rg[2][2], gn[2][2];
#pragma unroll
        for (int bj = 0; bj < 2; ++bj)
#pragma unroll
            for (int n = 0; n < 2; ++n) { const f32x4 g = *(const GAS_ f32x4*)(gprev + col0 + bj * HALF + 4 * n);
#pragma unroll
                for (int e = 0; e < 4; ++e) rg[bj][n][e] = 1.0f / g[e];
                gn[bj][n] = OUT_F32 ? (f32x4){0.f, 0.f, 0.f, 0.f} : *(const GAS_ f32x4*)(gnext + col0 + bj * HALF + 4 * n); }
#pragma unroll
        for (int ai = 0; ai < 2; ++ai) {
            u32x4 hb[4][2];
#pragma unroll
            for (int m = 0; m < 4; ++m)
#pragma unroll
                for (int bj = 0; bj < 2; ++bj) hb[m][bj] = *(const GAS_ u32x4*)(HG + (size_t)(row0 + ai * HALF + m * 16) * DM + col0 + bj * HALF);
#pragma unroll
            for (int m = 0; m < 4; ++m) {
                const int row = row0 + ai * HALF + m * 16; const size_t off = (size_t)row * DM + col0; float ss = 0.f;
#pragma unroll
                for (int bj = 0; bj < 2; ++bj) { f32x4 h0, h1; unpack8(hb[m][bj], h0, h1);
                    const f32x4 v0 = h0 * rg[bj][0] + acc[ai][bj][m][0] * alpha, v1 = h1 * rg[bj][1] + acc[ai][bj][m][1] * alpha;
                    ss += (v0[0] * v0[0] + v0[1] * v0[1]) + (v0[2] * v0[2] + v0[3] * v0[3]) + (v1[0] * v1[0] + v1[1] * v1[1]) + (v1[2] * v1[2] + v1[3] * v1[3]);
                    if (OUT_F32) { *(GAS_ f32x4*)(outf + off + bj * HALF) = v0; *(GAS_ f32x4*)(outf + off + bj * HALF + 4) = v1; }
                    else *(GAS_ u32x4*)(HG + off + bj * HALF) = pack8(v0 * gn[bj][0], v1 * gn[bj][1]); }
                ss += __shfl_xor(ss, 16); ss += __shfl_xor(ss, 32);
                if (fq == 0) ((GAS_ float*)ssq)[(size_t)row * 32 + u.pn * 4 + wc] = ss;
            }
        }
    }
};

struct EpiQKV {
    static constexpr bool PERM = true, AFTER_DRAIN = false, MIDK = false;
    const float* rstd; bf16_t* QO; bf16_t* KVP; bf16_t* KVS_DA; bf16_t* KVS_CB; float* out;
    __device__ __forceinline__ void operator()(const f32x4 (&acc)[2][2][4][2], const Unit& u, int wr, int wc, int fr, int fq) const {
        asm volatile("" : "+v"(fr), "+v"(fq));
        const int reg = u.pn >> 2, cin0 = (u.pn & 3) * BM + wc * 32 + 8 * fq, row0 = u.pm * BM + wr * 64 + fr;
        const bool prompt = u.pm < MP / BM;
        const float sc = reg == 0 ? SC_DA : (reg == 3 ? SC_CB : 1.f);
        const int kv = reg == 1 ? 0 : reg == 2 ? 1 : reg == 4 ? 2 : 3;
        const bool cb = reg >= 4;
#pragma unroll
        for (int ai = 0; ai < 2; ++ai)
#pragma unroll
            for (int m = 0; m < 4; ++m) {
                const int row = row0 + ai * HALF + m * 16; const float rs = ((const GAS_ float*)rstd)[row];
                bf16_t* bd; float* fd = nullptr;
                if (reg == 0) bd = QO + (size_t)row * DM + cin0;
                else if (reg == 3) bd = QO + (size_t)row * DM + 1024 + cin0;
                else if (prompt) {
                    bd = KVP + (size_t)kv * (32u * 1024u * 1024u) + (size_t)row * 1024 + cin0;
                    if (!cb) fd = out + (kv == 0 ? O_DAKP : O_DAVP) + (size_t)row * 1024 + cin0;
                    else { const int t = row & (SEQ - 1), b = row >> 14; if (t >= SEQ - CBR) fd = out + (kv == 2 ? O_CBKP : O_CBVP) + (size_t)(b * CBR + t - (SEQ - CBR)) * 1024 + cin0; }
                } else {
                    const int s = row - MP, b = s >> 6, t = s & 63;
                    if (!cb) { bd = KVS_DA + (size_t)kv * (34u * 1024u * 1024u) + (size_t)(b * KDAS_ROWS + PAST + t) * 1024 + cin0;
                               fd = out + (kv == 0 ? O_DAKS : O_DAVS) + (size_t)s * 1024 + cin0; }
                    else { bd = KVS_CB + (size_t)(kv - 2) * (18u * 1024u * 1024u) + (size_t)(b * KCBS_ROWS + CBR + t) * 1024 + cin0;
                           fd = out + (kv == 2 ? O_CBKS : O_CBVS) + (size_t)(b * CBR + (CBR - DT) + t) * 1024 + cin0; }
                }
#pragma unroll
                for (int bj = 0; bj < 2; ++bj) { const f32x4 v0 = acc[ai][bj][m][0] * rs, v1 = acc[ai][bj][m][1] * rs;
                    *(GAS_ u32x4*)(bd + bj * HALF) = pack8(v0 * sc, v1 * sc);
                    if (fd) { *(GAS_ f32x4*)(fd + bj * HALF) = v0; *(GAS_ f32x4*)(fd + bj * HALF + 4) = v1; } }
            }
    }
};

struct EpiGates {
    static constexpr bool PERM = true, AFTER_DRAIN = false, MIDK = false;
    const float* rstd; const float* bgate; bf16_t* GR; bf16_t* GB;
    __device__ __forceinline__ void operator()(const f32x4 (&acc)[2][2][4][2], const Unit& u, int wr, int wc, int fr, int fq) const {
        asm volatile("" : "+v"(fr), "+v"(fq));
        const int row0 = u.pm * BM + wr * 64 + fr, col0 = u.pn * HALF + wc * 32 + 8 * fq;
        f32x4 ba[2], bb[2];
#pragma unroll
        for (int n = 0; n < 2; ++n) { ba[n] = *(const GAS_ f32x4*)(bgate + col0 + 4 * n); bb[n] = *(const GAS_ f32x4*)(bgate + DM + col0 + 4 * n); }
#pragma unroll
        for (int ai = 0; ai < 2; ++ai)
#pragma unroll
            for (int m = 0; m < 4; ++m) {
                const int row = row0 + ai * HALF + m * 16; const float rs = ((const GAS_ float*)rstd)[row];
                f32x4 r[2], g[2];
#pragma unroll
                for (int n = 0; n < 2; ++n) { const f32x4 za = acc[ai][0][m][n] * rs + ba[n], zb = acc[ai][1][m][n] * rs + bb[n];
#pragma unroll
                    for (int e = 0; e < 4; ++e) { const float xa = fminf(fmaxf(za[e], -30.f), 30.f), xb = fminf(fmaxf(zb[e], -30.f), 30.f);
                        const float ea = 1.f + __builtin_amdgcn_exp2f(-1.4426950408889634f * xa), eb = 1.f + __builtin_amdgcn_exp2f(-1.4426950408889634f * xb);
                        g[n][e] = __builtin_amdgcn_rcpf(eb); r[n][e] = eb * __builtin_amdgcn_rcpf(ea); } }
                *(GAS_ u32x4*)(GR + (size_t)row * DM + col0) = pack8(r[0], r[1]);
                *(GAS_ u32x4*)(GB + (size_t)row * DM + col0) = pack8(g[0], g[1]);
            }
    }
};

struct EpiMix {
    static constexpr bool PERM = true, AFTER_DRAIN = false, MIDK = true;
    const bf16_t* GR; const bf16_t* GB; bf16_t* MIX;
    __device__ __forceinline__ void midk(f32x4 (&acc)[2][2][4][2], const Unit& u, int wr, int wc, int fr, int fq) const {
        asm volatile("" : "+v"(fr), "+v"(fq));
        const int row0 = u.pm * BM + wr * 64 + fr, col0 = u.pn * BM + wc * 32 + 8 * fq;
#pragma unroll
        for (int ai = 0; ai < 2; ++ai) { u32x4 w[4][2];
#pragma unroll
            for (int m = 0; m < 4; ++m)
#pragma unroll
                for (int bj = 0; bj < 2; ++bj) w[m][bj] = *(const GAS_ u32x4*)(GR + (size_t)(row0 + ai * HALF + m * 16) * DM + col0 + bj * HALF);
#pragma unroll
            for (int m = 0; m < 4; ++m)
#pragma unroll
                for (int bj = 0; bj < 2; ++bj) { f32x4 a, b; unpack8(w[m][bj], a, b); acc[ai][bj][m][0] *= a; acc[ai][bj][m][1] *= b; } }
    }
    __device__ __forceinline__ void operator()(const f32x4 (&acc)[2][2][4][2], const Unit& u, int wr, int wc, int fr, int fq) const {
        asm volatile("" : "+v"(fr), "+v"(fq));
        const int row0 = u.pm * BM + wr * 64 + fr, col0 = u.pn * BM + wc * 32 + 8 * fq;
#pragma unroll
        for (int ai = 0; ai < 2; ++ai) { u32x4 w[4][2];
#pragma unroll
            for (int m = 0; m < 4; ++m)
#pragma unroll
                for (int bj = 0; bj < 2; ++bj) w[m][bj] = *(const GAS_ u32x4*)(GB + (size_t)(row0 + ai * HALF + m * 16) * DM + col0 + bj * HALF);
#pragma unroll
            for (int m = 0; m < 4; ++m)
#pragma unroll
                for (int bj = 0; bj < 2; ++bj) { f32x4 a, b; unpack8(w[m][bj], a, b);
                    *(GAS_ u32x4*)(MIX + (size_t)(row0 + ai * HALF + m * 16) * DM + col0 + bj * HALF) = pack8(acc[ai][bj][m][0] * a, acc[ai][bj][m][1] * b); } }
    }
};

struct EpiSlab {
    static constexpr bool PERM = true, AFTER_DRAIN = false, MIDK = false;
    float* slab;
    __device__ __forceinline__ void operator()(const f32x4 (&acc)[2][2][4][2], const Unit& u, int wr, int wc, int fr, int fq) const {
        asm volatile("" : "+v"(fr), "+v"(fq));
        const int r0 = wr * 64 + fr, c0 = wc * 32 + 8 * fq;
#pragma unroll
        for (int ai = 0; ai < 2; ++ai)
#pragma unroll
            for (int m = 0; m < 4; ++m)
#pragma unroll
                for (int bj = 0; bj < 2; ++bj) { GAS_ float* p = (GAS_ float*)slab + (size_t)(r0 + ai * HALF + m * 16) * BM + c0 + bj * HALF;
                    *(GAS_ f32x4*)p = acc[ai][bj][m][0]; *(GAS_ f32x4*)(p + 4) = acc[ai][bj][m][1]; }
    }
};
struct EpiScaleBf16 {
    static constexpr bool PERM = true, AFTER_DRAIN = false, MIDK = false;
    const float* rstd; bf16_t* O; int ldc; float sc;
    __device__ __forceinline__ void operator()(const f32x4 (&acc)[2][2][4][2], const Unit& u, int wr, int wc, int fr, int fq) const {
        asm volatile("" : "+v"(fr), "+v"(fq));
        const int row0 = u.pm * BM + wr * 64 + fr, col0 = u.pn * BM + wc * 32 + 8 * fq;
#pragma unroll
        for (int ai = 0; ai < 2; ++ai)
#pragma unroll
            for (int m = 0; m < 4; ++m) { const int row = row0 + ai * HALF + m * 16; const float rs = ((const GAS_ float*)rstd)[row] * sc;
#pragma unroll
                for (int bj = 0; bj < 2; ++bj) *(GAS_ u32x4*)(O + (size_t)row * ldc + col0 + bj * HALF) = pack8(acc[ai][bj][m][0] * rs, acc[ai][bj][m][1] * rs); }
    }
};

struct EpiMemKV {
    static constexpr bool PERM = true, AFTER_DRAIN = false, MIDK = false;
    bf16_t* MKP; bf16_t* MVP; float* out;
    __device__ __forceinline__ void operator()(const f32x4 (&acc)[2][2][4][2], const Unit& u, int wr, int wc, int fr, int fq) const {
        asm volatile("" : "+v"(fr), "+v"(fq));
        const int row0 = u.pm * BM + wr * 64 + fr, col0 = (u.pn & 1) * BM + wc * 32 + 8 * fq; const bool isv = u.pn >= 2;
        bf16_t* B = isv ? MVP : MKP; float* F = out + (isv ? O_MVP : O_MKP);
#pragma unroll
        for (int ai = 0; ai < 2; ++ai)
#pragma unroll
            for (int m = 0; m < 4; ++m) { const size_t off = (size_t)(row0 + ai * HALF + m * 16) * XW + col0;
#pragma unroll
                for (int bj = 0; bj < 2; ++bj) { *(GAS_ u32x4*)(B + off + bj * HALF) = pack8(acc[ai][bj][m][0], acc[ai][bj][m][1]);
                    *(GAS_ f32x4*)(F + off + bj * HALF) = acc[ai][bj][m][0]; *(GAS_ f32x4*)(F + off + bj * HALF + 4) = acc[ai][bj][m][1]; } }
    }
};
template <class Epi, class Sched, bool ALIGN_EPI = false, bool SP2 = false>
__device__ __forceinline__ void gemm_phase(PG8_LAS unsigned char* lds, const Gemm g, const Sched& S, const Epi& E) {
    int tid_l = threadIdx.x; asm volatile("" : "+v"(tid_l));
    const int tid = tid_l, wid = __builtin_amdgcn_readfirstlane(tid >> 6), lane = tid & 63, wr = wid >> 2, wc = wid & 3, fr = lane & 15, fq = lane >> 4;
    const int K = g.ld ? g.ld : g.K  , nt = g.K / BK;
    unsigned voffA[2], voffB[2];
#pragma unroll
    for (int i = 0; i < 2; ++i) { int R, C; stage_rc(tid * 16 + i * 8192, R, C); const int Rb = Epi::PERM ? ((R & ~31) + perm32(R & 31)) : R;
        voffA[i] = (unsigned)(R * (g.ablk ? BK : K) + C) * 2u; voffB[i] = (unsigned)(Rb * K + C) * 2u; }
    const size_t kstep = (size_t)(BK * 2);
    const size_t hstep = (size_t)HALF * K * 2;
    const size_t tstep = 2 * hstep;
    const size_t kstepA = g.ablk ? (size_t)BM * BK * 2 : kstep, hstepA = g.ablk ? (size_t)HALF * BK * 2 : hstep;
    const unsigned ldsw = (unsigned)wid * 1024u;
    const int aoff = lds_byte(wr * 64 + fr, fq * 8), boff = lds_byte(wc * 32 + fr, fq * 8);
#define PG8_SA(b, h) (((b) * 2 + (h)) * HTB)
#define PG8_SB(b, h) ((4 + (b) * 2 + (h)) * HTB)
#define PG8_STAGE(bufoff, gbase, voff) do { _Pragma("unroll") for (int _i = 0; _i < 2; ++_i) \
        __builtin_amdgcn_global_load_lds((const unsigned*)((const char*)(gbase) + (voff)[_i]), (PG8_LAS unsigned*)(lds + (bufoff) + ldsw + _i * 8192), 16, 0, 0); } while (0)
#define PG8_LDA(dst, b, h) do { _Pragma("unroll") for (int m = 0; m < 4; ++m) _Pragma("unroll") for (int k = 0; k < 2; ++k) dst[m][k] = *(const PG8_LAS bf16x8*)(lds + PG8_SA(b, h) + aoff + m * 2048 + k * 1024); } while (0)
#define PG8_LDB(dst, b, h) do { _Pragma("unroll") for (int n = 0; n < 2; ++n) _Pragma("unroll") for (int k = 0; k < 2; ++k) dst[n][k] = *(const PG8_LAS bf16x8*)(lds + PG8_SB(b, h) + boff + n * 2048 + k * 1024); } while (0)
#define PG8_MMA(ai, bj, At, Bt) do { __builtin_amdgcn_s_setprio(1); _Pragma("unroll") for (int m = 0; m < 4; ++m) _Pragma("unroll") for (int n = 0; n < 2; ++n) _Pragma("unroll") for (int k = 0; k < 2; ++k) \
        acc[ai][bj][m][n] = __builtin_amdgcn_mfma_f32_16x16x32_bf16(Bt[n][k], At[m][k], acc[ai][bj][m][n], 0, 0, 0); __builtin_amdgcn_s_setprio(0); } while (0)
#define PG8_WAIT_V(n) asm volatile("s_waitcnt vmcnt(" #n ")" ::: "memory")
#define PG8_WAIT_L(n) asm volatile("s_waitcnt lgkmcnt(" #n ")" ::: "memory")
#define PG8_BAR __builtin_amdgcn_s_barrier()
#define PG8_SCHED __builtin_amdgcn_sched_barrier(0)
    Unit cur, nxt; int ui = 0;
    if (!S.next(0, cur)) return;
    f32x4 acc[2][2][4][2];
#pragma unroll
    for (int a = 0; a < 2; ++a)
#pragma unroll
        for (int b = 0; b < 2; ++b)
#pragma unroll
            for (int m = 0; m < 4; ++m)
#pragma unroll
                for (int n = 0; n < 2; ++n) acc[a][b][m][n] = (f32x4){0.f, 0.f, 0.f, 0.f};
    bf16x8 At[4][2], B0[2][2], B1[2][2];
    const char* cA = (const char*)g.A + (size_t)cur.pm * tstep; const char* cB = (const char*)g.Bt + (size_t)cur.pn * tstep;
    S.a_ready(cur);
    if constexpr (SP2) {
        PG8_STAGE(PG8_SB(0, 0), cB, voffB); PG8_STAGE(PG8_SB(0, 1), cB + hstep, voffB); PG8_STAGE(PG8_SA(0, 0), cA, voffA); PG8_STAGE(PG8_SA(0, 1), cA + hstepA, voffA);
        if (wr == 1) PG8_BAR;
        PG8_WAIT_V(2); PG8_BAR;
        PG8_STAGE(PG8_SB(1, 0), cB + kstep, voffB); PG8_STAGE(PG8_SA(1, 0), cA + kstepA, voffA); PG8_STAGE(PG8_SB(1, 1), cB + hstep + kstep, voffB);
        PG8_WAIT_V(6); PG8_BAR;
    } else {
        PG8_STAGE(PG8_SB(0, 0), cB, voffB); PG8_STAGE(PG8_SA(0, 0), cA, voffA); PG8_STAGE(PG8_SB(0, 1), cB + hstep, voffB); PG8_STAGE(PG8_SA(0, 1), cA + hstepA, voffA);
        if (wr == 1) PG8_BAR;
        PG8_WAIT_V(4); PG8_BAR;
        PG8_STAGE(PG8_SB(1, 0), cB + kstep, voffB); PG8_STAGE(PG8_SA(1, 0), cA + kstepA, voffA); PG8_STAGE(PG8_SB(1, 1), cB + hstep + kstep, voffB);
        PG8_WAIT_V(6); PG8_BAR;
    }
    for (;;) {
        const bool has_next = S.next(ui + 1, nxt);
        const char* nA = has_next ? (const char*)g.A + (size_t)nxt.pm * tstep : cA; const char* nB = has_next ? (const char*)g.Bt + (size_t)nxt.pn * tstep : cB;
        for (int t = 0; t < nt; t += 2) {
            const bool last = (t == nt - 2);
            const char* a1 = cA + (size_t)(t + 1) * kstepA;
            const char* a2 = last ? nA : cA + (size_t)(t + 2) * kstepA; const char* b2 = last ? nB : cB + (size_t)(t + 2) * kstep;
            const char* a3 = a2 + kstepA; const char* b3 = b2 + kstep;
            if (last && has_next) S.a_ready(nxt);
            if constexpr (Epi::MIDK) { if (t == nt / 2) E.midk(acc, cur, wr, wc, fr, fq); }
            if constexpr (SP2) {
            PG8_LDB(B0, 0, 0); PG8_LDB(B1, 0, 1); PG8_SCHED; PG8_LDA(At, 0, 0); PG8_STAGE(PG8_SA(1, 1), a1 + hstepA, voffA);
            PG8_WAIT_V(8); PG8_WAIT_L(0); PG8_BAR; PG8_MMA(0, 0, At, B0); PG8_MMA(0, 1, At, B1); PG8_BAR; PG8_SCHED;
            PG8_LDA(At, 0, 1); PG8_STAGE(PG8_SB(0, 0), b2, voffB); PG8_STAGE(PG8_SB(0, 1), b2 + hstep, voffB); PG8_STAGE(PG8_SA(0, 0), a2, voffA);
            PG8_WAIT_V(8); PG8_WAIT_L(0); PG8_BAR; PG8_MMA(1, 0, At, B0); PG8_MMA(1, 1, At, B1); PG8_BAR; PG8_SCHED;
            PG8_LDB(B0, 1, 0); PG8_LDB(B1, 1, 1); PG8_SCHED; PG8_LDA(At, 1, 0); PG8_STAGE(PG8_SA(0, 1), a2 + hstepA, voffA);
            PG8_WAIT_V(8); PG8_WAIT_L(0); PG8_BAR; PG8_MMA(0, 0, At, B0); PG8_MMA(0, 1, At, B1); PG8_BAR; PG8_SCHED;
            PG8_LDA(At, 1, 1); PG8_STAGE(PG8_SB(1, 0), b3, voffB); PG8_STAGE(PG8_SB(1, 1), b3 + hstep, voffB); PG8_STAGE(PG8_SA(1, 0), a3, voffA);
            PG8_WAIT_V(8); PG8_WAIT_L(0); PG8_BAR; PG8_MMA(1, 0, At, B0); PG8_MMA(1, 1, At, B1); PG8_BAR; PG8_SCHED;
            } else {
            PG8_LDB(B0, 0, 0); PG8_SCHED; PG8_LDA(At, 0, 0); PG8_STAGE(PG8_SA(1, 1), a1 + hstepA, voffA);
            PG8_WAIT_L(8); PG8_BAR; PG8_WAIT_L(0); PG8_MMA(0, 0, At, B0); PG8_BAR; PG8_SCHED;
            PG8_LDB(B1, 0, 1); PG8_STAGE(PG8_SB(0, 0), b2, voffB);
            PG8_BAR; PG8_WAIT_L(0); PG8_MMA(0, 1, At, B1); PG8_BAR;
            PG8_LDA(At, 0, 1); PG8_STAGE(PG8_SA(0, 0), a2, voffA);
            PG8_BAR; PG8_WAIT_L(0); PG8_MMA(1, 0, At, B0); PG8_BAR; PG8_SCHED;
            PG8_STAGE(PG8_SB(0, 1), b2 + hstep, voffB);
            PG8_WAIT_V(6); PG8_BAR; PG8_MMA(1, 1, At, B1); PG8_BAR;
            PG8_LDB(B0, 1, 0); PG8_SCHED; PG8_LDA(At, 1, 0); PG8_STAGE(PG8_SA(0, 1), a2 + hstepA, voffA);
            PG8_WAIT_L(8); PG8_BAR; PG8_WAIT_L(0); PG8_MMA(0, 0, At, B0); PG8_BAR; PG8_SCHED;
            PG8_LDB(B1, 1, 1); PG8_STAGE(PG8_SB(1, 0), b3, voffB);
            PG8_BAR; PG8_WAIT_L(0); PG8_MMA(0, 1, At, B1); PG8_BAR;
            PG8_LDA(At, 1, 1); PG8_STAGE(PG8_SA(1, 0), a3, voffA);
            PG8_BAR; PG8_WAIT_L(0); PG8_MMA(1, 0, At, B0); PG8_BAR; PG8_SCHED;
            PG8_STAGE(PG8_SB(1, 1), b3 + hstep, voffB);
            PG8_WAIT_V(6); PG8_BAR; PG8_MMA(1, 1, At, B1); PG8_BAR;
            }
        }
        if constexpr (ALIGN_EPI) { if (wr == 0) PG8_BAR; }
        if constexpr (!Epi::AFTER_DRAIN) { E(acc, cur, wr, wc, fr, fq); S.done(cur); }
        if (!has_next) break;
#pragma unroll
        for (int a = 0; a < 2; ++a)
#pragma unroll
            for (int b = 0; b < 2; ++b)
#pragma unroll
                for (int m = 0; m < 4; ++m)
#pragma unroll
                    for (int n = 0; n < 2; ++n) acc[a][b][m][n] = (f32x4){0.f, 0.f, 0.f, 0.f};
        cur = nxt; cA = nA; cB = nB; ++ui;
        if constexpr (ALIGN_EPI) { if (wr == 1) PG8_BAR; }
    }
    PG8_WAIT_V(0);
    if constexpr (!ALIGN_EPI) { if (wr == 0) PG8_BAR; }
    PG8_BAR;
    if constexpr (Epi::AFTER_DRAIN) { E.fused(acc, cur, wr, wc, fr, fq, lds, wid, lane); S.done(cur); }
#undef PG8_SA
#undef PG8_SB
#undef PG8_STAGE
#undef PG8_LDA
#undef PG8_LDB
#undef PG8_MMA
#undef PG8_WAIT_V
#undef PG8_WAIT_L
#undef PG8_BAR
#undef PG8_SCHED
}
}

namespace att {
typedef unsigned short bf16;
using bf16x8 = __attribute__((ext_vector_type(8))) short;
using s16x4  = __attribute__((ext_vector_type(4))) short;
using f32x16 = __attribute__((ext_vector_type(16))) float;
using u32x4  = __attribute__((ext_vector_type(4))) unsigned;
constexpr int NW = 8, QBLK = 32, KVBLK = 64, DV = 128;
constexpr float THR = 8.f;
constexpr int LDS_V = 0, LDS_K = 65536, LDS_WS = 114688, LDS_LUT = 114688 + 2048, LDS_OSTAGE = 0, LDS_ATT_BYTES = LDS_LUT + 320 * 4;
#define ATT_SBAR() __builtin_amdgcn_sched_barrier(0)
#define ATT_GCP const __attribute__((address_space(1))) char*
#define ATT_GVP const __attribute__((address_space(1))) bf16x8*
__device__ __forceinline__ int crow(int r, int hi) { return (r & 3) + 8 * (r >> 2) + 4 * hi; }
__device__ __forceinline__ unsigned cvtpk(float lo, float hi) { unsigned r; asm volatile("v_cvt_pk_bf16_f32 %0, %1, %2" : "=v"(r) : "v"(lo), "v"(hi)); return r; }
template <int DQK> __device__ __forceinline__ int kswz(int row, int colB) { return row * (DQK * 2) + (colB ^ ((row & 7) << 4)); }

__device__ __forceinline__ int v_st(int k, int c) { const int kk = (k & ~0xC) | ((k & 4) << 1) | ((k & 8) >> 1); return ((kk >> 3) * 4 + (c >> 5)) * 512 + ((kk & 7) * 32 + (c & 31)) * 2; }
__device__ __forceinline__ int v_rd_base(int lane) { return ((lane & 3) << 3) | (((lane >> 2) & 3) << 6) | (((lane >> 4) & 1) << 5) | (((lane >> 5) & 1) << 8); }
constexpr int v_rd_off(int d0, int ks, int half) { return d0 * 512 + ks * 4096 + half * 2048; }
template <int OFF> __device__ __forceinline__ s16x4 tr_read(int vb) { s16x4 r; asm volatile("ds_read_b64_tr_b16 %0, %1 offset:%2" : "=&v"(r) : "v"(vb), "i"(OFF) : "memory"); return r; }
template <int KS> __device__ __forceinline__ void pv_ks(f32x16* o, int vb, bf16x8 pa) {
  const s16x4 l0 = tr_read<v_rd_off(0, KS, 0)>(vb), h0 = tr_read<v_rd_off(0, KS, 1)>(vb), l1 = tr_read<v_rd_off(1, KS, 0)>(vb), h1 = tr_read<v_rd_off(1, KS, 1)>(vb);
  const s16x4 l2 = tr_read<v_rd_off(2, KS, 0)>(vb), h2 = tr_read<v_rd_off(2, KS, 1)>(vb), l3 = tr_read<v_rd_off(3, KS, 0)>(vb), h3 = tr_read<v_rd_off(3, KS, 1)>(vb);
  asm volatile("s_waitcnt lgkmcnt(0)" ::: "memory"); ATT_SBAR();
#define ATT_PK(L, H) (bf16x8){L[0], L[1], L[2], L[3], H[0], H[1], H[2], H[3]}
  o[0] = __builtin_amdgcn_mfma_f32_32x32x16_bf16(pa, ATT_PK(l0, h0), o[0], 0, 0, 0);
  o[1] = __builtin_amdgcn_mfma_f32_32x32x16_bf16(pa, ATT_PK(l1, h1), o[1], 0, 0, 0);
  o[2] = __builtin_amdgcn_mfma_f32_32x32x16_bf16(pa, ATT_PK(l2, h2), o[2], 0, 0, 0);
  o[3] = __builtin_amdgcn_mfma_f32_32x32x16_bf16(pa, ATT_PK(l3, h3), o[3], 0, 0, 0);
#undef ATT_PK
}
template <int KS> __device__ __forceinline__ void pv_ks_t(f32x16* o, int vb, bf16x8 pb) {
  const s16x4 l0 = tr_read<v_rd_off(0, KS, 0)>(vb), h0 = tr_read<v_rd_off(0, KS, 1)>(vb), l1 = tr_read<v_rd_off(1, KS, 0)>(vb), h1 = tr_read<v_rd_off(1, KS, 1)>(vb);
  const s16x4 l2 = tr_read<v_rd_off(2, KS, 0)>(vb), h2 = tr_read<v_rd_off(2, KS, 1)>(vb), l3 = tr_read<v_rd_off(3, KS, 0)>(vb), h3 = tr_read<v_rd_off(3, KS, 1)>(vb);
  asm volatile("s_waitcnt lgkmcnt(0)" ::: "memory"); ATT_SBAR();
#define ATT_PK(L, H) (bf16x8){L[0], L[1], L[2], L[3], H[0], H[1], H[2], H[3]}
  o[0] = __builtin_amdgcn_mfma_f32_32x32x16_bf16(ATT_PK(l0, h0), pb, o[0], 0, 0, 0);
  o[1] = __builtin_amdgcn_mfma_f32_32x32x16_bf16(ATT_PK(l1, h1), pb, o[1], 0, 0, 0);
  o[2] = __builtin_amdgcn_mfma_f32_32x32x16_bf16(ATT_PK(l2, h2), pb, o[2], 0, 0, 0);
  o[3] = __builtin_amdgcn_mfma_f32_32x32x16_bf16(ATT_PK(l3, h3), pb, o[3], 0, 0, 0);
#undef ATT_PK
}
__device__ __forceinline__ void pv_all_t(f32x16* o, int vb, bf16x8 pb0, bf16x8 pb1, bf16x8 pb2, bf16x8 pb3) {
  pv_ks_t<0>(o, vb, pb0); pv_ks_t<1>(o, vb, pb1); pv_ks_t<2>(o, vb, pb2); pv_ks_t<3>(o, vb, pb3);
}
__device__ __forceinline__ void pv_all(f32x16* o, int vb, bf16x8 pa0, bf16x8 pa1, bf16x8 pa2, bf16x8 pa3) {
  pv_ks<0>(o, vb, pa0); pv_ks<1>(o, vb, pa1); pv_ks<2>(o, vb, pa2); pv_ks<3>(o, vb, pa3);
}
template <int DQK> __device__ __forceinline__ void qkt(f32x16& p0, f32x16& p1, const char* Ks, const bf16x8* qr, int r32, int hi, const f32x16& c0) {
  p0 = c0; p1 = c0;
#pragma unroll
  for (int d0 = 0; d0 < DQK / 16; ++d0) { const int cb = (d0 * 16 + hi * 8) * 2;
    const bf16x8 b0 = *reinterpret_cast<const bf16x8*>(Ks + kswz<DQK>(r32, cb));
    const bf16x8 b1 = *reinterpret_cast<const bf16x8*>(Ks + kswz<DQK>(32 + r32, cb));
    p0 = __builtin_amdgcn_mfma_f32_32x32x16_bf16(b0, qr[d0], p0, 0, 0, 0);
    p1 = __builtin_amdgcn_mfma_f32_32x32x16_bf16(b1, qr[d0], p1, 0, 0, 0); }
}
template <bool BIAS> __device__ __forceinline__ float bias_mask(f32x16& p0, f32x16& p1, bool valid, bool far, float cfar, const float* lut, int relb, int hi) {
  if (__builtin_expect(__builtin_amdgcn_readfirstlane((int)!valid) != 0, 0)) {
#pragma unroll
    for (int r = 0; r < 16; ++r) { p0[r] = -INFINITY; p1[r] = -INFINITY; }
    asm volatile("" : "+v"(p0), "+v"(p1));
    return 0.f;
  }
  if (BIAS) {
    if (far) return cfar;
    int rb = relb + 4 * hi; asm volatile("" : "+v"(rb));
#pragma unroll
    for (int r = 0; r < 16; ++r) { const int i0 = rb + (r & 3) + 8 * (r >> 2);
      p0[r] += lut[min(max(i0, 0), 319)]; p1[r] += lut[min(max(i0 + 32, 0), 319)];
      if ((r & 3) == 3) asm volatile("" ::: "memory"); }
  }
  return 0.f;
}
__device__ __forceinline__ void partialSM(f32x16& p0, f32x16& p1, float badd, float& m_reg, float& alpha) {
  float pmax = p0[0];
#pragma unroll
  for (int r = 1; r < 16; ++r) pmax = fmaxf(pmax, p0[r]);
#pragma unroll
  for (int r = 0; r < 16; ++r) pmax = fmaxf(pmax, p1[r]);
  { auto rr = __builtin_amdgcn_permlane32_swap(__float_as_uint(pmax), __float_as_uint(pmax), false, false);
    pmax = fmaxf(__uint_as_float(rr[0]), __uint_as_float(rr[1])); }
  pmax += badd;
  float mn;
  if (__builtin_expect(__all(pmax - m_reg <= THR), 1)) { mn = m_reg; alpha = 1.f; }
  else { mn = fmaxf(m_reg, pmax); alpha = __builtin_amdgcn_exp2f(m_reg - mn); m_reg = mn; }
  const float sub = mn - badd;
  p0 = p0 - sub; p1 = p1 - sub;
#pragma unroll
  for (int r = 0; r < 16; ++r) p0[r] = __builtin_amdgcn_exp2f(p0[r]);
}
#define ATT_MX3(a, b, c) __builtin_fmaxf(__builtin_fmaxf((a), (b)), (c))
__device__ __forceinline__ float rowmax32(const f32x16& p0, const f32x16& p1) {
  float a = ATT_MX3(p0[0], p0[1], p1[0]), b = ATT_MX3(p0[2], p0[3], p1[1]); a = ATT_MX3(a, p1[2], p1[3]);
#pragma unroll
  for (int r = 4; r < 16; r += 4) { a = ATT_MX3(a, p0[r], p0[r + 1]); b = ATT_MX3(b, p0[r + 2], p0[r + 3]); a = ATT_MX3(a, p1[r], p1[r + 1]); b = ATT_MX3(b, p1[r + 2], p1[r + 3]); }
  float m = __builtin_fmaxf(a, b);
  auto rr = __builtin_amdgcn_permlane32_swap(__float_as_uint(m), __float_as_uint(m), false, false);
  return __builtin_fmaxf(__uint_as_float(rr[0]), __uint_as_float(rr[1]));
}
template <bool FIRST> __device__ __forceinline__ void partialSM_negc(f32x16& p0, f32x16& p1, float& m_reg, float& alpha) {
  const float pmax = rowmax32(p0, p1);
  alpha = 1.f;
  if (FIRST) { const float dl = pmax > -INFINITY ? pmax : 0.f; m_reg += dl; p0 = p0 - dl; p1 = p1 - dl; }
  else if (!__builtin_expect(__all(pmax <= THR), 1)) { const float dl = __builtin_fmaxf(pmax, 0.f); alpha = __builtin_amdgcn_exp2f(-dl); m_reg += dl; p0 = p0 - dl; p1 = p1 - dl; }
#pragma unroll
  for (int r = 0; r < 16; ++r) p0[r] = __builtin_amdgcn_exp2f(p0[r]);
}
__device__ __forceinline__ void finishSM(f32x16& p0, f32x16& p1, float alpha, float& l_reg, bf16x8& pa0, bf16x8& pa1, bf16x8& pa2, bf16x8& pa3) {
#pragma unroll
  for (int r = 0; r < 16; ++r) p1[r] = __builtin_amdgcn_exp2f(p1[r]);
  float ps = 0;
#pragma unroll
  for (int r = 0; r < 16; ++r) ps += p0[r];
#pragma unroll
  for (int r = 0; r < 16; ++r) ps += p1[r];
  { auto rr = __builtin_amdgcn_permlane32_swap(__float_as_uint(ps), __float_as_uint(ps), false, false);
    ps = __uint_as_float(rr[0]) + __uint_as_float(rr[1]); }
  l_reg = l_reg * alpha + ps;
#define ATT_PK4(P, BASE, OUT) do { unsigned a0 = cvtpk(P[BASE + 0], P[BASE + 1]), a1 = cvtpk(P[BASE + 2], P[BASE + 3]);   \
    unsigned b0 = cvtpk(P[BASE + 4], P[BASE + 5]), b1 = cvtpk(P[BASE + 6], P[BASE + 7]);                              \
    auto r0 = __builtin_amdgcn_permlane32_swap(a0, b0, false, false); auto r1 = __builtin_amdgcn_permlane32_swap(a1, b1, false, false); \
    u32x4 w = {r0[0], r1[0], r0[1], r1[1]}; OUT = *reinterpret_cast<bf16x8*>(&w); } while (0)
  ATT_PK4(p0, 0, pa0); ATT_PK4(p0, 8, pa1); ATT_PK4(p1, 0, pa2); ATT_PK4(p1, 8, pa3);
#undef ATT_PK4
}

__device__ __forceinline__ void glds16(const void* gsrc, unsigned lds_dst) { unsigned keep;
  asm volatile("s_mov_b32 %0, m0\n\ts_mov_b32 m0, %2\n\ts_nop 0\n\tglobal_load_lds_dwordx4 %1, off\n\ts_mov_b32 m0, %0" : "=&s"(keep) : "v"(gsrc), "s"(lds_dst) : "memory"); }
__device__ __forceinline__ void glds16s(const void* sbase, unsigned voff, unsigned lds_dst) { unsigned keep;
  asm volatile("s_mov_b32 %0, m0\n\ts_mov_b32 m0, %3\n\ts_nop 0\n\tglobal_load_lds_dwordx4 %1, %2\n\ts_mov_b32 m0, %0" : "=&s"(keep) : "v"(voff), "s"(sbase), "s"(lds_dst) : "memory"); }
struct TileArgs {
  const bf16* Qw; int ldq;
  const bf16* Kh; int ldk;
  const bf16* Vh; int ldv;
  int t0, NT, tmax;
  int wlo, whi;
  int relw;
  int abl;
};

template <int DQK, bool BIAS, int SD, bool SKIPW = false>
__device__ __forceinline__ void attn_tiles(const TileArgs& A, const float* lut, char* lds, f32x16 (&o)[4], float& l_out) {
  int tid_l = threadIdx.x; asm volatile("" : "+v"(tid_l));
  const int tid = tid_l, wid = tid >> 6, lane = tid & 63, r32 = lane & 31, hi = lane >> 5;
  char* V_lds = lds + LDS_V; char* K_lds = lds + LDS_K;
  constexpr int SHM_V = KVBLK * DV * 2, SHM_K = KVBLK * DQK * 2;
  float* ws = (float*)(lds + LDS_WS) + wid * 64; float* al_l = ws + 32;
  float m_reg = -1e30f, l_reg = 0.f; o[0] = f32x16{}; o[1] = f32x16{}; o[2] = f32x16{}; o[3] = f32x16{};
  bf16x8 qr[DQK / 16];
  { ATT_GCP Qp = (ATT_GCP)A.Qw + (unsigned)((r32 * A.ldq + hi * 8) * 2);
#pragma unroll
    for (int d0 = 0; d0 < DQK / 16; ++d0) qr[d0] = *(ATT_GVP)(Qp + d0 * 32); }
  const int vb0 = (int)(uintptr_t)V_lds + v_rd_base(lane);
  const float cfar = BIAS ? lut[0] : 0.f;
  const int ldk = A.ldk, ldv = A.ldv; const bf16* Kh = A.Kh; const bf16* Vh = A.Vh; const int t0 = A.t0, tmax = A.tmax;
  unsigned voV, voK;
  { const int sst = 2 * wid + (lane >> 5), kk = 8 * (sst >> 2) + ((lane & 31) >> 2), kq = (DQK == 64) ? kk : ((kk & ~0xC) | ((kk & 4) << 1) | ((kk & 8) >> 1));
    voV = (unsigned)(kq * ldv + 32 * (sst & 3) + 8 * (lane & 3)) * 2u; }
  if (DQK == 64) { const int row = 8 * wid + (lane >> 3), ch = (lane & 7) ^ (row & 7); voK = (unsigned)(row * ldk + 8 * ch) * 2u; }
  else { const int row = 4 * wid + (lane >> 4), ch = (lane & 15) ^ (row & 7); voK = (unsigned)(row * ldk + 8 * ch) * 2u; }
  const unsigned ldsV = (unsigned)(uintptr_t)V_lds + (unsigned)wid * 1024u, ldsK = (unsigned)(uintptr_t)K_lds + (unsigned)wid * 1024u;
  constexpr int NDMA = (DQK == 64) ? 3 : 4;
#define ATT_DMA(j) do { const int tl_ = min(t0 + (j), tmax); const char* vt_ = (const char*)Vh + (size_t)tl_ * (KVBLK * 2) * ldv; const char* kt_ = (const char*)Kh + (size_t)tl_ * (KVBLK * 2) * ldk;   \
    const unsigned dv_ = (unsigned)__builtin_amdgcn_readfirstlane(ldsV + (unsigned)(((j) & 3) * SHM_V)), dk_ = (unsigned)__builtin_amdgcn_readfirstlane(ldsK + (unsigned)(((j) % 3) * SHM_K));   \
    if (DQK == 64) { glds16s(vt_, voV, dv_); glds16s(vt_ + (size_t)64 * ldv, voV, dv_ + 8192u); glds16s(kt_, voK, dk_); }       \
    else { glds16(vt_ + voV, dv_); glds16(vt_ + (size_t)64 * ldv + voV, dv_ + 8192u); glds16(kt_ + voK, dk_); glds16(kt_ + (size_t)64 * ldk + voK, dk_ + 8192u); } } while (0)
#define ATT_WAITBAR(j) do { if ((j) + 2 < NT) { if (DQK == 64) asm volatile("s_waitcnt vmcnt(3) lgkmcnt(0)\n\ts_barrier" ::: "memory"); else asm volatile("s_waitcnt vmcnt(4) lgkmcnt(0)\n\ts_barrier" ::: "memory"); }   \
    else asm volatile("s_waitcnt vmcnt(0) lgkmcnt(0)\n\ts_barrier" ::: "memory"); } while (0)
#define ATT_RESC(a) do { if (__any((a) != 1.f)) { if (hi == 0) al_l[r32] = (a); asm volatile("s_waitcnt lgkmcnt(0)" ::: "memory"); \
    _Pragma("unroll") for (int d = 0; d < 4; ++d) _Pragma("unroll") for (int r = 0; r < 16; ++r) o[d][r] *= al_l[crow(r, hi)]; } } while (0)
#define ATT_BM(P0, P1, j, BADD) do { const int t_ = t0 + (j); const bool valid_ = (t_ >= A.wlo) && (t_ <= A.whi); const int rk_ = A.relw + t_ * KVBLK;   \
    BADD = bias_mask<BIAS>(P0, P1, valid_, (rk_ + 63 <= -128), NEGC ? 0.f : cfar, lut, rk_ - r32 + 256, hi); } while (0)
#define ATT_PRE(j) do { if constexpr (NEGC) { const int rk_ = A.relw + (t0 + (j)) * KVBLK; const float cf_ = ((BIAS && (rk_ + 63 <= -128)) ? cfar : 0.f) - m_reg;   \
    if (__any(cf_ != ccur)) { ccur = cf_; _Pragma("unroll") for (int r = 0; r < 16; ++r) negc[r] = cf_; asm volatile("" : "+v"(negc)); } } } while (0)
#define ATT_PSM(P0, P1, AL) do { if constexpr (NEGC) partialSM_negc<false>(P0, P1, m_reg, AL); else partialSM(P0, P1, badd, m_reg, AL); } while (0)
#define ATT_VALID(j) ((!SKIPW || act) && (__builtin_amdgcn_readfirstlane((int)(((t0 + (j)) >= A.wlo) && ((t0 + (j)) <= A.whi))) != 0))
#define ATT_STEP(PC0, PC1, ALC, PP0, PP1, ALP, j) do {                                                                \
    if ((j) + 2 < NT && !(abl & 1)) ATT_DMA((j) + 2);                                                                 \
    const bool cv_ = ATT_VALID(j), pv_ = ATT_VALID((j) - 1);                                                          \
    if (cv_) { ATT_PRE(j); ATT_SBAR(); qkt<DQK>(PC0, PC1, K_lds + ((j) % 3) * SHM_K, qr, r32, hi, negc); }            \
    if (pv_) { finishSM(PP0, PP1, ALP, l_reg, pa0, pa1, pa2, pa3); ATT_SBAR(); pv_all(o, vb0 + (((j) + 3) & 3) * SHM_V, pa0, pa1, pa2, pa3); }   \
    if (cv_) { ATT_BM(PC0, PC1, j, badd); ATT_PSM(PC0, PC1, ALC); ATT_RESC(ALC); }                                    \
    ATT_WAITBAR(j); } while (0)
#define ATT_PIN(x) asm volatile("" : "+v"(x))
#define ATT_KLD(D0, B0, B1) do { const int cb_ = ((D0) * 16 + hi * 8) * 2; B0 = *reinterpret_cast<const bf16x8*>(kb_ + kswz<64>(r32, cb_)); B1 = *reinterpret_cast<const bf16x8*>(kb_ + kswz<64>(32 + r32, cb_)); } while (0)
#define ATT_PKT(P, BASE, OUT) do { u32x4 w_ = {cvtpk(P[BASE + 0], P[BASE + 1]), cvtpk(P[BASE + 2], P[BASE + 3]), cvtpk(P[BASE + 4], P[BASE + 5]), cvtpk(P[BASE + 6], P[BASE + 7])}; OUT = *reinterpret_cast<bf16x8*>(&w_); } while (0)
#define ATT_G1(D0, PC0, PC1, PP, PB, PAK, CB0, CB1, NB0, NB1) do { if ((D0) < 3) ATT_KLD((D0) + 1, NB0, NB1);          \
    PC0 = __builtin_amdgcn_mfma_f32_32x32x16_bf16(CB0, qr[D0], (D0) == 0 ? negc : PC0, 0, 0, 0);                         \
    sacc_ += PP[PB + 0]; sacc_ += PP[PB + 1]; sacc_ += PP[PB + 2]; sacc_ += PP[PB + 3]; ATT_PIN(sacc_);                 \
    const unsigned a0_ = cvtpk(PP[PB + 0], PP[PB + 1]), a1_ = cvtpk(PP[PB + 2], PP[PB + 3]); ATT_SBAR();                \
    PC1 = __builtin_amdgcn_mfma_f32_32x32x16_bf16(CB1, qr[D0], (D0) == 0 ? negc : PC1, 0, 0, 0);                         \
    sacc_ += PP[PB + 4]; sacc_ += PP[PB + 5]; sacc_ += PP[PB + 6]; sacc_ += PP[PB + 7]; ATT_PIN(sacc_);                 \
    const unsigned b0c_ = cvtpk(PP[PB + 4], PP[PB + 5]), b1c_ = cvtpk(PP[PB + 6], PP[PB + 7]);                          \
    u32x4 w_ = {a0_, a1_, b0c_, b1c_}; PAK = *reinterpret_cast<bf16x8*>(&w_); ATT_SBAR(); } while (0)
#define ATT_TRIG(PP0, PP1, PC0, PC1, HAVE_CUR) do { if (!__builtin_expect(__all(sacc_ <= 16384.f), 1)) {                                        \
      float full_; { auto rr_ = __builtin_amdgcn_permlane32_swap(__float_as_uint(sacc_), __float_as_uint(sacc_), false, false); full_ = __uint_as_float(rr_[0]) + __uint_as_float(rr_[1]); }   \
      const bool big_ = full_ > 16384.f;                                      \
      const float al_ = big_ ? __builtin_amdgcn_rcpf(full_) : 1.f, dl_ = big_ ? __builtin_amdgcn_logf(full_) : 0.f;                            \
      PP0 = PP0 * al_; PP1 = PP1 * al_; sacc_ *= al_; l_reg *= al_; m_reg += dl_;                                                              \
      _Pragma("unroll") for (int d_ = 0; d_ < 4; ++d_) o[d_] = o[d_] * al_;                                                                     \
      if (HAVE_CUR) { PC0 = PC0 - dl_; PC1 = PC1 - dl_; }                                                                                      \
      ATT_PKT(PP0, 0, pa0); ATT_PKT(PP0, 8, pa1); ATT_PKT(PP1, 0, pa2); ATT_PKT(PP1, 8, pa3); } } while (0)
#define ATT_B1(PC0, PC1, PP0, PP1, j) do { const char* kb_ = K_lds + ((j) % 3) * SHM_K; float sacc_ = 0.f; bf16x8 ke0_, ke1_, ko0_, ko1_;   \
    ATT_KLD(0, ke0_, ke1_); ATT_SBAR();                                                                                 \
    ATT_G1(0, PC0, PC1, PP0, 0, pa0, ke0_, ke1_, ko0_, ko1_); ATT_G1(1, PC0, PC1, PP0, 8, pa1, ko0_, ko1_, ke0_, ke1_); \
    ATT_G1(2, PC0, PC1, PP1, 0, pa2, ke0_, ke1_, ko0_, ko1_); ATT_G1(3, PC0, PC1, PP1, 8, pa3, ko0_, ko1_, ke0_, ke1_); \
    ATT_TRIG(PP0, PP1, PC0, PC1, true); l_reg += sacc_; } while (0)
#define ATT_PKV(L, H) (bf16x8){L[0], L[1], L[2], L[3], H[0], H[1], H[2], H[3]}
#define ATT_EX2(X, B) do { X[B] = __builtin_amdgcn_exp2f(X[B]); X[(B) + 1] = __builtin_amdgcn_exp2f(X[(B) + 1]); ATT_PIN(X); ATT_SBAR(); } while (0)
#define ATT_VRD(KS, S) do { S##l0 = tr_read<v_rd_off(0, KS, 0)>(vb_); S##h0 = tr_read<v_rd_off(0, KS, 1)>(vb_); S##l1 = tr_read<v_rd_off(1, KS, 0)>(vb_); S##h1 = tr_read<v_rd_off(1, KS, 1)>(vb_);   \
    S##l2 = tr_read<v_rd_off(2, KS, 0)>(vb_); S##h2 = tr_read<v_rd_off(2, KS, 1)>(vb_); S##l3 = tr_read<v_rd_off(3, KS, 0)>(vb_); S##h3 = tr_read<v_rd_off(3, KS, 1)>(vb_); } while (0)
#define ATT_VMF(S, PAK, X, XB) do {                                                                                     \
    o[0] = __builtin_amdgcn_mfma_f32_32x32x16_bf16(ATT_PKV(S##l0, S##h0), PAK, o[0], 0, 0, 0); ATT_EX2(X, XB);          \
    o[1] = __builtin_amdgcn_mfma_f32_32x32x16_bf16(ATT_PKV(S##l1, S##h1), PAK, o[1], 0, 0, 0); ATT_EX2(X, (XB) + 2);    \
    o[2] = __builtin_amdgcn_mfma_f32_32x32x16_bf16(ATT_PKV(S##l2, S##h2), PAK, o[2], 0, 0, 0); ATT_EX2(X, (XB) + 4);    \
    o[3] = __builtin_amdgcn_mfma_f32_32x32x16_bf16(ATT_PKV(S##l3, S##h3), PAK, o[3], 0, 0, 0); ATT_EX2(X, (XB) + 6); } while (0)
#define ATT_LW8() do { asm volatile("s_waitcnt lgkmcnt(8)" ::: "memory"); ATT_SBAR(); } while (0)
#define ATT_LW0() do { asm volatile("s_waitcnt lgkmcnt(0)" ::: "memory"); ATT_SBAR(); } while (0)
#define ATT_B2(PC0, PC1, j) do { const int vb_ = vb0 + (((j) + 3) & 3) * SHM_V;                                         \
    s16x4 fa_l0, fa_h0, fa_l1, fa_h1, fa_l2, fa_h2, fa_l3, fa_h3, fb_l0, fb_h0, fb_l1, fb_h1, fb_l2, fb_h2, fb_l3, fb_h3;   \
    ATT_VRD(0, fa_); ATT_VRD(1, fb_); ATT_LW8(); ATT_VMF(fa_, pa0, PC0, 0);                                             \
    ATT_VRD(2, fa_); ATT_LW8(); ATT_VMF(fb_, pa1, PC0, 8);                                                              \
    ATT_VRD(3, fb_); ATT_LW8(); ATT_VMF(fa_, pa2, PC1, 0);                                                              \
    ATT_LW0(); ATT_VMF(fb_, pa3, PC1, 8); } while (0)
#define ATT_ISTEP(PC0, PC1, PP0, PP1, j) do {                                                                           \
    if ((j) + 2 < NT) ATT_DMA((j) + 2);                                                                                 \
    if (!SKIPW || act) {                                                                                                \
      ATT_PRE(j); ATT_SBAR(); ATT_B1(PC0, PC1, PP0, PP1, j);                                                            \
      ATT_BM(PC0, PC1, j, badd); ATT_SBAR();                                                                            \
      ATT_B2(PC0, PC1, j); }                                                                                            \
    ATT_WAITBAR(j); } while (0)
  f32x16 pA0 = f32x16{}, pA1 = f32x16{}, pB0 = f32x16{}, pB1 = f32x16{}; float alA = 1.f, alB = 1.f; bf16x8 pa0 = bf16x8{}, pa1 = bf16x8{}, pa2 = bf16x8{}, pa3 = bf16x8{}; const int NT = A.NT; const int abl = A.abl;
  const bool act = !SKIPW || (__builtin_amdgcn_readfirstlane(wid) < 2);
  float badd; constexpr bool NEGC = (DQK == 64);
  asm volatile("s_waitcnt vmcnt(0) lgkmcnt(0)\n\ts_barrier" ::: "memory");
  ATT_DMA(0); ATT_DMA(1);
  if (wid >= 4) __builtin_amdgcn_s_setprio(1);
  f32x16 negc = f32x16{}; float ccur = 0.f;
  if constexpr (NEGC) { m_reg = 0.f; float z_ = 0.f; asm volatile("" : "+v"(z_));
#pragma unroll
    for (int r = 0; r < 16; ++r) negc[r] = z_;
    asm volatile("" : "+v"(negc)); }
  asm volatile("s_waitcnt vmcnt(0)\n\ts_barrier" ::: "memory");
  if (2 < NT) ATT_DMA(2);
  if (!SKIPW || act) { ATT_PRE(0); qkt<DQK>(pA0, pA1, K_lds, qr, r32, hi, negc); ATT_BM(pA0, pA1, 0, badd); }
  if constexpr (NEGC) {
    if (!SKIPW || act) {
      partialSM_negc<true>(pA0, pA1, m_reg, alA);
#pragma unroll
      for (int r = 0; r < 16; ++r) pA1[r] = __builtin_amdgcn_exp2f(pA1[r]);
    }
    ATT_WAITBAR(0);
    for (int j = 1; j + 1 < NT; j += 2) {
      ATT_ISTEP(pB0, pB1, pA0, pA1, j);
      ATT_ISTEP(pA0, pA1, pB0, pB1, j + 1);
    }
    ATT_ISTEP(pB0, pB1, pA0, pA1, NT - 1);
    if (!SKIPW || act) { float sacc_ = 0.f;
#pragma unroll
      for (int r = 0; r < 16; ++r) sacc_ += pB0[r];
#pragma unroll
      for (int r = 0; r < 16; ++r) sacc_ += pB1[r];
      ATT_PKT(pB0, 0, pa0); ATT_PKT(pB0, 8, pa1); ATT_PKT(pB1, 0, pa2); ATT_PKT(pB1, 8, pa3);
      ATT_TRIG(pB0, pB1, pA0, pA1, false); l_reg += sacc_;
    }
    ATT_SBAR();
    if (!SKIPW || act) pv_all_t(o, vb0 + ((NT - 1) & 3) * SHM_V, pa0, pa1, pa2, pa3);
  } else {
    if (ATT_VALID(0)) partialSM(pA0, pA1, badd, m_reg, alA);
    ATT_WAITBAR(0);
    for (int j = 1; j + 1 < NT; j += 2) {
      ATT_STEP(pB0, pB1, alB, pA0, pA1, alA, j);
      ATT_STEP(pA0, pA1, alA, pB0, pB1, alB, j + 1);
    }
    ATT_STEP(pB0, pB1, alB, pA0, pA1, alA, NT - 1);
    if (ATT_VALID(NT - 1)) { finishSM(pB0, pB1, alB, l_reg, pa0, pa1, pa2, pa3); ATT_SBAR();
      pv_all(o, vb0 + ((NT - 1) & 3) * SHM_V, pa0, pa1, pa2, pa3); }
  }
  __builtin_amdgcn_s_setprio(0);
  l_out = l_reg;
#undef ATT_DMA
#undef ATT_WAITBAR
#undef ATT_RESC
#undef ATT_BM
#undef ATT_STEP
#undef ATT_VALID
#undef ATT_PIN
#undef ATT_KLD
#undef ATT_G1
#undef ATT_B1
#undef ATT_PKV
#undef ATT_EX2
#undef ATT_VRD
#undef ATT_VMF
#undef ATT_LW8
#undef ATT_LW0
#undef ATT_B2
#undef ATT_PKT
#undef ATT_TRIG
#undef ATT_ISTEP
#undef ATT_PRE
#undef ATT_PSM
}
__device__ __forceinline__ void attn_normalize_t(f32x16 (&o)[4], float l_part) {
  auto rr = __builtin_amdgcn_permlane32_swap(__float_as_uint(l_part), __float_as_uint(l_part), false, false);
  const float rl = __builtin_amdgcn_rcpf(__uint_as_float(rr[0]) + __uint_as_float(rr[1]));
#pragma unroll
  for (int d = 0; d < 4; ++d) o[d] = o[d] * rl;
}
__device__ __forceinline__ void attn_normalize(f32x16 (&o)[4], float l_reg, char* lds) {
  int tid_l = threadIdx.x; asm volatile("" : "+v"(tid_l));
  const int tid = tid_l, wid = tid >> 6, lane = tid & 63, r32 = lane & 31, hi = lane >> 5;
  float* li_l = (float*)(lds + LDS_WS) + wid * 64;
  if (hi == 0) li_l[r32] = l_reg; asm volatile("s_waitcnt lgkmcnt(0)" ::: "memory");
#pragma unroll
  for (int r = 0; r < 16; ++r) { const float rl = __builtin_amdgcn_rcpf(li_l[crow(r, hi)]);
#pragma unroll
    for (int d = 0; d < 4; ++d) o[d][r] *= rl; }
  asm volatile("s_waitcnt lgkmcnt(0)" ::: "memory");
}
#undef ATT_SBAR
#undef ATT_GCP
#undef ATT_GVP
}
#define GAS __attribute__((address_space(1)))
#define LAS __attribute__((address_space(3)))
typedef unsigned short bf16;
typedef unsigned v4u __attribute__((ext_vector_type(4)));
typedef float f32x4 __attribute__((ext_vector_type(4)));
typedef short bf16x8 __attribute__((ext_vector_type(8)));
typedef GAS unsigned gu32;
typedef GAS unsigned long long gu64;
#define RLX_AGENT __ATOMIC_RELAXED, __HIP_MEMORY_SCOPE_AGENT
#define LDS_WAIT() asm volatile("s_waitcnt lgkmcnt(0)" ::: "memory")
#define VM_WAIT() asm volatile("s_waitcnt vmcnt(0)" ::: "memory")
__device__ __forceinline__ unsigned long long rt() { return __builtin_amdgcn_s_memrealtime(); }
__device__ __forceinline__ unsigned f2bf(float f) { unsigned u = __builtin_bit_cast(unsigned, f); return (u + 0x7fffu + ((u >> 16) & 1u)) >> 16; }
__device__ __forceinline__ unsigned pk2(float lo, float hi) { return f2bf(lo) | (f2bf(hi) << 16); }

#define XB_TMO      128
#define XB_XCNT(j)  (256  + 64 * (j))
#define XB_XSUB(j)  (1280 + 64 * (j))
#define XB_XGEN(j)  (2304 + 64 * (j))
#define XB_TOP      3328
#define XB_TOPGEN   3392
#define XCD_BAR_WORDS 3456
#define XB_SPIN_CAP (1u << 18)

__device__ __forceinline__ unsigned xb_ld(unsigned* p)              { return __hip_atomic_load(p, __ATOMIC_RELAXED, __HIP_MEMORY_SCOPE_AGENT); }
__device__ __forceinline__ unsigned xb_add(unsigned* p, unsigned v) { return __hip_atomic_fetch_add(p, v, __ATOMIC_RELAXED, __HIP_MEMORY_SCOPE_AGENT); }
__device__ __forceinline__ unsigned xb_xcc_id() { return (unsigned)__builtin_amdgcn_s_getreg((3 << 11) | 20) & 0xFu; }
#define XB_SPIN(cond, bar) do { unsigned _sp = 0; while (cond) { __builtin_amdgcn_s_sleep(1); \
    if ((++_sp & 255u) == 0u) { if (xb_ld(&(bar)[XB_TMO])) break; if (_sp > XB_SPIN_CAP) { atomicAdd(&(bar)[XB_TMO], 1u); break; } } } } while (0)

struct XcdBarrier {
    unsigned* bar; unsigned x;
    volatile LAS unsigned* st;
};

__device__ __forceinline__ XcdBarrier xcd_barrier_post(unsigned* bar, volatile LAS unsigned* st) {
    XcdBarrier b; b.bar = bar; b.x = xb_xcc_id(); b.st = st;
    if (threadIdx.x == 0) (void)xb_add(&bar[XB_XCNT(b.x)], 1u);
    return b;
}
__device__ __forceinline__ void xcd_barrier_complete(unsigned* bar, unsigned x, unsigned& nloc, unsigned& nx) {
    const unsigned G = gridDim.x * gridDim.y * gridDim.z;
    unsigned sum, cnt, mine, sp = 0u;
    for (;;) {
        sum = 0u; cnt = 0u; mine = 0u;
#pragma unroll
        for (unsigned j = 0; j < 16; ++j) { const unsigned c = xb_ld(&bar[XB_XCNT(j)]); sum += c; cnt += (c > 0u) ? 1u : 0u; mine = (j == x) ? c : mine; }
        if (sum == G) break;
        __builtin_amdgcn_s_sleep(1);
        if ((++sp & 255u) == 0u) { if (xb_ld(&bar[XB_TMO])) break; if (sp > XB_SPIN_CAP) { atomicAdd(&bar[XB_TMO], 1u); break; } }
    }
    nloc = mine > 0u ? mine : 1u; nx = cnt > 0u ? cnt : 1u;
}

__device__ __forceinline__ void xcd_barrier(const XcdBarrier& b) {
    asm volatile("s_waitcnt vmcnt(0)" ::: "memory");
    __syncthreads();
    if (threadIdx.x == 0) {
        unsigned* bar = b.bar;
        __builtin_amdgcn_s_waitcnt(0);
        unsigned nloc = b.st[0], nx = b.st[1];
        if (nloc == 0u) { xcd_barrier_complete(bar, b.x, nloc, nx); b.st[0] = nloc; b.st[1] = nx; }
        const unsigned old = xb_add(&bar[XB_XSUB(b.x)], 1u);
        const unsigned gen = old / nloc;
        if (old + 1u == (gen + 1u) * nloc) {
            __builtin_amdgcn_fence(__ATOMIC_RELEASE, "agent");
            asm volatile("s_waitcnt vmcnt(0)" ::: "memory");
            const unsigned og = xb_add(&bar[XB_TOP], 1u);
            const unsigned tg = og / nx;
            if (og + 1u == (tg + 1u) * nx) xb_add(&bar[XB_TOPGEN], 1u);
            else XB_SPIN(xb_ld(&bar[XB_TOPGEN]) == tg, bar);
            __builtin_amdgcn_fence(__ATOMIC_ACQUIRE, "agent");
            xb_add(&bar[XB_XGEN(b.x)], 1u);
            asm volatile("s_waitcnt vmcnt(0)" ::: "memory");
        } else {
            XB_SPIN(xb_ld(&bar[XB_XGEN(b.x)]) == gen, bar);
            __builtin_amdgcn_fence(__ATOMIC_ACQUIRE, "agent");
            asm volatile("s_waitcnt vmcnt(0)" ::: "memory");
        }
    }
    __syncthreads();
}
struct Args { const float* in[33]; float* out; unsigned char* ws; int ph_lo, ph_hi, li, pad; };
constexpr int N_PHASES = 17;
#ifndef MK_N_LAUNCHES
#define MK_N_LAUNCHES 1
#endif
constexpr int N_LAUNCHES = MK_N_LAUNCHES;

enum InIdx { I_XP = 0, I_XS, I_CDAK, I_CDAV, I_CCBK, I_CCBV, I_CMK, I_CMV, I_MEMP, I_T5, I_G1, I_W1G, I_W1U, I_W1D, I_GMIX, I_WIN, I_BGATE, I_LAMBDA, I_DAG, I_CBREL,
             I_WBRDA, I_WBRCB, I_WOUT, I_GCROSS, I_GMEM, I_WMKV, I_WCQ, I_WCO, I_G2, I_W2G, I_W2U, I_W2D, I_GFINAL };

__device__ __forceinline__ float wave_sum(float v) {
#pragma unroll
    for (int o = 1; o < 64; o <<= 1) v += __shfl_xor(v, o);
    return v;
}
__device__ __forceinline__ void tr_item(const float* W, int ldw, int N, bf16* WT, int pitch, int koff, int il, int half, LAS float* scr, int item, int lane) {
    const int nblk = N / 32, kb = item / nblk, nb = item % nblk, k0 = 64 * kb, n0 = 32 * nb;
#pragma unroll 8
    for (int i = 0; i < 32; ++i) { const int kk = 2 * i + (lane >> 5); scr[kk * 33 + (lane & 31)] = W[(size_t)(k0 + kk) * ldw + n0 + (lane & 31)]; }
    LDS_WAIT(); asm volatile("" ::: "memory");
    const int c = lane & 7;
#pragma unroll
    for (int j = 0; j < 4; ++j) { const int n = (lane >> 3) + 8 * j; const LAS float* s = scr + (8 * c) * 33 + n;
        v4u o; o.x = pk2(s[0 * 33], s[1 * 33]); o.y = pk2(s[2 * 33], s[3 * 33]); o.z = pk2(s[4 * 33], s[5 * 33]); o.w = pk2(s[6 * 33], s[7 * 33]);
        const int nn = n0 + n, drow = il ? ((nn >> 7) * 256 + half * 128 + (nn & 127)) : nn;
        *(GAS v4u*)(WT + (size_t)drow * pitch + koff + k0 + 8 * c) = o; }
    LDS_WAIT(); asm volatile("" ::: "memory");
}
__device__ __forceinline__ void rms_row_to_bf16(const float* xrow, const float* g, bf16* orow, int lane) {
    const GAS f32x4* xr = (const GAS f32x4*)xrow + lane; const GAS f32x4* gr = (const GAS f32x4*)g + lane;
    f32x4 v[8]; float s = 0.f;
#pragma unroll
    for (int j = 0; j < 8; ++j) { v[j] = xr[64 * j]; s += (v[j].x * v[j].x + v[j].y * v[j].y) + (v[j].z * v[j].z + v[j].w * v[j].w); }
    const float rs = 1.f / sqrtf(wave_sum(s) * (1.f / DM) + EPS);
    GAS unsigned long long* o8 = (GAS unsigned long long*)orow + lane;
#pragma unroll
    for (int j = 0; j < 8; ++j) { const f32x4 gg = gr[64 * j];
        o8[64 * j] = (unsigned long long)pk2(v[j].x * rs * gg.x, v[j].y * rs * gg.y) | ((unsigned long long)pk2(v[j].z * rs * gg.z, v[j].w * rs * gg.w) << 32); }
}
__device__ __forceinline__ void cvt_row1024(const float* src, bf16* dst, float* fcopy, int lane) {
    const GAS f32x4* s = (const GAS f32x4*)src + lane; GAS unsigned long long* d = (GAS unsigned long long*)dst + lane;
#pragma unroll
    for (int j = 0; j < 4; ++j) { const f32x4 v = s[64 * j]; d[64 * j] = (unsigned long long)pk2(v.x, v.y) | ((unsigned long long)pk2(v.z, v.w) << 32);
        if (fcopy) ((GAS f32x4*)fcopy)[lane + 64 * j] = v; }
}
__device__ __forceinline__ int t5_bucket(int rel) {
    const int base = rel > 0 ? 16 : 0, n = rel < 0 ? -rel : rel;
    if (n < 8) return base + n;
    const float nf = (float)n;
    int large = 8 + (int)(logf(nf / 8.f) / 2.772588722239781f * 8.f);
    large = large < 15 ? large : 15;
    return base + large;
}

struct Frame {
    LAS unsigned char* lds; volatile LAS unsigned* MISC; gu32* ctl;
    int tid, lane, wave, vcu, G;
};

constexpr int I_FFN = 32 * 176, I_FFD = 88 * 64, I_QKV = 32 * 192, I_G = 32 * 64, I_BR = 16 * 64, I_O = 32 * 64, I_MKV = 32 * 32, I_CQ = 32 * 16, I_CO = 8 * 64;
constexpr int N_EARLY = 2 * I_FFN + I_MKV, N_W1D = N_EARLY + I_FFD, N_W2 = N_W1D + 2 * I_FFN + I_FFD, NITEMS = 6 * I_FFN + I_QKV + 2 * I_G + 2 * I_BR + I_O + I_MKV + I_CQ + I_CO;
static_assert(I_FFN == I_FFD, "items");
__device__ __forceinline__ void tr_items(const Args& a, LAS float* scr, int first, int last, int gw, int NGW, int lane) {
    unsigned char* ws = a.ws;
    for (int it = first + gw; it < last; it += NGW) {
        int r = it;
        if (r < I_FFN) { tr_item(a.in[I_W1G], FF, FF, (bf16*)(ws + WS_W1GU), DM, 0, 1, 0, scr, r, lane); continue; } r -= I_FFN;
        if (r < I_FFN) { tr_item(a.in[I_W1U], FF, FF, (bf16*)(ws + WS_W1GU), DM, 0, 1, 1, scr, r, lane); continue; } r -= I_FFN;
        if (r < I_MKV) { tr_item(a.in[I_WMKV], 1024, 1024, (bf16*)(ws + WS_WMKV), DM, 0, 0, 0, scr, r, lane); continue; } r -= I_MKV;
        if (r < I_FFD) { tr_item(a.in[I_W1D], DM, DM, (bf16*)(ws + WS_W1D), FF, 0, 0, 0, scr, r, lane); continue; } r -= I_FFD;
        if (r < I_FFN) { tr_item(a.in[I_W2G], FF, FF, (bf16*)(ws + WS_W2GU), DM, 0, 1, 0, scr, r, lane); continue; } r -= I_FFN;
        if (r < I_FFN) { tr_item(a.in[I_W2U], FF, FF, (bf16*)(ws + WS_W2GU), DM, 0, 1, 1, scr, r, lane); continue; } r -= I_FFN;
        if (r < I_FFD) { tr_item(a.in[I_W2D], DM, DM, (bf16*)(ws + WS_W2D), FF, 0, 0, 0, scr, r, lane); continue; } r -= I_FFD;
        if (r < I_QKV) { tr_item(a.in[I_WIN], 10240, 6144, (bf16*)(ws + WS_WQKV), DM, 0, 0, 0, scr, r, lane); continue; } r -= I_QKV;
        if (r < I_G) { tr_item(a.in[I_WIN] + 6144, 10240, 2048, (bf16*)(ws + WS_WG), DM, 0, 1, 0, scr, r, lane); continue; } r -= I_G;
        if (r < I_G) { tr_item(a.in[I_WIN] + 8192, 10240, 2048, (bf16*)(ws + WS_WG), DM, 0, 1, 1, scr, r, lane); continue; } r -= I_G;
        if (r < I_BR) { tr_item(a.in[I_WBRDA], DM, DM, (bf16*)(ws + WS_WBR), DM, 0, 0, 0, scr, r, lane); continue; } r -= I_BR;
        if (r < I_BR) { tr_item(a.in[I_WBRCB], DM, DM, (bf16*)(ws + WS_WBR), DM, 1024, 0, 0, scr, r, lane); continue; } r -= I_BR;
        if (r < I_O) { tr_item(a.in[I_WOUT], DM, DM, (bf16*)(ws + WS_WO), DM, 0, 0, 0, scr, r, lane); continue; } r -= I_O;
        if (r < I_CQ) { tr_item(a.in[I_WCQ], XW, XW, (bf16*)(ws + WS_WCQ), DM, 0, 0, 0, scr, r, lane); continue; } r -= I_CQ;
        tr_item(a.in[I_WCO], DM, DM, (bf16*)(ws + WS_WCO), XW, 0, 0, 0, scr, r, lane);
    }
}
__device__ __forceinline__ void cache_rows(const Args& a, int gw, int NGW, int lane) {
    unsigned char* ws = a.ws;
    constexpr int R_DA = DB * PAST, R_CB = DB * CBR, R_MEM = DB * NMEM * XW / 1024;
    for (int r0 = gw; r0 < 2 * R_DA + 2 * R_CB + 2 * R_MEM; r0 += NGW) {
        int r = r0;
        if (r < 2 * R_DA) { const int v = r >= R_DA; r -= v * R_DA; const int b = r >> 10, t = r & 1023;
            cvt_row1024(a.in[v ? I_CDAV : I_CDAK] + (size_t)r * 1024, (bf16*)(ws + (v ? WS_VDAS : WS_KDAS)) + (size_t)(b * KDAS_ROWS + t) * 1024, nullptr, lane); continue; }
        r -= 2 * R_DA;
        if (r < 2 * R_CB) { const int v = r >= R_CB; r -= v * R_CB; const int b = r >> 9, t = r & 511;
            float* fc = t >= DT ? a.out + (v ? O_CBVS : O_CBKS) + (size_t)(b * CBR + t - DT) * 1024 : nullptr;
            cvt_row1024(a.in[v ? I_CCBV : I_CCBK] + (size_t)r * 1024, (bf16*)(ws + (v ? WS_VCBS : WS_KCBS)) + (size_t)(b * KCBS_ROWS + t) * 1024, fc, lane); continue; }
        r -= 2 * R_CB;
        { const int v = r >= R_MEM; r -= v * R_MEM;
          cvt_row1024(a.in[v ? I_CMV : I_CMK] + (size_t)r * 1024, (bf16*)(ws + (v ? WS_MVS : WS_MKS)) + (size_t)r * 1024, nullptr, lane); }
    }
}
#ifndef DIFF_XCD32
#define DIFF_XCD32 0
#endif
#ifndef WGM_QKV
#define WGM_QKV 4
#endif
#ifndef WGM_GU
#define WGM_GU 4
#endif
#ifndef A_BLOCKED
#define A_BLOCKED 0
#endif
#ifndef PANEL_REV
#define PANEL_REV 0
#endif
#ifndef DEFER_CVT
#define DEFER_CVT 1
#endif
__device__ __forceinline__ void p0_prologue(Frame& F, const Args& a) {
    LAS float* scr = (LAS float*)(F.lds + RING_OFF + F.wave * 16384);
    const int gw = F.vcu * NWAVES + F.wave, NGW = F.G * NWAVES;
    unsigned char* ws = a.ws;
    tr_items(a, scr, 0, DEFER_CVT ? N_EARLY : NITEMS, gw, NGW, F.lane);
    for (int m = gw; m < MTOT + NBP * NMEM; m += NGW) {
        if (m < MP) rms_row_to_bf16(a.in[I_XP] + (size_t)m * DM, a.in[I_G1], (bf16*)(ws + WS_XN) + (size_t)m * DM, F.lane);
        else if (m < MTOT) rms_row_to_bf16(a.in[I_XS] + (size_t)(m - MP) * DM, a.in[I_G1], (bf16*)(ws + WS_XN) + (size_t)m * DM, F.lane);
        else rms_row_to_bf16(a.in[I_MEMP] + (size_t)(m - MTOT) * DM, a.in[I_GMEM], (bf16*)(ws + WS_XM) + (size_t)(m - MTOT) * DM, F.lane);
    }
    if (!DEFER_CVT) cache_rows(a, gw, NGW, F.lane);
    if (blockIdx.x == 0) {
        float* lut = (float*)(ws + WS_LUT);
        for (int i = F.tid; i < 2 * 8 * 320; i += NWAVES * 64) { const int ty = i / 2560, h = (i / 320) & 7, e = i % 320, rel = e - 256;
            float v;
            if (ty == 0) v = a.in[I_T5][t5_bucket(rel) * 8 + h];
            else { const int idx = (rel < -128 ? -128 : (rel > 128 ? 128 : rel)) + 128; v = a.in[I_CBREL][idx * 8 + h]; }
            lut[i] = v * LOG2E; }
        if (F.wave == 0) { const float* lp = a.in[I_LAMBDA]; const float s1 = wave_sum(lp[F.lane] * lp[64 + F.lane]), s2 = wave_sum(lp[128 + F.lane] * lp[192 + F.lane]);
            if (F.lane == 0) *(float*)(ws + WS_LUT + 32768) = expf(s1) - expf(s2) + LAM_INIT; }
    }
}

__device__ __forceinline__ void rstd_phase(Frame& F, unsigned char* ws, int nrows) {
    const float* ssq = (const float*)(ws + WS_SSQ); float* rstd = (float*)(ws + WS_RSTD);
    for (int row = F.vcu * (NWAVES * 64) + F.tid; row < nrows; row += F.G * NWAVES * 64) {
        const f32x4* p = (const f32x4*)(ssq + (size_t)row * 32); float s = 0.f;
#pragma unroll
        for (int k = 0; k < 8; ++k) { const f32x4 v = p[k]; s += (v.x + v.y) + (v.z + v.w); }
        rstd[row] = 1.f / sqrtf(s * (1.f / DM) + EPS);
    }
}
__device__ __forceinline__ void final_phase(Frame& F, unsigned char* ws, float* outp, int nrows) {
    const float* ssq = (const float*)(ws + WS_SSQ); const bf16* XN = (const bf16*)(ws + WS_XN);
    const int gw = F.vcu * NWAVES + F.wave, NGW = F.G * NWAVES;
    for (int row = gw; row < nrows; row += NGW) {
        const GAS v4u* x = (const GAS v4u*)(XN + (size_t)row * DM) + F.lane; GAS f32x4* y = (GAS f32x4*)(outp + O_Y + (size_t)row * DM) + 2 * F.lane;
        v4u w[4];
#pragma unroll
        for (int j = 0; j < 4; ++j) w[j] = x[64 * j];
        const float part = F.lane < 32 ? ((const GAS float*)ssq)[(size_t)row * 32 + F.lane] : 0.f;
        const float rs = 1.f / sqrtf(wave_sum(part) * (1.f / DM) + EPS);
#pragma unroll
        for (int j = 0; j < 4; ++j) { f32x4 a, b;
            a[0] = __uint_as_float(w[j].x << 16); a[1] = __uint_as_float(w[j].x & 0xffff0000u); a[2] = __uint_as_float(w[j].y << 16); a[3] = __uint_as_float(w[j].y & 0xffff0000u);
            b[0] = __uint_as_float(w[j].z << 16); b[1] = __uint_as_float(w[j].z & 0xffff0000u); b[2] = __uint_as_float(w[j].w << 16); b[3] = __uint_as_float(w[j].w & 0xffff0000u);
            y[128 * j] = a * rs; y[128 * j + 1] = b * rs; }
    }
}
constexpr size_t WS_SLAB15 = 864 * MiB;
static_assert(WS_SLAB15 >= WS_A + (size_t)MTOT * FF * 2 && WS_SLAB15 + 4 * 64 * 65536 * 4 <= WS_END, "slab region");
template <int MODE  >
__device__ __forceinline__ f32x4 fixup_v(const float* slab, const bf16* XN, const float* xs, const float* gprev, float alpha, int s, int pn, int lane) {
    const int row = MP + s, tt = (s >> 8) + 8 * pn, col = pn * 256 + lane * 4;
    const GAS f32x4* sp = (const GAS f32x4*)(slab + (size_t)tt * 65536 + (s & 255) * 256 + lane * 4);
    const f32x4 a = (sp[0] + sp[(size_t)64 * 65536 / 4]) + (sp[(size_t)2 * 64 * 65536 / 4] + sp[(size_t)3 * 64 * 65536 / 4]);
    f32x4 b;
    if (MODE == 0) b = *(const GAS f32x4*)(xs + (size_t)s * DM + col);
    else { const unsigned long long w = *(const GAS unsigned long long*)(XN + (size_t)row * DM + col); const f32x4 gp = *(const GAS f32x4*)(gprev + col);
        b[0] = __uint_as_float((unsigned)w << 16) / gp[0]; b[1] = __uint_as_float((unsigned)w & 0xffff0000u) / gp[1];
        b[2] = __uint_as_float((unsigned)(w >> 32) << 16) / gp[2]; b[3] = __uint_as_float((unsigned)(w >> 32) & 0xffff0000u) / gp[3]; }
    return b + a * alpha;
}
template <int MODE, bool FINAL>
__device__ __forceinline__ void fixup_rows(Frame& F, unsigned char* ws, const float* slab, const float* xs, const float* gprev, const float* gnext, float alpha, float* outy) {
    const int gw = F.vcu * NWAVES + F.wave, NGW = F.G * NWAVES, lane = F.lane;
    bf16* XN = (bf16*)(ws + WS_XN); float* rstd = (float*)(ws + WS_RSTD);
    for (int s = gw; s < MS; s += NGW) { const int row = MP + s;
        float ss = 0.f;
#pragma unroll 1
        for (int pn = 0; pn < 8; ++pn) { const f32x4 v = fixup_v<MODE>(slab, XN, xs, gprev, alpha, s, pn, lane); ss += (v[0] * v[0] + v[1] * v[1]) + (v[2] * v[2] + v[3] * v[3]); }
        const float rs = 1.f / sqrtf(wave_sum(ss) * (1.f / DM) + EPS);
#pragma unroll 1
        for (int pn = 0; pn < 8; ++pn) { const f32x4 v = fixup_v<MODE>(slab, XN, xs, gprev, alpha, s, pn, lane); const int col = pn * 256 + lane * 4; const f32x4 gnx = *(const GAS f32x4*)(gnext + col);
            if (FINAL) *(GAS f32x4*)(outy + (size_t)row * DM + col) = v * rs * gnx;
            else { const f32x4 o = v * gnx; *(GAS unsigned long long*)(XN + (size_t)row * DM + col) = (unsigned long long)pk2(o[0], o[1]) | ((unsigned long long)pk2(o[2], o[3]) << 32); } }
        if (!FINAL && lane == 0) rstd[row] = rs;
    }
}
#ifndef ABL_BITS
#define ABL_BITS 0
#endif
#ifndef NO_DIFF
#define NO_DIFF 0
#endif
#ifndef NO_BAND
#define NO_BAND 0
#endif
#ifndef ATT_SD_DIFF
#define ATT_SD_DIFF 1
#endif
#ifndef ATT_SD_BAND
#define ATT_SD_BAND 1
#endif
using att::f32x16;
__device__ __forceinline__ void load_lut(Frame& F, const float* glut, char* lds) {
    __syncthreads();
    int t_ = threadIdx.x; asm volatile("" : "+v"(t_));
    if (t_ < 320) ((float*)(lds + att::LDS_LUT))[t_] = glut[t_];
    __syncthreads();
}
__device__ __forceinline__ void store_o_bf16(const f32x16 (&o)[4], bf16* Ow, int ld, char* lds, int wid) {
    int lane = threadIdx.x; asm volatile("" : "+v"(lane)); lane &= 63;
    const int r32 = lane & 31, hi = lane >> 5;
    bf16* stg = (bf16*)(lds + att::LDS_OSTAGE + wid * 4096);
#pragma unroll
    for (int hf = 0; hf < 2; ++hf) {
#pragma unroll
        for (int r = 0; r < 16; ++r) { const int orow = att::crow(r, hi);
#pragma unroll
            for (int dd = 0; dd < 2; ++dd) stg[orow * 64 + dd * 32 + r32] = (bf16)f2bf(o[2 * hf + dd][r]); }
        asm volatile("s_waitcnt lgkmcnt(0)" ::: "memory");
        bf16* gp = Ow + (size_t)(lane >> 3) * ld + hf * 64 + (lane & 7) * 8;
#pragma unroll
        for (int i = 0; i < 4; ++i) { const v4u v = *(const v4u*)(stg + (i * 8 + (lane >> 3)) * 64 + (lane & 7) * 8); *(v4u*)gp = v; gp += (size_t)8 * ld; }
        asm volatile("s_waitcnt lgkmcnt(0)" ::: "memory");
    }
}
__device__ __forceinline__ void store_ot_bf16(const f32x16 (&o)[4], bf16* Ow, int ld, char* lds, int wid) {
    int lane = threadIdx.x; asm volatile("" : "+v"(lane)); lane &= 63;
    const int q = lane & 31, hi = lane >> 5;
    bf16* stg = (bf16*)(lds + att::LDS_OSTAGE + wid * 4096);
#pragma unroll
    for (int hf = 0; hf < 2; ++hf) {
#pragma unroll
        for (int dd = 0; dd < 2; ++dd)
#pragma unroll
            for (int r = 0; r < 16; ++r) stg[q * 64 + dd * 32 + att::crow(r, hi)] = (bf16)f2bf(o[2 * hf + dd][r]);
        asm volatile("s_waitcnt lgkmcnt(0)" ::: "memory");
        bf16* gp = Ow + (size_t)(lane >> 3) * ld + hf * 64 + (lane & 7) * 8;
#pragma unroll
        for (int i = 0; i < 4; ++i) { const v4u v = *(const v4u*)(stg + (i * 8 + (lane >> 3)) * 64 + (lane & 7) * 8); *(v4u*)gp = v; gp += (size_t)8 * ld; }
        asm volatile("s_waitcnt lgkmcnt(0)" ::: "memory");
    }
}
template <bool sample>
__device__ __forceinline__ void diff_unit(Frame& F, unsigned char* ws, const float* dag, char* lds, int b, int h, int qb, bool dostore = true) {
    bf16* QO = (bf16*)(ws + WS_QO);
    const int wid = F.wave;
    const float lam = *(const float*)(ws + WS_LUT + 32768);
    const float* lut = (const float*)(lds + att::LDS_LUT);
    load_lut(F, (const float*)(ws + WS_LUT) + h * 320, lds);
    att::TileArgs T; T.abl = dostore ? 0 : ABL_BITS;
    size_t qrow; const bf16 *Kb, *Vb;
    if (!sample) { qrow = (size_t)b * SEQ + qb * 256 + wid * 32; Kb = (const bf16*)(ws + WS_KDAP) + (size_t)b * SEQ * 1024 + h * 128; Vb = (const bf16*)(ws + WS_VDAP) + (size_t)b * SEQ * 1024 + h * 128;
        T.t0 = 0; T.NT = 4 * qb + 4; T.tmax = T.NT - 1; T.wlo = 0; T.whi = 4 * qb + (wid >> 1); T.relw = -(qb * 256 + wid * 32); }
    else { qrow = (size_t)MP + b * DT + (wid & 1) * 32; Kb = (const bf16*)(ws + WS_KDAS) + (size_t)b * KDAS_ROWS * 1024 + h * 128; Vb = (const bf16*)(ws + WS_VDAS) + (size_t)b * KDAS_ROWS * 1024 + h * 128;
        T.t0 = 0; T.NT = 18; T.tmax = 16; T.wlo = 0; T.whi = 16; T.relw = -(PAST + (wid & 1) * 32); }
    T.ldq = DM; T.ldk = 1024; T.ldv = 1024; T.Vh = Vb;
    f32x16 o[4]; float l;
#pragma unroll 1
    for (int map = 0; map < 2; ++map) {
        T.Qw = QO + qrow * DM + h * 128 + map * 64; T.Kh = Kb + map * 64;
        att::attn_tiles<64, true, ATT_SD_DIFF, sample>(T, lut, lds, o, l);
        att::attn_normalize_t(o, l);
        if (map == 0) { int t_ = threadIdx.x; asm volatile("" : "+v"(t_));
            f32x4* stash = (f32x4*)(ws + WS_STASH) + ((size_t)blockIdx.x * 512 + t_) * 16;
#pragma unroll
            for (int d = 0; d < 4; ++d)
#pragma unroll
                for (int q = 0; q < 4; ++q) stash[d * 4 + q] = (f32x4){o[d][4 * q], o[d][4 * q + 1], o[d][4 * q + 2], o[d][4 * q + 3]};
        }
    }
    int t2_ = threadIdx.x; asm volatile("" : "+v"(t2_));
    const f32x4* stash = (const f32x4*)(ws + WS_STASH) + ((size_t)blockIdx.x * 512 + t2_) * 16; const int hib = (t2_ >> 5) & 1;
    float ssp = 0.f;
#pragma unroll
    for (int d = 0; d < 4; ++d)
#pragma unroll
        for (int q = 0; q < 4; ++q) { const f32x4 s4 = stash[d * 4 + q];
#pragma unroll
            for (int e = 0; e < 4; ++e) { const int r = 4 * q + e; const float v = s4[e] - lam * o[d][r]; o[d][r] = v; ssp += v * v; } }
    { auto rr = __builtin_amdgcn_permlane32_swap(__float_as_uint(ssp), __float_as_uint(ssp), false, false); ssp = __uint_as_float(rr[0]) + __uint_as_float(rr[1]); }
    const float rsn = (1.f - LAM_INIT) / sqrtf(ssp * (1.f / 128.f) + EPS);
#pragma unroll
    for (int d = 0; d < 4; ++d)
#pragma unroll
        for (int r = 0; r < 16; ++r) o[d][r] *= rsn * dag[d * 32 + (r & 3) + 8 * (r >> 2) + 4 * hib];
    __syncthreads();
    if (dostore && (!sample || wid < 2)) store_ot_bf16(o, QO + qrow * DM + h * 128, DM, lds, wid);
}
template <bool sample>
__device__ __forceinline__ void band_unit(Frame& F, unsigned char* ws, char* lds, int b, int h, int qb, bool dostore = true) {
    bf16* QO = (bf16*)(ws + WS_QO);
    const int wid = F.wave;
    const float* lut = (const float*)(lds + att::LDS_LUT);
    load_lut(F, (const float*)(ws + WS_LUT) + 2560 + h * 320, lds);
    att::TileArgs T; T.abl = 0; size_t qrow;
    if (!sample) { qrow = (size_t)b * SEQ + qb * 256 + wid * 32; const int c0 = 4 * qb, c = c0 + (wid >> 1);
        T.Kh = (const bf16*)(ws + WS_KCBP) + (size_t)b * SEQ * 1024 + h * 128; T.Vh = (const bf16*)(ws + WS_VCBP) + (size_t)b * SEQ * 1024 + h * 128;
        T.t0 = c0 >= 8 ? c0 - 8 : 0; T.tmax = c0 + 3; T.NT = T.tmax - T.t0 + 1; T.wlo = c >= 8 ? c - 8 : 0; T.whi = c; T.relw = -(qb * 256 + wid * 32); }
    else { qrow = (size_t)MP + b * DT + (wid & 1) * 32;
        T.Kh = (const bf16*)(ws + WS_KCBS) + (size_t)b * KCBS_ROWS * 1024 + h * 128; T.Vh = (const bf16*)(ws + WS_VCBS) + (size_t)b * KCBS_ROWS * 1024 + h * 128;
        T.t0 = 0; T.NT = 10; T.tmax = 8; T.wlo = 0; T.whi = 8; T.relw = (PAST - CBR) - (PAST + (wid & 1) * 32); }
    T.ldq = DM; T.ldk = 1024; T.ldv = 1024; T.Qw = QO + qrow * DM + 1024 + h * 128;
    f32x16 o[4]; float l;
    att::attn_tiles<128, true, ATT_SD_BAND, sample>(T, lut, lds, o, l); att::attn_normalize(o, l, lds);
    __syncthreads();
    if (dostore && (!sample || wid < 2)) store_o_bf16(o, QO + qrow * DM + 1024 + h * 128, DM, lds, wid);
}
template <bool sample>
__device__ __forceinline__ void cross_unit(Frame& F, unsigned char* ws, char* lds, int b, int h, int qb, const float* qslab = nullptr) {
    bf16* QX = (bf16*)(ws + WS_QX);
    const int wid = F.wave;
    __syncthreads();
    if (sample && qslab) {
        int t = threadIdx.x; asm volatile("" : "+v"(t));
        const int r = t >> 3, cg = (t & 7) * 16, s = b * DT + r, tt = (s >> 8) + 8 * (h >> 1);
        const GAS f32x4* sp = (const GAS f32x4*)(qslab + (size_t)tt * 65536 + (s & 255) * 256 + (h & 1) * 128 + cg);
        const float sc = ((const GAS float*)(ws + WS_RSTD))[MP + s] * SC_CB;
        f32x4 a[4];
#pragma unroll
        for (int q = 0; q < 4; ++q) a[q] = ((sp[q] + sp[q + (size_t)16 * 65536 / 4]) + (sp[q + (size_t)2 * 16 * 65536 / 4] + sp[q + (size_t)3 * 16 * 65536 / 4])) * sc;
        v4u o0, o1; o0.x = pk2(a[0][0], a[0][1]); o0.y = pk2(a[0][2], a[0][3]); o0.z = pk2(a[1][0], a[1][1]); o0.w = pk2(a[1][2], a[1][3]);
        o1.x = pk2(a[2][0], a[2][1]); o1.y = pk2(a[2][2], a[2][3]); o1.z = pk2(a[3][0], a[3][1]); o1.w = pk2(a[3][2], a[3][3]);
        GAS v4u* d = (GAS v4u*)(QX + (size_t)(MP + s) * XW + h * 128 + cg); d[0] = o0; d[1] = o1;
        asm volatile("s_waitcnt vmcnt(0)" ::: "memory"); __syncthreads();
    }
    att::TileArgs T; T.abl = 0; size_t qrow;
    if (!sample) { qrow = (size_t)b * SEQ + qb * 256 + wid * 32; T.Kh = (const bf16*)(ws + WS_MKP) + (size_t)b * NMEM * XW + h * 128; T.Vh = (const bf16*)(ws + WS_MVP) + (size_t)b * NMEM * XW + h * 128; }
    else { qrow = (size_t)MP + b * DT + (wid & 1) * 32; T.Kh = (const bf16*)(ws + WS_MKS) + (size_t)b * NMEM * XW + h * 128; T.Vh = (const bf16*)(ws + WS_MVS) + (size_t)b * NMEM * XW + h * 128; }
    T.t0 = 0; T.NT = 4; T.tmax = 3; T.wlo = 0; T.whi = 3; T.relw = 0; T.ldq = XW; T.ldk = XW; T.ldv = XW; T.Qw = QX + qrow * XW + h * 128;
    f32x16 o[4]; float l;
    att::attn_tiles<128, false, 2, sample>(T, nullptr, lds, o, l); att::attn_normalize(o, l, lds);
    __syncthreads();
    if (!sample || wid < 2) store_o_bf16(o, QX + qrow * XW + h * 128, XW, lds, wid);
}

constexpr int PT_OFF = MISC_OFF + 128;
__device__ __forceinline__ unsigned long long ldp(LAS unsigned char* lds, int idx) {
    volatile LAS unsigned* p = (volatile LAS unsigned*)(lds + PT_OFF) + 2 * idx;
    const unsigned lo = __builtin_amdgcn_readfirstlane(p[0]), hi = __builtin_amdgcn_readfirstlane(p[1]);
    return ((unsigned long long)hi << 32) | lo;
}
__global__ void __launch_bounds__(NWAVES * 64, 2) mega_fwd(Args args) {
    extern __shared__ __attribute__((aligned(16))) unsigned char lds[];
    Frame F;
    F.lds = (LAS unsigned char*)lds; F.MISC = (volatile LAS unsigned*)(F.lds + MISC_OFF);
    F.tid = threadIdx.x; F.lane = F.tid & 63; F.wave = __builtin_amdgcn_readfirstlane(F.tid >> 6);
    F.G = gridDim.x; { const int bx = blockIdx.x; F.vcu = (F.G % 8 == 0) ? (bx % 8) * (F.G / 8) + bx / 8 : bx; }
    F.ctl = (gu32*)(args.ws + WS_CTL);
    for (int u = F.tid; u < (LDS_BYTES - LDSCTL_OFF) / 4; u += NWAVES * 64) ((LAS unsigned*)(F.lds + LDSCTL_OFF))[u] = 0u;
    __syncthreads();
    if (F.tid == 0) { volatile LAS unsigned long long* PT = (volatile LAS unsigned long long*)(F.lds + PT_OFF);
        PT[0] = (unsigned long long)args.out; PT[1] = (unsigned long long)args.ws; PT[2] = (unsigned long long)args.in[I_XP]; PT[3] = (unsigned long long)args.in[I_XS];
        PT[4] = (unsigned long long)args.in[I_GMIX]; PT[5] = (unsigned long long)args.in[I_BGATE]; PT[6] = (unsigned long long)args.in[I_GCROSS]; PT[7] = (unsigned long long)args.in[I_G2];
        PT[8] = (unsigned long long)args.in[I_DAG]; PT[9] = (unsigned long long)args.in[I_GFINAL]; }
    __syncthreads();
#define LDP(T, idx) ((T)ldp(F.lds, (idx)))
    XcdBarrier bar; bar.bar = (unsigned*)(F.ctl + CW_BAR); bar.x = 0; bar.st = nullptr;
    if (N_LAUNCHES == 1) bar = xcd_barrier_post((unsigned*)(F.ctl + CW_BAR), F.MISC + 8);
#define GRID_BAR() do { if (N_LAUNCHES == 1) xcd_barrier(bar); } while (0)
    const int lo = args.ph_lo, hi = args.ph_hi;
#ifndef PH_MASK
#define PH_MASK 0x1ffff
#endif
#define IN(k) (((PH_MASK >> (k)) & 1) && lo <= (k) && (k) < hi)
#define BOTH(k) (IN(k) && IN((k) + 1))
#define IDS() do { int t_ = threadIdx.x; asm volatile("" : "+v"(t_)); F.tid = t_; F.lane = t_ & 63; } while (0)
    const int G = F.G, bx = (int)blockIdx.x;
    LAS unsigned char* ring = F.lds + RING_OFF;

    if (IN(0)) { IDS(); p0_prologue(F, args); if (BOTH(0)) GRID_BAR(); }
    if (IN(1)) {
        unsigned char* ws = LDP(unsigned char*, 1);
        { pg8::Gemm g{(const bf16*)(ws + WS_XN), (const bf16*)(ws + WS_W1GU), MTOT, 2 * FF, DM}; pg8::StaticOrder S; S.init(MTOT, 2 * FF, G, bx, 0, WGM_GU);
          pg8::EpiSwiGLU E{(bf16*)(ws + WS_A), FF, nullptr, A_BLOCKED};
          pg8::gemm_phase<pg8::EpiSwiGLU, pg8::StaticOrder, true, true>(ring, g, S, E); }
        if (bx >= G - 8) { float* out = LDP(float*, 0);
          pg8::Gemm g{(const bf16*)(ws + WS_XM), (const bf16*)(ws + WS_WMKV), NBP * NMEM, 1024, DM}; pg8::StaticOrder S; S.init(NBP * NMEM, 1024, G, bx - (G - 8));
          pg8::EpiMemKV E{(bf16*)(ws + WS_MKP), (bf16*)(ws + WS_MVP), out};
          pg8::gemm_phase<pg8::EpiMemKV, pg8::StaticOrder, true, true>(ring, g, S, E); }
        if (DEFER_CVT) {
            const int nfull = (MTOT / 256) * (2 * FF / 256) - ((MTOT / 256) * (2 * FF / 256) / G) * G;
            const int lo_b = nfull, hi_b = G - 8;
            if (hi_b > lo_b) { if (bx >= lo_b && bx < hi_b) { IDS(); tr_items(args, (LAS float*)(F.lds + RING_OFF + F.wave * 16384), N_EARLY, N_W1D, (bx - lo_b) * NWAVES + F.wave, (hi_b - lo_b) * NWAVES, F.lane); } }
            else { IDS(); tr_items(args, (LAS float*)(F.lds + RING_OFF + F.wave * 16384), N_EARLY, N_W1D, bx * NWAVES + F.wave, G * NWAVES, F.lane); }
        }
        if (BOTH(1)) GRID_BAR();
    }
    if (IN(2)) {
        unsigned char* ws = LDP(unsigned char*, 1); float* out = LDP(float*, 0);
        pg8::Gemm g{(const bf16*)(ws + WS_A), (const bf16*)(ws + WS_W1D), MTOT, DM, FF, 0, A_BLOCKED}; pg8::StaticOrder S; S.init(MTOT, DM, G, bx, PANEL_REV);
        pg8::EpiResidX E{LDP(const float*, 2), LDP(const float*, 3) - (size_t)MP * DM, 0.5f, LDP(const float*, 4), (bf16*)(ws + WS_XN), (float*)(ws + WS_SSQ)};
        pg8::gemm_phase<pg8::EpiResidX, pg8::StaticOrder, true, true>(ring, g, S, E);
        if (DEFER_CVT) {
            const int nfull = (MTOT / 256) * (DM / 256) - 4 * G;
            if (nfull >= 0 && nfull < G && bx >= nfull) { IDS(); const int gw = (bx - nfull) * NWAVES + F.wave, NGW = (G - nfull) * NWAVES;
                tr_items(args, (LAS float*)(F.lds + RING_OFF + F.wave * 16384), N_W2, NITEMS, gw, NGW, F.lane); cache_rows(args, gw, NGW, F.lane); }
            else if (nfull < 0 || nfull >= G) { IDS(); const int gw = bx * NWAVES + F.wave, NGW = G * NWAVES;
                tr_items(args, (LAS float*)(F.lds + RING_OFF + F.wave * 16384), N_W2, NITEMS, gw, NGW, F.lane); cache_rows(args, gw, NGW, F.lane); }
        }
        if (BOTH(2)) GRID_BAR();
    }
    if (IN(3)) { IDS(); rstd_phase(F, LDP(unsigned char*, 1), MTOT); if (BOTH(3)) GRID_BAR(); }
    if (IN(4)) {
        unsigned char* ws = LDP(unsigned char*, 1); float* out = LDP(float*, 0);
        pg8::Gemm g{(const bf16*)(ws + WS_XN), (const bf16*)(ws + WS_WQKV), MTOT, 6144, DM}; pg8::StaticOrder S; S.init(MTOT, 6144, G, bx, 0, WGM_QKV);
        pg8::EpiQKV E{(const float*)(ws + WS_RSTD), (bf16*)(ws + WS_QO), (bf16*)(ws + WS_KDAP), (bf16*)(ws + WS_KDAS), (bf16*)(ws + WS_KCBS), out};
        pg8::gemm_phase<pg8::EpiQKV, pg8::StaticOrder, true, true>(ring, g, S, E);
        if (BOTH(4)) GRID_BAR();
    }
    if (IN(5)) {
        IDS();
        unsigned char* ws = LDP(unsigned char*, 1); const float* dag = LDP(const float*, 8);
        char* al = (char*)lds + RING_OFF;
#ifndef DUP_DIFF
#define DUP_DIFF 0
#endif
#ifndef DUP_BAND
#define DUP_BAND 0
#endif
        for (int u = F.vcu; u < 1024; u += G) {
            const int v = u & 255, i = u >> 8, bh = v >> 4, s = v & 15; const int qb = i == 0 ? s : i == 1 ? 31 - s : i == 2 ? 32 + s : 63 - s;
            if (!NO_DIFF) diff_unit<false>(F, ws, dag, al, bh >> 3, bh & 7, qb); }
        for (int u = 1024 + F.vcu; u < 1280; u += G) {
            const int v = u & 255;
            if (!NO_DIFF) diff_unit<true>(F, ws, dag, al, v >> 3, v & 7, 0); }
        for (int u = F.vcu; u < 1024; u += G) { const int v = u & 255, i = u >> 8, bh = v >> 4;
            if (!NO_BAND) band_unit<false>(F, ws, al, bh >> 3, bh & 7, (v & 15) * 4 + i); }
        for (int u = 1024 + F.vcu; u < 1280; u += G) { const int v = u & 255;
            if (!NO_BAND) band_unit<true>(F, ws, al, v >> 3, v & 7, 0); }
        __syncthreads();
        if (BOTH(5)) GRID_BAR();
    }
    if (IN(6)) {
        unsigned char* ws = LDP(unsigned char*, 1);
        pg8::Gemm g{(const bf16*)(ws + WS_XN), (const bf16*)(ws + WS_WG), MTOT, 4096, DM}; pg8::StaticOrder S; S.init(MTOT, 4096, G, bx, PANEL_REV, WGM_QKV);
        pg8::EpiGates E{(const float*)(ws + WS_RSTD), LDP(const float*, 5), (bf16*)(ws + WS_GR), (bf16*)(ws + WS_GB)};
        pg8::gemm_phase<pg8::EpiGates, pg8::StaticOrder, true, true>(ring, g, S, E);
        if (BOTH(6)) GRID_BAR();
    }
    if (IN(7)) {
        unsigned char* ws = LDP(unsigned char*, 1);
        pg8::Gemm g{(const bf16*)(ws + WS_QO), (const bf16*)(ws + WS_WBR), MTOT, DM, DM}; pg8::StaticOrder S; S.init(MTOT, DM, G, bx);
        pg8::EpiMix E{(const bf16*)(ws + WS_GR), (const bf16*)(ws + WS_GB), (bf16*)(ws + WS_MIX)};
        pg8::gemm_phase<pg8::EpiMix, pg8::StaticOrder, true, true>(ring, g, S, E);
        if (DEFER_CVT) {
            const int nfull = (MTOT / 256) * (DM / 256) - 4 * G;
            if (nfull >= 0 && nfull < G) { if (bx >= nfull) { IDS(); tr_items(args, (LAS float*)(F.lds + RING_OFF + F.wave * 16384), N_W1D, N_W2, (bx - nfull) * NWAVES + F.wave, (G - nfull) * NWAVES, F.lane); } }
            else { IDS(); tr_items(args, (LAS float*)(F.lds + RING_OFF + F.wave * 16384), N_W1D, N_W2, bx * NWAVES + F.wave, G * NWAVES, F.lane); }
        }
        if (BOTH(7)) GRID_BAR();
    }
    if (IN(8)) {
        unsigned char* ws = LDP(unsigned char*, 1); const bool split = (G == 256);
        { pg8::Gemm g{(const bf16*)(ws + WS_MIX), (const bf16*)(ws + WS_WO), split ? MP : MTOT, DM, DM}; pg8::StaticOrder S; S.init(split ? MP : MTOT, DM, G, bx, PANEL_REV);
          pg8::EpiResidH<false> E{(bf16*)(ws + WS_XN), LDP(const float*, 4), LDP(const float*, 6), nullptr, 1.0f, (float*)(ws + WS_SSQ)};
          pg8::gemm_phase<pg8::EpiResidH<false>, pg8::StaticOrder, true, true>(ring, g, S, E); }
        if (split) { const int tt = bx >> 2, ks = bx & 3; float* slab = LDP(float*, 0) + O_Y;
          pg8::Gemm g{(const bf16*)(ws + WS_MIX) + (size_t)MP * DM + ks * (DM / 4), (const bf16*)(ws + WS_WO) + ks * (DM / 4), MS, DM, DM / 4, DM}; pg8::OneUnit S{{tt & 7, tt >> 3}};
          pg8::EpiSlab E{slab + (size_t)(ks * 64 + tt) * 65536};
          pg8::gemm_phase<pg8::EpiSlab, pg8::OneUnit, true, true>(ring, g, S, E); }
        if (BOTH(8)) GRID_BAR();
    }
    if (IN(9)) { IDS(); unsigned char* ws = LDP(unsigned char*, 1); const bool split = (G == 256); rstd_phase(F, ws, split ? MP : MTOT);
        if (split) fixup_rows<1, false>(F, ws, LDP(const float*, 0) + O_Y, nullptr, LDP(const float*, 4), LDP(const float*, 6), 1.0f, nullptr);
        if (BOTH(9)) GRID_BAR(); }
    if (IN(10)) {
        unsigned char* ws = LDP(unsigned char*, 1);
        const bool split = (G == 256);
        { pg8::Gemm g{(const bf16*)(ws + WS_XN), (const bf16*)(ws + WS_WCQ), split ? MP : MTOT, XW, DM}; pg8::StaticOrder S; S.init(split ? MP : MTOT, XW, G, bx);
          pg8::EpiScaleBf16 E{(const float*)(ws + WS_RSTD), (bf16*)(ws + WS_QX), XW, SC_CB};
          pg8::gemm_phase<pg8::EpiScaleBf16, pg8::StaticOrder, true, true>(ring, g, S, E); }
        if (split && bx < 64) { const int tt = bx >> 2, ks = bx & 3; float* slab = LDP(float*, 0) + O_Y;
          pg8::Gemm g{(const bf16*)(ws + WS_XN) + (size_t)MP * DM + ks * (DM / 4), (const bf16*)(ws + WS_WCQ) + ks * (DM / 4), MS, XW, DM / 4, DM}; pg8::OneUnit S{{tt & 7, tt >> 3}};
          pg8::EpiSlab E{slab + (size_t)(ks * 16 + tt) * 65536};
          pg8::gemm_phase<pg8::EpiSlab, pg8::OneUnit, true, true>(ring, g, S, E); }
        if (BOTH(10)) GRID_BAR();
    }
    if (IN(11)) {
        IDS();
        unsigned char* ws = LDP(unsigned char*, 1);
        char* al = (char*)lds + RING_OFF;
        for (int u = F.vcu; u < 512; u += G) cross_unit<false>(F, ws, al, u >> 8, (u >> 6) & 3, u & 63);
        for (int u = 512 + F.vcu; u < 640; u += G) cross_unit<true>(F, ws, al, (u - 512) >> 2, (u - 512) & 3, 0, (G == 256) ? LDP(const float*, 0) + O_Y : nullptr);
        __syncthreads();
        if (BOTH(11)) GRID_BAR();
    }
    if (IN(12)) {
        unsigned char* ws = LDP(unsigned char*, 1); const bool split = (G == 256);
        { pg8::Gemm g{(const bf16*)(ws + WS_QX), (const bf16*)(ws + WS_WCO), split ? MP : MTOT, DM, XW}; pg8::StaticOrder S; S.init(split ? MP : MTOT, DM, G, bx, PANEL_REV);
          pg8::EpiResidH<false> E{(bf16*)(ws + WS_XN), LDP(const float*, 6), LDP(const float*, 7), nullptr, 1.0f, (float*)(ws + WS_SSQ)};
          pg8::gemm_phase<pg8::EpiResidH<false>, pg8::StaticOrder, true, true>(ring, g, S, E); }
        if (split) { const int tt = bx >> 2, ks = bx & 3; float* slab = LDP(float*, 0) + O_Y;
          pg8::Gemm g{(const bf16*)(ws + WS_QX) + (size_t)MP * XW + ks * (XW / 4), (const bf16*)(ws + WS_WCO) + ks * (XW / 4), MS, DM, XW / 4, XW}; pg8::OneUnit S{{tt & 7, tt >> 3}};
          pg8::EpiSlab E{slab + (size_t)(ks * 64 + tt) * 65536};
          pg8::gemm_phase<pg8::EpiSlab, pg8::OneUnit, true, true>(ring, g, S, E); }
        if (BOTH(12)) GRID_BAR();
    }
    if (IN(13)) { IDS(); unsigned char* ws = LDP(unsigned char*, 1); const bool split = (G == 256); rstd_phase(F, ws, split ? MP : MTOT);
        if (split) fixup_rows<1, false>(F, ws, LDP(const float*, 0) + O_Y, nullptr, LDP(const float*, 6), LDP(const float*, 7), 1.0f, nullptr);
        if (BOTH(13)) GRID_BAR(); }
    if (IN(14)) {
        unsigned char* ws = LDP(unsigned char*, 1);
        pg8::Gemm g{(const bf16*)(ws + WS_XN), (const bf16*)(ws + WS_W2GU), MTOT, 2 * FF, DM}; pg8::StaticOrder S; S.init(MTOT, 2 * FF, G, bx, 0, WGM_GU);
        pg8::EpiSwiGLU E{(bf16*)(ws + WS_A), FF, (const float*)(ws + WS_RSTD), A_BLOCKED};
        pg8::gemm_phase<pg8::EpiSwiGLU, pg8::StaticOrder, true, true>(ring, g, S, E);
        if (BOTH(14)) GRID_BAR();
    }
    if (IN(15)) {
        unsigned char* ws = LDP(unsigned char*, 1); const bool split = (G == 256);
        { pg8::Gemm g{(const bf16*)(ws + WS_A), (const bf16*)(ws + WS_W2D), split ? MP : MTOT, DM, FF, 0, A_BLOCKED}; pg8::StaticOrder S; S.init(split ? MP : MTOT, DM, G, bx, PANEL_REV);
          pg8::EpiResidH<false> E{(bf16*)(ws + WS_XN), LDP(const float*, 7), LDP(const float*, 9), nullptr, 0.5f, (float*)(ws + WS_SSQ)};
          pg8::gemm_phase<pg8::EpiResidH<false>, pg8::StaticOrder, true, true>(ring, g, S, E); }
        if (split) { const int tt = bx >> 2, ks = bx & 3; float* slab = (float*)(ws + WS_SLAB15);
          pg8::Gemm g{(const bf16*)(ws + WS_A) + (size_t)MP * FF + (A_BLOCKED ? (size_t)ks * (FF / 4 / 64) * (256 * 64) : (size_t)ks * (FF / 4)), (const bf16*)(ws + WS_W2D) + ks * (FF / 4), MS, DM, FF / 4, FF, A_BLOCKED}; pg8::OneUnit S{{tt & 7, tt >> 3}};
          pg8::EpiSlab E{slab + (size_t)(ks * 64 + tt) * 65536};
          pg8::gemm_phase<pg8::EpiSlab, pg8::OneUnit, true, true>(ring, g, S, E); }
        if (BOTH(15)) GRID_BAR();
    }
    if (IN(16)) { IDS(); unsigned char* ws = LDP(unsigned char*, 1); float* out = LDP(float*, 0); const bool split = (G == 256); final_phase(F, ws, out, split ? MP : MTOT);
        if (split) fixup_rows<1, true>(F, ws, (const float*)(ws + WS_SLAB15), nullptr, LDP(const float*, 7), LDP(const float*, 9), 0.5f, out + O_Y); }
#undef IN
#undef BOTH
#undef GRID_BAR
#undef LDP
#undef IDS
}

extern "C" void kernel_launch(void* const* d_in, const int* in_sizes, int n_in, void* d_out, int out_size, void* d_ws, size_t ws_size, hipStream_t stream) {
    static int grid = 0;
    if (grid == 0) {
        if (n_in != 33 || (size_t)out_size != O_TOTAL || ws_size < WS_END) { fprintf(stderr, "kernel_launch: shape mismatch: n_in %d out %d ws %zu (need 33, %zu, >= %zu)\n", n_in, out_size, ws_size, (size_t)O_TOTAL, (size_t)WS_END); grid = -1; return; }
        int dev = 0, cus = 0, per_cu = 0;
        if (hipGetDevice(&dev) != hipSuccess || hipDeviceGetAttribute(&cus, hipDeviceAttributeMultiprocessorCount, dev) != hipSuccess) { grid = -1; return; }
        if (hipFuncSetAttribute((const void*)mega_fwd, hipFuncAttributeMaxDynamicSharedMemorySize, LDS_BYTES) != hipSuccess) { fprintf(stderr, "kernel_launch: hipFuncSetAttribute failed\n"); grid = -1; return; }
        if (hipOccupancyMaxActiveBlocksPerMultiprocessor(&per_cu, (const void*)mega_fwd, NWAVES * 64, LDS_BYTES) != hipSuccess || per_cu < 1)
            fprintf(stderr, "kernel_launch: note: occupancy query reports %d workgroups per CU\n", per_cu);
        (void)hipGetLastError();
        grid = cus;
    }
    if (grid < 0) return;
    if (hipMemsetAsync((char*)d_ws + WS_CTL, 0, CTL_ZERO_BYTES, stream) != hipSuccess) return;
    Args a{};
    for (int i = 0; i < 33; ++i) a.in[i] = (const float*)d_in[i];
    a.out = (float*)d_out; a.ws = (unsigned char*)d_ws;
    if (N_LAUNCHES == 1) { a.ph_lo = 0; a.ph_hi = N_PHASES; a.li = 0; hipLaunchKernelGGL(mega_fwd, dim3(grid), dim3(NWAVES * 64), LDS_BYTES, stream, a); }
    else for (int p = 0; p < N_PHASES; ++p) { a.ph_lo = p; a.ph_hi = p + 1; a.li = p; hipLaunchKernelGGL(mega_fwd, dim3(grid), dim3(NWAVES * 64), LDS_BYTES, stream, a); }
    const hipError_t le = hipPeekAtLastError();
    if (le != hipSuccess) fprintf(stderr, "kernel_launch: launch failed: %s\n", hipGetErrorName(le));
}
```

```cpp
#include <hip/hip_runtime.h>
#include <cstdio>
#include <cstdint>
#include <cmath>

constexpr int DM = 2048, SEQ = 16384, NBP = 2, MP = NBP * SEQ, DB = 32, DT = 64, MS = DB * DT, MTOT = MP + MS;
constexpr int PAST = 1024, FF = 5632, NMEM = 256, XW = 512, CBR = 512;
constexpr int KDAS_ROWS = PAST + DT  , KCBS_ROWS = CBR + DT  ;
constexpr float EPS = 1e-6f, LOG2E = 1.4426950408889634f;
constexpr float SC_DA = 0.125f * LOG2E, SC_CB = 0.08838834764831845f * LOG2E;
constexpr float LAM_INIT = 0.2f;

constexpr size_t MiB = 1u << 20;
constexpr size_t WS_CTL = 0, CTL_ZERO_BYTES = 1 * MiB;
constexpr size_t WS_SSQ = 1 * MiB;
constexpr size_t WS_RSTD = 6 * MiB;
constexpr size_t WS_LUT = 6 * MiB + 512 * 1024;
constexpr size_t WS_XM = 7 * MiB;
constexpr size_t WS_MKP = 9 * MiB, WS_MVP = 9 * MiB + 512 * 1024;
constexpr size_t WS_MKS = 10 * MiB, WS_MVS = 18 * MiB;
constexpr size_t WS_W1GU = 26 * MiB, WS_W1D = 70 * MiB, WS_WQKV = 92 * MiB, WS_WG = 116 * MiB, WS_WBR = 132 * MiB, WS_WO = 140 * MiB;
constexpr size_t WS_WMKV = 148 * MiB, WS_WCQ = 152 * MiB, WS_WCO = 154 * MiB, WS_W2GU = 156 * MiB, WS_W2D = 200 * MiB;
constexpr size_t WS_XN = 222 * MiB;
constexpr size_t WS_QX = 358 * MiB;
constexpr size_t WS_STASH = WS_QX;
constexpr size_t WS_R = 392 * MiB;
constexpr size_t WS_A = WS_R;
constexpr size_t WS_QO = WS_R;
constexpr size_t WS_KDAP = 528 * MiB, WS_VDAP = 592 * MiB, WS_KCBP = 656 * MiB, WS_VCBP = 720 * MiB;
constexpr size_t WS_KDAS = 784 * MiB, WS_VDAS = 852 * MiB;
constexpr size_t WS_KCBS = 920 * MiB, WS_VCBS = 956 * MiB;
constexpr size_t WS_GR = 528 * MiB, WS_GB = 664 * MiB;
constexpr size_t WS_MIX = 800 * MiB;
constexpr size_t WS_END = 992 * MiB;
static_assert(WS_A + (size_t)MTOT * FF * 2 <= WS_KDAS, "A1/A2 must not reach the sample K/V buffers");
static_assert(WS_GB + (size_t)MTOT * DM * 2 <= WS_MIX && WS_MIX + (size_t)MTOT * DM * 2 <= WS_END, "ws map");
static_assert(WS_VCBS + (size_t)DB * KCBS_ROWS * 1024 * 2 <= WS_END, "ws map");
static_assert(WS_XN + (size_t)MTOT * DM * 2 <= WS_QX && WS_QX + (size_t)MTOT * XW * 2 <= WS_R, "ws map");

constexpr size_t O_Y = 0, O_DAKP = (size_t)MTOT * DM, O_DAVP = O_DAKP + (size_t)MP * 1024, O_CBKP = O_DAVP + (size_t)MP * 1024, O_CBVP = O_CBKP + (size_t)NBP * CBR * 1024;
constexpr size_t O_MKP = O_CBVP + (size_t)NBP * CBR * 1024, O_MVP = O_MKP + (size_t)NBP * NMEM * XW, O_DAKS = O_MVP + (size_t)NBP * NMEM * XW, O_DAVS = O_DAKS + (size_t)MS * 1024;
constexpr size_t O_CBKS = O_DAVS + (size_t)MS * 1024, O_CBVS = O_CBKS + (size_t)DB * CBR * 1024, O_TOTAL = O_CBVS + (size_t)DB * CBR * 1024;
static_assert(O_TOTAL == 178782208, "output size");

constexpr int CW_TMO = 0, CW_CODE = 1, CW_BAR = 4096;

constexpr int RING_OFF = 0, RING_BYTES = 131072, LDSCTL_OFF = 137216  , MISC_OFF = LDSCTL_OFF + 320, LDS_BYTES = 147456;
constexpr int NWAVES = 8;
namespace pg8 {
#define PG8_LAS __attribute__((address_space(3)))
typedef unsigned short bf16_t;
typedef short bf16x8 __attribute__((ext_vector_type(8)));
typedef float f32x4 __attribute__((ext_vector_type(4)));
typedef unsigned u32x4 __attribute__((ext_vector_type(4)));
constexpr int BM = 256, BK = 64, HALF = 128, HTB = HALF * BK * 2  , STAGE_BYTES = 8 * HTB, NXCD = 8, WGM = 4;

__host__ __device__ __forceinline__ int lds_byte(int r, int c) { const int st = (r >> 4) * 2 + (c >> 5), rr = r & 15, cc = c & 31, ob = rr * 64 + cc * 2; return st * 1024 + (ob ^ (((ob >> 9) & 1) << 5)); }
__host__ __device__ __forceinline__ void stage_rc(int b, int& R, int& C) { const int st = b / 1024, sb = b % 1024, swz = sb ^ (((sb >> 9) & 1) << 5); R = (st >> 1) * 16 + swz / 64; C = (st & 1) * 32 + (swz % 64) / 2; }
__host__ __device__ __forceinline__ int perm32(int rho) { const int n = rho >> 4, i = rho & 15; return 8 * (i >> 2) + 4 * n + (i & 3); }

#ifndef PN_ROT
#define PN_ROT 0
#endif
struct Unit { int pm, pn; };
struct Gemm { const bf16_t* A; const bf16_t* Bt; int M, N, K; int ld = 0; int ablk = 0; };
struct OneUnit { Unit u; __host__ __device__ bool next(int i, Unit& o) const { if (i) return false; o = u; return true; } __device__ __forceinline__ void a_ready(const Unit&) const {} __device__ __forceinline__ void done(const Unit&) const {} };

struct StaticOrder {
    int nM, nN, nwg, G, c; int rev = 0; int wgm = WGM;
    __host__ __device__ void init(int M, int N, int G_, int c_, int rev_ = 0, int wgm_ = WGM) { nM = M / BM; nN = N / BM; nwg = nM * nN; G = G_; c = c_; rev = rev_; wgm = wgm_; }
    __host__ __device__ bool next(int i, Unit& u) const {
        const long L = (long)i * G + c; if (L >= nwg) return false;
        int wgid = (int)L; { const int q = nwg / NXCD, r = nwg % NXCD, xcd = wgid % NXCD, off = wgid / NXCD; wgid = (xcd < r ? xcd * (q + 1) : r * (q + 1) + (xcd - r) * q) + off; }
        const int nig = wgm * nN, gid = wgid / nig, fm = gid * wgm, gsz = (nM - fm) < wgm ? (nM - fm) : wgm;
        u.pm = fm + ((wgid % nig) % gsz); u.pn = (wgid % nig) / gsz; if (rev) u.pm = nM - 1 - u.pm;
        if (PN_ROT) u.pn = (u.pn + gid * PN_ROT) % nN;
        return true;
    }
    __device__ __forceinline__ void a_ready(const Unit&) const {}
    __device__ __forceinline__ void done(const Unit&) const {}
};

__device__ __forceinline__ unsigned cvt_pk_bf16(float lo, float hi) { unsigned r; asm volatile("v_cvt_pk_bf16_f32 %0, %1, %2" : "=v"(r) : "v"(lo), "v"(hi)); return r; }
typedef float f32x2 __attribute__((ext_vector_type(2)));
#define GAS_ __attribute__((address_space(1)))
__device__ __forceinline__ float sigm(float x) { return __builtin_amdgcn_rcpf(1.f + __builtin_amdgcn_exp2f(-1.4426950408889634f * x)); }
__device__ __forceinline__ u32x4 pack8(const f32x4 a, const f32x4 b) { u32x4 w; w.x = cvt_pk_bf16(a[0], a[1]); w.y = cvt_pk_bf16(a[2], a[3]); w.z = cvt_pk_bf16(b[0], b[1]); w.w = cvt_pk_bf16(b[2], b[3]); return w; }
__device__ __forceinline__ void unpack8(const u32x4 w, f32x4& a, f32x4& b) {
    a[0] = __uint_as_float(w.x << 16); a[1] = __uint_as_float(w.x & 0xffff0000u); a[2] = __uint_as_float(w.y << 16); a[3] = __uint_as_float(w.y & 0xffff0000u);
    b[0] = __uint_as_float(w.z << 16); b[1] = __uint_as_float(w.z & 0xffff0000u); b[2] = __uint_as_float(w.w << 16); b[3] = __uint_as_float(w.w & 0xffff0000u); }

struct EpiSwiGLU {
    static constexpr bool PERM = true, AFTER_DRAIN = false, MIDK = false;
    bf16_t* O; int ldc; const float* rstd; int blk;
    __device__ __forceinline__ void operator()(const f32x4 (&acc)[2][2][4][2], const Unit& u, int wr, int wc, int fr, int fq) const {
        asm volatile("" : "+v"(fr), "+v"(fq));
        const int row0 = u.pm * BM + wr * 64 + fr, col0 = u.pn * HALF + wc * 32 + 8 * fq;
#pragma unroll
        for (int ai = 0; ai < 2; ++ai)
#pragma unroll
            for (int m = 0; m < 4; ++m) {
                const int row = row0 + ai * HALF + m * 16; const float rs = rstd ? ((const GAS_ float*)rstd)[row] : 1.f;
                f32x4 o[2];
#pragma unroll
                for (int n = 0; n < 2; ++n) { const f32x4 g = acc[ai][0][m][n] * rs, up = acc[ai][1][m][n] * rs;
#pragma unroll
                    for (int e = 0; e < 4; ++e) o[n][e] = g[e] * sigm(g[e]) * up[e]; }
                if (blk) *(GAS_ u32x4*)(O + (size_t)(row >> 8) * ((size_t)BM * ldc) + (size_t)(col0 >> 6) * (BM * BK) + (row & 255) * BK + (col0 & 63)) = pack8(o[0], o[1]);
                else *(GAS_ u32x4*)(O + (size_t)row * ldc + col0) = pack8(o[0], o[1]);
            }
    }
};

struct EpiResidX {
    static constexpr bool PERM = true, AFTER_DRAIN = false, MIDK = false;
    const float* base_p; const float* base_s; float alpha; const float* gnext; bf16_t* HG; float* ssq;
    __device__ __forceinline__ void operator()(const f32x4 (&acc)[2][2][4][2], const Unit& u, int wr, int wc, int fr, int fq) const {
        asm volatile("" : "+v"(fr), "+v"(fq));
        const int row0 = u.pm * BM + wr * 64 + fr, col0 = u.pn * BM + wc * 32 + 8 * fq;
        const float* base = (u.pm < MP / BM) ? base_p : base_s;
        f32x4 gn[2][2];
#pragma unroll
        for (int bj = 0; bj < 2; ++bj)
#pragma unroll
            for (int n = 0; n < 2; ++n) gn[bj][n] = *(const GAS_ f32x4*)(gnext + col0 + bj * HALF + 4 * n);
#pragma unroll
        for (int ai = 0; ai < 2; ++ai) {
#pragma unroll
            for (int mh = 0; mh < 2; ++mh) {
                f32x4 xb[2][2][2];
#pragma unroll
                for (int mm = 0; mm < 2; ++mm)
#pragma unroll
                    for (int bj = 0; bj < 2; ++bj)
#pragma unroll
                        for (int n = 0; n < 2; ++n) xb[mm][bj][n] = *(const GAS_ f32x4*)(base + (size_t)(row0 + ai * HALF + (2 * mh + mm) * 16) * DM + col0 + bj * HALF + 4 * n);
#pragma unroll
                for (int mm = 0; mm < 2; ++mm) { const int m = 2 * mh + mm;
                    const int row = row0 + ai * HALF + m * 16; const size_t off = (size_t)row * DM + col0; float ss = 0.f;
#pragma unroll
                    for (int bj = 0; bj < 2; ++bj) { f32x4 v[2];
#pragma unroll
                        for (int n = 0; n < 2; ++n) { v[n] = xb[mm][bj][n] + acc[ai][bj][m][n] * alpha; ss += (v[n][0] * v[n][0] + v[n][1] * v[n][1]) + (v[n][2] * v[n][2] + v[n][3] * v[n][3]); }
                        *(GAS_ u32x4*)(HG + off + bj * HALF) = pack8(v[0] * gn[bj][0], v[1] * gn[bj][1]); }
                    ss += __shfl_xor(ss, 16); ss += __shfl_xor(ss, 32);
                    if (fq == 0) ((GAS_ float*)ssq)[(size_t)row * 32 + u.pn * 4 + wc] = ss;
                }
            }
        }
    }
};
template <bool OUT_F32> struct EpiResidH {
    static constexpr bool PERM = true, AFTER_DRAIN = false, MIDK = false;
    bf16_t* HG; const float* gprev; const float* gnext; float* outf; float alpha; float* ssq;
    __device__ __forceinline__ void operator()(const f32x4 (&acc)[2][2][4][2], const Unit& u, int wr, int wc, int fr, int fq) const {
        asm volatile("" : "+v"(fr), "+v"(fq));
        const int row0 = u.pm * BM + wr * 64 + fr, col0 = u.pn * BM + wc * 32 + 8 * fq;
        f32x4 rg[2][2], gn[2][2];
#pragma unroll
        for (int bj = 0; bj < 2; ++bj)
#pragma unroll
            for (int n = 0; n < 2; ++n) { const f32x4 g = *(const GAS_ f32x4*)(gprev + col0 + bj * HALF + 4 * n);
#pragma unroll
                for (int e = 0; e < 4; ++e) rg[bj][n][e] = 1.0f / g[e];
                gn[bj][n] = OUT_F32 ? (f32x4){0.f, 0.f, 0.f, 0.f} : *(const GAS_ f32x4*)(gnext + col0 + bj * HALF + 4 * n); }
#pragma unroll
        for (int ai = 0; ai < 2; ++ai) {
            u32x4 hb[4][2];
#pragma unroll
            for (int m = 0; m < 4; ++m)
#pragma unroll
                for (int bj = 0; bj < 2; ++bj) hb[m][bj] = *(const GAS_ u32x4*)(HG + (size_t)(row0 + ai * HALF + m * 16) * DM + col0 + bj * HALF);
#pragma unroll
            for (int m = 0; m < 4; ++m) {
                const int row = row0 + ai * HALF + m * 16; const size_t off = (size_t)row * DM + col0; float ss = 0.f;
#pragma unroll
                for (int bj = 0; bj < 2; ++bj) { f32x4 h0, h1; unpack8(hb[m][bj], h0, h1);
                    const f32x4 v0 = h0 * rg[bj][0] + acc[ai][bj][m][0] * alpha, v1 = h1 * rg[bj][1] + acc[ai][bj][m][1] * alpha;
                    ss += (v0[0] * v0[0] + v0[1] * v0[1]) + (v0[2] * v0[2] + v0[3] * v0[3]) + (v1[0] * v1[0] + v1[1] * v1[1]) + (v1[2] * v1[2] + v1[3] * v1[3]);
                    if (OUT_F32) { *(GAS_ f32x4*)(outf + off + bj * HALF) = v0; *(GAS_ f32x4*)(outf + off + bj * HALF + 4) = v1; }
                    else *(GAS_ u32x4*)(HG + off + bj * HALF) = pack8(v0 * gn[bj][0], v1 * gn[bj][1]); }
                ss += __shfl_xor(ss, 16); ss += __shfl_xor(ss, 32);
                if (fq == 0) ((GAS_ float*)ssq)[(size_t)row * 32 + u.pn * 4 + wc] = ss;
            }
        }
    }
};

struct EpiQKV {
    static constexpr bool PERM = true, AFTER_DRAIN = false, MIDK = false;
    const float* rstd; bf16_t* QO; bf16_t* KVP; bf16_t* KVS_DA; bf16_t* KVS_CB; float* out;
    __device__ __forceinline__ void operator()(const f32x4 (&acc)[2][2][4][2], const Unit& u, int wr, int wc, int fr, int fq) const {
        asm volatile("" : "+v"(fr), "+v"(fq));
        const int reg = u.pn >> 2, cin0 = (u.pn & 3) * BM + wc * 32 + 8 * fq, row0 = u.pm * BM + wr * 64 + fr;
        const bool prompt = u.pm < MP / BM;
        const float sc = reg == 0 ? SC_DA : (reg == 3 ? SC_CB : 1.f);
        const int kv = reg == 1 ? 0 : reg == 2 ? 1 : reg == 4 ? 2 : 3;
        const bool cb = reg >= 4;
#pragma unroll
        for (int ai = 0; ai < 2; ++ai)
#pragma unroll
            for (int m = 0; m < 4; ++m) {
                const int row = row0 + ai * HALF + m * 16; const float rs = ((const GAS_ float*)rstd)[row];
                bf16_t* bd; float* fd = nullptr;
                if (reg == 0) bd = QO + (size_t)row * DM + cin0;
                else if (reg == 3) bd = QO + (size_t)row * DM + 1024 + cin0;
                else if (prompt) {
                    bd = KVP + (size_t)kv * (32u * 1024u * 1024u) + (size_t)row * 1024 + cin0;
                    if (!cb) fd = out + (kv == 0 ? O_DAKP : O_DAVP) + (size_t)row * 1024 + cin0;
                    else { const int t = row & (SEQ - 1), b = row >> 14; if (t >= SEQ - CBR) fd = out + (kv == 2 ? O_CBKP : O_CBVP) + (size_t)(b * CBR + t - (SEQ - CBR)) * 1024 + cin0; }
                } else {
                    const int s = row - MP, b = s >> 6, t = s & 63;
                    if (!cb) { bd = KVS_DA + (size_t)kv * (34u * 1024u * 1024u) + (size_t)(b * KDAS_ROWS + PAST + t) * 1024 + cin0;
                               fd = out + (kv == 0 ? O_DAKS : O_DAVS) + (size_t)s * 1024 + cin0; }
                    else { bd = KVS_CB + (size_t)(kv - 2) * (18u * 1024u * 1024u) + (size_t)(b * KCBS_ROWS + CBR + t) * 1024 + cin0;
                           fd = out + (kv == 2 ? O_CBKS : O_CBVS) + (size_t)(b * CBR + (CBR - DT) + t) * 1024 + cin0; }
                }
#pragma unroll
                for (int bj = 0; bj < 2; ++bj) { const f32x4 v0 = acc[ai][bj][m][0] * rs, v1 = acc[ai][bj][m][1] * rs;
                    *(GAS_ u32x4*)(bd + bj * HALF) = pack8(v0 * sc, v1 * sc);
                    if (fd) { *(GAS_ f32x4*)(fd + bj * HALF) = v0; *(GAS_ f32x4*)(fd + bj * HALF + 4) = v1; } }
            }
    }
};

struct EpiGates {
    static constexpr bool PERM = true, AFTER_DRAIN = false, MIDK = false;
    const float* rstd; const float* bgate; bf16_t* GR; bf16_t* GB;
    __device__ __forceinline__ void operator()(const f32x4 (&acc)[2][2][4][2], const Unit& u, int wr, int wc, int fr, int fq) const {
        asm volatile("" : "+v"(fr), "+v"(fq));
        const int row0 = u.pm * BM + wr * 64 + fr, col0 = u.pn * HALF + wc * 32 + 8 * fq;
        f32x4 ba[2], bb[2];
#pragma unroll
        for (int n = 0; n < 2; ++n) { ba[n] = *(const GAS_ f32x4*)(bgate + col0 + 4 * n); bb[n] = *(const GAS_ f32x4*)(bgate + DM + col0 + 4 * n); }
#pragma unroll
        for (int ai = 0; ai < 2; ++ai)
#pragma unroll
            for (int m = 0; m < 4; ++m) {
                const int row = row0 + ai * HALF + m * 16; const float rs = ((const GAS_ float*)rstd)[row];
                f32x4 r[2], g[2];
#pragma unroll
                for (int n = 0; n < 2; ++n) { const f32x4 za = acc[ai][0][m][n] * rs + ba[n], zb = acc[ai][1][m][n] * rs + bb[n];
#pragma unroll
                    for (int e = 0; e < 4; ++e) { const float xa = fminf(fmaxf(za[e], -30.f), 30.f), xb = fminf(fmaxf(zb[e], -30.f), 30.f);
                        const float ea = 1.f + __builtin_amdgcn_exp2f(-1.4426950408889634f * xa), eb = 1.f + __builtin_amdgcn_exp2f(-1.4426950408889634f * xb);
                        g[n][e] = __builtin_amdgcn_rcpf(eb); r[n][e] = eb * __builtin_amdgcn_rcpf(ea); } }
                *(GAS_ u32x4*)(GR + (size_t)row * DM + col0) = pack8(r[0], r[1]);
                *(GAS_ u32x4*)(GB + (size_t)row * DM + col0) = pack8(g[0], g[1]);
            }
    }
};

struct EpiMix {
    static constexpr bool PERM = true, AFTER_DRAIN = false, MIDK = true;
    const bf16_t* GR; const bf16_t* GB; bf16_t* MIX;
    __device__ __forceinline__ void midk(f32x4 (&acc)[2][2][4][2], const Unit& u, int wr, int wc, int fr, int fq) const {
        asm volatile("" : "+v"(fr), "+v"(fq));
        const int row0 = u.pm * BM + wr * 64 + fr, col0 = u.pn * BM + wc * 32 + 8 * fq;
#pragma unroll
        for (int ai = 0; ai < 2; ++ai) { u32x4 w[4][2];
#pragma unroll
            for (int m = 0; m < 4; ++m)
#pragma unroll
                for (int bj = 0; bj < 2; ++bj) w[m][bj] = *(const GAS_ u32x4*)(GR + (size_t)(row0 + ai * HALF + m * 16) * DM + col0 + bj * HALF);
#pragma unroll
            for (int m = 0; m < 4; ++m)
#pragma unroll
                for (int bj = 0; bj < 2; ++bj) { f32x4 a, b; unpack8(w[m][bj], a, b); acc[ai][bj][m][0] *= a; acc[ai][bj][m][1] *= b; } }
    }
    __device__ __forceinline__ void operator()(const f32x4 (&acc)[2][2][4][2], const Unit& u, int wr, int wc, int fr, int fq) const {
        asm volatile("" : "+v"(fr), "+v"(fq));
        const int row0 = u.pm * BM + wr * 64 + fr, col0 = u.pn * BM + wc * 32 + 8 * fq;
#pragma unroll
        for (int ai = 0; ai < 2; ++ai) { u32x4 w[4][2];
#pragma unroll
            for (int m = 0; m < 4; ++m)
#pragma unroll
                for (int bj = 0; bj < 2; ++bj) w[m][bj] = *(const GAS_ u32x4*)(GB + (size_t)(row0 + ai * HALF + m * 16) * DM + col0 + bj * HALF);
#pragma unroll
            for (int m = 0; m < 4; ++m)
#pragma unroll
                for (int bj = 0; bj < 2; ++bj) { f32x4 a, b; unpack8(w[m][bj], a, b);
                    *(GAS_ u32x4*)(MIX + (size_t)(row0 + ai * HALF + m * 16) * DM + col0 + bj * HALF) = pack8(acc[ai][bj][m][0] * a, acc[ai][bj][m][1] * b); } }
    }
};

struct EpiSlab {
    static constexpr bool PERM = true, AFTER_DRAIN = false, MIDK = false;
    float* slab;
    __device__ __forceinline__ void operator()(const f32x4 (&acc)[2][2][4][2], const Unit& u, int wr, int wc, int fr, int fq) const {
        asm volatile("" : "+v"(fr), "+v"(fq));
        const int r0 = wr * 64 + fr, c0 = wc * 32 + 8 * fq;
#pragma unroll
        for (int ai = 0; ai < 2; ++ai)
#pragma unroll
            for (int m = 0; m < 4; ++m)
#pragma unroll
                for (int bj = 0; bj < 2; ++bj) { GAS_ float* p = (GAS_ float*)slab + (size_t)(r0 + ai * HALF + m * 16) * BM + c0 + bj * HALF;
                    *(GAS_ f32x4*)p = acc[ai][bj][m][0]; *(GAS_ f32x4*)(p + 4) = acc[ai][bj][m][1]; }
    }
};
struct EpiScaleBf16 {
    static constexpr bool PERM = true, AFTER_DRAIN = false, MIDK = false;
    const float* rstd; bf16_t* O; int ldc; float sc;
    __device__ __forceinline__ void operator()(const f32x4 (&acc)[2][2][4][2], const Unit& u, int wr, int wc, int fr, int fq) const {
        asm volatile("" : "+v"(fr), "+v"(fq));
        const int row0 = u.pm * BM + wr * 64 + fr, col0 = u.pn * BM + wc * 32 + 8 * fq;
#pragma unroll
        for (int ai = 0; ai < 2; ++ai)
#pragma unroll
            for (int m = 0; m < 4; ++m) { const int row = row0 + ai * HALF + m * 16; const float rs = ((const GAS_ float*)rstd)[row] * sc;
#pragma unroll
                for (int bj = 0; bj < 2; ++bj) *(GAS_ u32x4*)(O + (size_t)row * ldc + col0 + bj * HALF) = pack8(acc[ai][bj][m][0] * rs, acc[ai][bj][m][1] * rs); }
    }
};

struct EpiMemKV {
    static constexpr bool PERM = true, AFTER_DRAIN = false, MIDK = false;
    bf16_t* MKP; bf16_t* MVP; float* out;
    __device__ __forceinline__ void operator()(const f32x4 (&acc)[2][2][4][2], const Unit& u, int wr, int wc, int fr, int fq) const {
        asm volatile("" : "+v"(fr), "+v"(fq));
        const int row0 = u.pm * BM + wr * 64 + fr, col0 = (u.pn & 1) * BM + wc * 32 + 8 * fq; const bool isv = u.pn >= 2;
        bf16_t* B = isv ? MVP : MKP; float* F = out + (isv ? O_MVP : O_MKP);
#pragma unroll
        for (int ai = 0; ai < 2; ++ai)
#pragma unroll
            for (int m = 0; m < 4; ++m) { const size_t off = (size_t)(row0 + ai * HALF + m * 16) * XW + col0;
#pragma unroll
                for (int bj = 0; bj < 2; ++bj) { *(GAS_ u32x4*)(B + off + bj * HALF) = pack8(acc[ai][bj][m][0], acc[ai][bj][m][1]);
                    *(GAS_ f32x4*)(F + off + bj * HALF) = acc[ai][bj][m][0]; *(GAS_ f32x4*)(F + off + bj * HALF + 4) = acc[ai][bj][m][1]; } }
    }
};
template <class Epi, class Sched, bool ALIGN_EPI = false, bool SP2 = false>
__device__ __forceinline__ void gemm_phase(PG8_LAS unsigned char* lds, const Gemm g, const Sched& S, const Epi& E) {
    int tid_l = threadIdx.x; asm volatile("" : "+v"(tid_l));
    const int tid = tid_l, wid = __builtin_amdgcn_readfirstlane(tid >> 6), lane = tid & 63, wr = wid >> 2, wc = wid & 3, fr = lane & 15, fq = lane >> 4;
    const int K = g.ld ? g.ld : g.K  , nt = g.K / BK;
    unsigned voffA[2], voffB[2];
#pragma unroll
    for (int i = 0; i < 2; ++i) { int R, C; stage_rc(tid * 16 + i * 8192, R, C); const int Rb = Epi::PERM ? ((R & ~31) + perm32(R & 31)) : R;
        voffA[i] = (unsigned)(R * (g.ablk ? BK : K) + C) * 2u; voffB[i] = (unsigned)(Rb * K + C) * 2u; }
    const size_t kstep = (size_t)(BK * 2);
    const size_t hstep = (size_t)HALF * K * 2;
    const size_t tstep = 2 * hstep;
    const size_t kstepA = g.ablk ? (size_t)BM * BK * 2 : kstep, hstepA = g.ablk ? (size_t)HALF * BK * 2 : hstep;
    const unsigned ldsw = (unsigned)wid * 1024u;
    const int aoff = lds_byte(wr * 64 + fr, fq * 8), boff = lds_byte(wc * 32 + fr, fq * 8);
#define PG8_SA(b, h) (((b) * 2 + (h)) * HTB)
#define PG8_SB(b, h) ((4 + (b) * 2 + (h)) * HTB)
#define PG8_STAGE(bufoff, gbase, voff) do { _Pragma("unroll") for (int _i = 0; _i < 2; ++_i) \
        __builtin_amdgcn_global_load_lds((const unsigned*)((const char*)(gbase) + (voff)[_i]), (PG8_LAS unsigned*)(lds + (bufoff) + ldsw + _i * 8192), 16, 0, 0); } while (0)
#define PG8_LDA(dst, b, h) do { _Pragma("unroll") for (int m = 0; m < 4; ++m) _Pragma("unroll") for (int k = 0; k < 2; ++k) dst[m][k] = *(const PG8_LAS bf16x8*)(lds + PG8_SA(b, h) + aoff + m * 2048 + k * 1024); } while (0)
#define PG8_LDB(dst, b, h) do { _Pragma("unroll") for (int n = 0; n < 2; ++n) _Pragma("unroll") for (int k = 0; k < 2; ++k) dst[n][k] = *(const PG8_LAS bf16x8*)(lds + PG8_SB(b, h) + boff + n * 2048 + k * 1024); } while (0)
#define PG8_MMA(ai, bj, At, Bt) do { __builtin_amdgcn_s_setprio(1); _Pragma("unroll") for (int m = 0; m < 4; ++m) _Pragma("unroll") for (int n = 0; n < 2; ++n) _Pragma("unroll") for (int k = 0; k < 2; ++k) \
        acc[ai][bj][m][n] = __builtin_amdgcn_mfma_f32_16x16x32_bf16(Bt[n][k], At[m][k], acc[ai][bj][m][n], 0, 0, 0); __builtin_amdgcn_s_setprio(0); } while (0)
#define PG8_WAIT_V(n) asm volatile("s_waitcnt vmcnt(" #n ")" ::: "memory")
#define PG8_WAIT_L(n) asm volatile("s_waitcnt lgkmcnt(" #n ")" ::: "memory")
#define PG8_BAR __builtin_amdgcn_s_barrier()
#define PG8_SCHED __builtin_amdgcn_sched_barrier(0)
    Unit cur, nxt; int ui = 0;
    if (!S.next(0, cur)) return;
    f32x4 acc[2][2][4][2];
#pragma unroll
    for (int a = 0; a < 2; ++a)
#pragma unroll
        for (int b = 0; b < 2; ++b)
#pragma unroll
            for (int m = 0; m < 4; ++m)
#pragma unroll
                for (int n = 0; n < 2; ++n) acc[a][b][m][n] = (f32x4){0.f, 0.f, 0.f, 0.f};
    bf16x8 At[4][2], B0[2][2], B1[2][2];
    const char* cA = (const char*)g.A + (size_t)cur.pm * tstep; const char* cB = (const char*)g.Bt + (size_t)cur.pn * tstep;
    S.a_ready(cur);
    if constexpr (SP2) {
        PG8_STAGE(PG8_SB(0, 0), cB, voffB); PG8_STAGE(PG8_SB(0, 1), cB + hstep, voffB); PG8_STAGE(PG8_SA(0, 0), cA, voffA); PG8_STAGE(PG8_SA(0, 1), cA + hstepA, voffA);
        if (wr == 1) PG8_BAR;
        PG8_WAIT_V(2); PG8_BAR;
        PG8_STAGE(PG8_SB(1, 0), cB + kstep, voffB); PG8_STAGE(PG8_SA(1, 0), cA + kstepA, voffA); PG8_STAGE(PG8_SB(1, 1), cB + hstep + kstep, voffB);
        PG8_WAIT_V(6); PG8_BAR;
    } else {
        PG8_STAGE(PG8_SB(0, 0), cB, voffB); PG8_STAGE(PG8_SA(0, 0), cA, voffA); PG8_STAGE(PG8_SB(0, 1), cB + hstep, voffB); PG8_STAGE(PG8_SA(0, 1), cA + hstepA, voffA);
        if (wr == 1) PG8_BAR;
        PG8_WAIT_V(4); PG8_BAR;
        PG8_STAGE(PG8_SB(1, 0), cB + kstep, voffB); PG8_STAGE(PG8_SA(1, 0), cA + kstepA, voffA); PG8_STAGE(PG8_SB(1, 1), cB + hstep + kstep, voffB);
        PG8_WAIT_V(6); PG8_BAR;
    }
    for (;;) {
        const bool has_next = S.next(ui + 1, nxt);
        const char* nA = has_next ? (const char*)g.A + (size_t)nxt.pm * tstep : cA; const char* nB = has_next ? (const char*)g.Bt + (size_t)nxt.pn * tstep : cB;
        for (int t = 0; t < nt; t += 2) {
            const bool last = (t == nt - 2);
            const char* a1 = cA + (size_t)(t + 1) * kstepA;
            const char* a2 = last ? nA : cA + (size_t)(t + 2) * kstepA; const char* b2 = last ? nB : cB + (size_t)(t + 2) * kstep;
            const char* a3 = a2 + kstepA; const char* b3 = b2 + kstep;
            if (last && has_next) S.a_ready(nxt);
            if constexpr (Epi::MIDK) { if (t == nt / 2) E.midk(acc, cur, wr, wc, fr, fq); }
            if constexpr (SP2) {
            PG8_LDB(B0, 0, 0); PG8_LDB(B1, 0, 1); PG8_SCHED; PG8_LDA(At, 0, 0); PG8_STAGE(PG8_SA(1, 1), a1 + hstepA, voffA);
            PG8_WAIT_V(8); PG8_WAIT_L(0); PG8_BAR; PG8_MMA(0, 0, At, B0); PG8_MMA(0, 1, At, B1); PG8_BAR; PG8_SCHED;
            PG8_LDA(At, 0, 1); PG8_STAGE(PG8_SB(0, 0), b2, voffB); PG8_STAGE(PG8_SB(0, 1), b2 + hstep, voffB); PG8_STAGE(PG8_SA(0, 0), a2, voffA);
            PG8_WAIT_V(8); PG8_WAIT_L(0); PG8_BAR; PG8_MMA(1, 0, At, B0); PG8_MMA(1, 1, At, B1); PG8_BAR; PG8_SCHED;
            PG8_LDB(B0, 1, 0); PG8_LDB(B1, 1, 1); PG8_SCHED; PG8_LDA(At, 1, 0); PG8_STAGE(PG8_SA(0, 1), a2 + hstepA, voffA);
            PG8_WAIT_V(8); PG8_WAIT_L(0); PG8_BAR; PG8_MMA(0, 0, At, B0); PG8_MMA(0, 1, At, B1); PG8_BAR; PG8_SCHED;
            PG8_LDA(At, 1, 1); PG8_STAGE(PG8_SB(1, 0), b3, voffB); PG8_STAGE(PG8_SB(1, 1), b3 + hstep, voffB); PG8_STAGE(PG8_SA(1, 0), a3, voffA);
            PG8_WAIT_V(8); PG8_WAIT_L(0); PG8_BAR; PG8_MMA(1, 0, At, B0); PG8_MMA(1, 1, At, B1); PG8_BAR; PG8_SCHED;
            } else {
            PG8_LDB(B0, 0, 0); PG8_SCHED; PG8_LDA(At, 0, 0); PG8_STAGE(PG8_SA(1, 1), a1 + hstepA, voffA);
            PG8_WAIT_L(8); PG8_BAR; PG8_WAIT_L(0); PG8_MMA(0, 0, At, B0); PG8_BAR; PG8_SCHED;
            PG8_LDB(B1, 0, 1); PG8_STAGE(PG8_SB(0, 0), b2, voffB);
            PG8_BAR; PG8_WAIT_L(0); PG8_MMA(0, 1, At, B1); PG8_BAR;
            PG8_LDA(At, 0, 1); PG8_STAGE(PG8_SA(0, 0), a2, voffA);
            PG8_BAR; PG8_WAIT_L(0); PG8_MMA(1, 0, At, B0); PG8_BAR; PG8_SCHED;
            PG8_STAGE(PG8_SB(0, 1), b2 + hstep, voffB);
            PG8_WAIT_V(6); PG8_BAR; PG8_MMA(1, 1, At, B1); PG8_BAR;
            PG8_LDB(B0, 1, 0); PG8_SCHED; PG8_LDA(At, 1, 0); PG8_STAGE(PG8_SA(0, 1), a2 + hstepA, voffA);
            PG8_WAIT_L(8); PG8_BAR; PG8_WAIT_L(0); PG8_MMA(0, 0, At, B0); PG8_BAR; PG8_SCHED;
            PG8_LDB(B1, 1, 1); PG8_STAGE(PG8_SB(1, 0), b3, voffB);
            PG8_BAR; PG8_WAIT_L(0); PG8_MMA(0, 1, At, B1); PG8_BAR;
            PG8_LDA(At, 1, 1); PG8_STAGE(PG8_SA(1, 0), a3, voffA);
            PG8_BAR; PG8_WAIT_L(0); PG8_MMA(1, 0, At, B0); PG8_BAR; PG8_SCHED;
            PG8_STAGE(PG8_SB(1, 1), b3 + hstep, voffB);
            PG8_WAIT_V(6); PG8_BAR; PG8_MMA(1, 1, At, B1); PG8_BAR;
            }
        }
        if constexpr (ALIGN_EPI) { if (wr == 0) PG8_BAR; }
        if constexpr (!Epi::AFTER_DRAIN) { E(acc, cur, wr, wc, fr, fq); S.done(cur); }
        if (!has_next) break;
#pragma unroll
        for (int a = 0; a < 2; ++a)
#pragma unroll
            for (int b = 0; b < 2; ++b)
#pragma unroll
                for (int m = 0; m < 4; ++m)
#pragma unroll
                    for (int n = 0; n < 2; ++n) acc[a][b][m][n] = (f32x4){0.f, 0.f, 0.f, 0.f};
        cur = nxt; cA = nA; cB = nB; ++ui;
        if constexpr (ALIGN_EPI) { if (wr == 1) PG8_BAR; }
    }
    PG8_WAIT_V(0);
    if constexpr (!ALIGN_EPI) { if (wr == 0) PG8_BAR; }
    PG8_BAR;
    if constexpr (Epi::AFTER_DRAIN) { E.fused(acc, cur, wr, wc, fr, fq, lds, wid, lane); S.done(cur); }
#undef PG8_SA
#undef PG8_SB
#undef PG8_STAGE
#undef PG8_LDA
#undef PG8_LDB
#undef PG8_MMA
#undef PG8_WAIT_V
#undef PG8_WAIT_L
#undef PG8_BAR
#undef PG8_SCHED
}
}

namespace att {
typedef unsigned short bf16;
using bf16x8 = __attribute__((ext_vector_type(8))) short;
using s16x4  = __attribute__((ext_vector_type(4))) short;
using f32x16 = __attribute__((ext_vector_type(16))) float;
using u32x4  = __attribute__((ext_vector_type(4))) unsigned;
constexpr int NW = 8, QBLK = 32, KVBLK = 64, DV = 128;
constexpr float THR = 8.f;
constexpr int LDS_V = 0, LDS_K = 65536, LDS_WS = 114688, LDS_LUT = 114688 + 2048, LDS_OSTAGE = 0, LDS_ATT_BYTES = LDS_LUT + 320 * 4;
#define ATT_SBAR() __builtin_amdgcn_sched_barrier(0)
#define ATT_GCP const __attribute__((address_space(1))) char*
#define ATT_GVP const __attribute__((address_space(1))) bf16x8*
__device__ __forceinline__ int crow(int r, int hi) { return (r & 3) + 8 * (r >> 2) + 4 * hi; }
__device__ __forceinline__ unsigned cvtpk(float lo, float hi) { unsigned r; asm volatile("v_cvt_pk_bf16_f32 %0, %1, %2" : "=v"(r) : "v"(lo), "v"(hi)); return r; }
template <int DQK> __device__ __forceinline__ int kswz(int row, int colB) { return row * (DQK * 2) + (colB ^ ((row & 7) << 4)); }

__device__ __forceinline__ int v_st(int k, int c) { const int kk = (k & ~0xC) | ((k & 4) << 1) | ((k & 8) >> 1); return ((kk >> 3) * 4 + (c >> 5)) * 512 + ((kk & 7) * 32 + (c & 31)) * 2; }
__device__ __forceinline__ int v_rd_base(int lane) { return ((lane & 3) << 3) | (((lane >> 2) & 3) << 6) | (((lane >> 4) & 1) << 5) | (((lane >> 5) & 1) << 8); }
constexpr int v_rd_off(int d0, int ks, int half) { return d0 * 512 + ks * 4096 + half * 2048; }
template <int OFF> __device__ __forceinline__ s16x4 tr_read(int vb) { s16x4 r; asm volatile("ds_read_b64_tr_b16 %0, %1 offset:%2" : "=&v"(r) : "v"(vb), "i"(OFF) : "memory"); return r; }
template <int KS> __device__ __forceinline__ void pv_ks(f32x16* o, int vb, bf16x8 pa) {
  const s16x4 l0 = tr_read<v_rd_off(0, KS, 0)>(vb), h0 = tr_read<v_rd_off(0, KS, 1)>(vb), l1 = tr_read<v_rd_off(1, KS, 0)>(vb), h1 = tr_read<v_rd_off(1, KS, 1)>(vb);
  const s16x4 l2 = tr_read<v_rd_off(2, KS, 0)>(vb), h2 = tr_read<v_rd_off(2, KS, 1)>(vb), l3 = tr_read<v_rd_off(3, KS, 0)>(vb), h3 = tr_read<v_rd_off(3, KS, 1)>(vb);
  asm volatile("s_waitcnt lgkmcnt(0)" ::: "memory"); ATT_SBAR();
#define ATT_PK(L, H) (bf16x8){L[0], L[1], L[2], L[3], H[0], H[1], H[2], H[3]}
  o[0] = __builtin_amdgcn_mfma_f32_32x32x16_bf16(pa, ATT_PK(l0, h0), o[0], 0, 0, 0);
  o[1] = __builtin_amdgcn_mfma_f32_32x32x16_bf16(pa, ATT_PK(l1, h1), o[1], 0, 0, 0);
  o[2] = __builtin_amdgcn_mfma_f32_32x32x16_bf16(pa, ATT_PK(l2, h2), o[2], 0, 0, 0);
  o[3] = __builtin_amdgcn_mfma_f32_32x32x16_bf16(pa, ATT_PK(l3, h3), o[3], 0, 0, 0);
#undef ATT_PK
}
template <int KS> __device__ __forceinline__ void pv_ks_t(f32x16* o, int vb, bf16x8 pb) {
  const s16x4 l0 = tr_read<v_rd_off(0, KS, 0)>(vb), h0 = tr_read<v_rd_off(0, KS, 1)>(vb), l1 = tr_read<v_rd_off(1, KS, 0)>(vb), h1 = tr_read<v_rd_off(1, KS, 1)>(vb);
  const s16x4 l2 = tr_read<v_rd_off(2, KS, 0)>(vb), h2 = tr_read<v_rd_off(2, KS, 1)>(vb), l3 = tr_read<v_rd_off(3, KS, 0)>(vb), h3 = tr_read<v_rd_off(3, KS, 1)>(vb);
  asm volatile("s_waitcnt lgkmcnt(0)" ::: "memory"); ATT_SBAR();
#define ATT_PK(L, H) (bf16x8){L[0], L[1], L[2], L[3], H[0], H[1], H[2], H[3]}
  o[0] = __builtin_amdgcn_mfma_f32_32x32x16_bf16(ATT_PK(l0, h0), pb, o[0], 0, 0, 0);
  o[1] = __builtin_amdgcn_mfma_f32_32x32x16_bf16(ATT_PK(l1, h1), pb, o[1], 0, 0, 0);
  o[2] = __builtin_amdgcn_mfma_f32_32x32x16_bf16(ATT_PK(l2, h2), pb, o[2], 0, 0, 0);
  o[3] = __builtin_amdgcn_mfma_f32_32x32x16_bf16(ATT_PK(l3, h3), pb, o[3], 0, 0, 0);
#undef ATT_PK
}
__device__ __forceinline__ void pv_all_t(f32x16* o, int vb, bf16x8 pb0, bf16x8 pb1, bf16x8 pb2, bf16x8 pb3) {
  pv_ks_t<0>(o, vb, pb0); pv_ks_t<1>(o, vb, pb1); pv_ks_t<2>(o, vb, pb2); pv_ks_t<3>(o, vb, pb3);
}
__device__ __forceinline__ void pv_all(f32x16* o, int vb, bf16x8 pa0, bf16x8 pa1, bf16x8 pa2, bf16x8 pa3) {
  pv_ks<0>(o, vb, pa0); pv_ks<1>(o, vb, pa1); pv_ks<2>(o, vb, pa2); pv_ks<3>(o, vb, pa3);
}
template <int DQK> __device__ __forceinline__ void qkt(f32x16& p0, f32x16& p1, const char* Ks, const bf16x8* qr, int r32, int hi, const f32x16& c0) {
  p0 = c0; p1 = c0;
#pragma unroll
  for (int d0 = 0; d0 < DQK / 16; ++d0) { const int cb = (d0 * 16 + hi * 8) * 2;
    const bf16x8 b0 = *reinterpret_cast<const bf16x8*>(Ks + kswz<DQK>(r32, cb));
    const bf16x8 b1 = *reinterpret_cast<const bf16x8*>(Ks + kswz<DQK>(32 + r32, cb));
    p0 = __builtin_amdgcn_mfma_f32_32x32x16_bf16(b0, qr[d0], p0, 0, 0, 0);
    p1 = __builtin_amdgcn_mfma_f32_32x32x16_bf16(b1, qr[d0], p1, 0, 0, 0); }
}
template <bool BIAS> __device__ __forceinline__ float bias_mask(f32x16& p0, f32x16& p1, bool valid, bool far, float cfar, const float* lut, int relb, int hi) {
  if (__builtin_expect(__builtin_amdgcn_readfirstlane((int)!valid) != 0, 0)) {
#pragma unroll
    for (int r = 0; r < 16; ++r) { p0[r] = -INFINITY; p1[r] = -INFINITY; }
    asm volatile("" : "+v"(p0), "+v"(p1));
    return 0.f;
  }
  if (BIAS) {
    if (far) return cfar;
    int rb = relb + 4 * hi; asm volatile("" : "+v"(rb));
#pragma unroll
    for (int r = 0; r < 16; ++r) { const int i0 = rb + (r & 3) + 8 * (r >> 2);
      p0[r] += lut[min(max(i0, 0), 319)]; p1[r] += lut[min(max(i0 + 32, 0), 319)];
      if ((r & 3) == 3) asm volatile("" ::: "memory"); }
  }
  return 0.f;
}
__device__ __forceinline__ void partialSM(f32x16& p0, f32x16& p1, float badd, float& m_reg, float& alpha) {
  float pmax = p0[0];
#pragma unroll
  for (int r = 1; r < 16; ++r) pmax = fmaxf(pmax, p0[r]);
#pragma unroll
  for (int r = 0; r < 16; ++r) pmax = fmaxf(pmax, p1[r]);
  { auto rr = __builtin_amdgcn_permlane32_swap(__float_as_uint(pmax), __float_as_uint(pmax), false, false);
    pmax = fmaxf(__uint_as_float(rr[0]), __uint_as_float(rr[1])); }
  pmax += badd;
  float mn;
  if (__builtin_expect(__all(pmax - m_reg <= THR), 1)) { mn = m_reg; alpha = 1.f; }
  else { mn = fmaxf(m_reg, pmax); alpha = __builtin_amdgcn_exp2f(m_reg - mn); m_reg = mn; }
  const float sub = mn - badd;
  p0 = p0 - sub; p1 = p1 - sub;
#pragma unroll
  for (int r = 0; r < 16; ++r) p0[r] = __builtin_amdgcn_exp2f(p0[r]);
}
#define ATT_MX3(a, b, c) __builtin_fmaxf(__builtin_fmaxf((a), (b)), (c))
__device__ __forceinline__ float rowmax32(const f32x16& p0, const f32x16& p1) {
  float a = ATT_MX3(p0[0], p0[1], p1[0]), b = ATT_MX3(p0[2], p0[3], p1[1]); a = ATT_MX3(a, p1[2], p1[3]);
#pragma unroll
  for (int r = 4; r < 16; r += 4) { a = ATT_MX3(a, p0[r], p0[r + 1]); b = ATT_MX3(b, p0[r + 2], p0[r + 3]); a = ATT_MX3(a, p1[r], p1[r + 1]); b = ATT_MX3(b, p1[r + 2], p1[r + 3]); }
  float m = __builtin_fmaxf(a, b);
  auto rr = __builtin_amdgcn_permlane32_swap(__float_as_uint(m), __float_as_uint(m), false, false);
  return __builtin_fmaxf(__uint_as_float(rr[0]), __uint_as_float(rr[1]));
}
template <bool FIRST> __device__ __forceinline__ void partialSM_negc(f32x16& p0, f32x16& p1, float& m_reg, float& alpha) {
  const float pmax = rowmax32(p0, p1);
  alpha = 1.f;
  if (FIRST) { const float dl = pmax > -INFINITY ? pmax : 0.f; m_reg += dl; p0 = p0 - dl; p1 = p1 - dl; }
  else if (!__builtin_expect(__all(pmax <= THR), 1)) { const float dl = __builtin_fmaxf(pmax, 0.f); alpha = __builtin_amdgcn_exp2f(-dl); m_reg += dl; p0 = p0 - dl; p1 = p1 - dl; }
#pragma unroll
  for (int r = 0; r < 16; ++r) p0[r] = __builtin_amdgcn_exp2f(p0[r]);
}
__device__ __forceinline__ void finishSM(f32x16& p0, f32x16& p1, float alpha, float& l_reg, bf16x8& pa0, bf16x8& pa1, bf16x8& pa2, bf16x8& pa3) {
#pragma unroll
  for (int r = 0; r < 16; ++r) p1[r] = __builtin_amdgcn_exp2f(p1[r]);
  float ps = 0;
#pragma unroll
  for (int r = 0; r < 16; ++r) ps += p0[r];
#pragma unroll
  for (int r = 0; r < 16; ++r) ps += p1[r];
  { auto rr = __builtin_amdgcn_permlane32_swap(__float_as_uint(ps), __float_as_uint(ps), false, false);
    ps = __uint_as_float(rr[0]) + __uint_as_float(rr[1]); }
  l_reg = l_reg * alpha + ps;
#define ATT_PK4(P, BASE, OUT) do { unsigned a0 = cvtpk(P[BASE + 0], P[BASE + 1]), a1 = cvtpk(P[BASE + 2], P[BASE + 3]);   \
    unsigned b0 = cvtpk(P[BASE + 4], P[BASE + 5]), b1 = cvtpk(P[BASE + 6], P[BASE + 7]);                              \
    auto r0 = __builtin_amdgcn_permlane32_swap(a0, b0, false, false); auto r1 = __builtin_amdgcn_permlane32_swap(a1, b1, false, false); \
    u32x4 w = {r0[0], r1[0], r0[1], r1[1]}; OUT = *reinterpret_cast<bf16x8*>(&w); } while (0)
  ATT_PK4(p0, 0, pa0); ATT_PK4(p0, 8, pa1); ATT_PK4(p1, 0, pa2); ATT_PK4(p1, 8, pa3);
#undef ATT_PK4
}

__device__ __forceinline__ void glds16(const void* gsrc, unsigned lds_dst) { unsigned keep;
  asm volatile("s_mov_b32 %0, m0\n\ts_mov_b32 m0, %2\n\ts_nop 0\n\tglobal_load_lds_dwordx4 %1, off\n\ts_mov_b32 m0, %0" : "=&s"(keep) : "v"(gsrc), "s"(lds_dst) : "memory"); }
__device__ __forceinline__ void glds16s(const void* sbase, unsigned voff, unsigned lds_dst) { unsigned keep;
  asm volatile("s_mov_b32 %0, m0\n\ts_mov_b32 m0, %3\n\ts_nop 0\n\tglobal_load_lds_dwordx4 %1, %2\n\ts_mov_b32 m0, %0" : "=&s"(keep) : "v"(voff), "s"(sbase), "s"(lds_dst) : "memory"); }
struct TileArgs {
  const bf16* Qw; int ldq;
  const bf16* Kh; int ldk;
  const bf16* Vh; int ldv;
  int t0, NT, tmax;
  int wlo, whi;
  int relw;
  int abl;
};

template <int DQK, bool BIAS, int SD, bool SKIPW = false>
__device__ __forceinline__ void attn_tiles(const TileArgs& A, const float* lut, char* lds, f32x16 (&o)[4], float& l_out) {
  int tid_l = threadIdx.x; asm volatile("" : "+v"(tid_l));
  const int tid = tid_l, wid = tid >> 6, lane = tid & 63, r32 = lane & 31, hi = lane >> 5;
  char* V_lds = lds + LDS_V; char* K_lds = lds + LDS_K;
  constexpr int SHM_V = KVBLK * DV * 2, SHM_K = KVBLK * DQK * 2;
  float* ws = (float*)(lds + LDS_WS) + wid * 64; float* al_l = ws + 32;
  float m_reg = -1e30f, l_reg = 0.f; o[0] = f32x16{}; o[1] = f32x16{}; o[2] = f32x16{}; o[3] = f32x16{};
  bf16x8 qr[DQK / 16];
  { ATT_GCP Qp = (ATT_GCP)A.Qw + (unsigned)((r32 * A.ldq + hi * 8) * 2);
#pragma unroll
    for (int d0 = 0; d0 < DQK / 16; ++d0) qr[d0] = *(ATT_GVP)(Qp + d0 * 32); }
  const int vb0 = (int)(uintptr_t)V_lds + v_rd_base(lane);
  const float cfar = BIAS ? lut[0] : 0.f;
  const int ldk = A.ldk, ldv = A.ldv; const bf16* Kh = A.Kh; const bf16* Vh = A.Vh; const int t0 = A.t0, tmax = A.tmax;
  unsigned voV, voK;
  { const int sst = 2 * wid + (lane >> 5), kk = 8 * (sst >> 2) + ((lane & 31) >> 2), kq = (DQK == 64) ? kk : ((kk & ~0xC) | ((kk & 4) << 1) | ((kk & 8) >> 1));
    voV = (unsigned)(kq * ldv + 32 * (sst & 3) + 8 * (lane & 3)) * 2u; }
  if (DQK == 64) { const int row = 8 * wid + (lane >> 3), ch = (lane & 7) ^ (row & 7); voK = (unsigned)(row * ldk + 8 * ch) * 2u; }
  else { const int row = 4 * wid + (lane >> 4), ch = (lane & 15) ^ (row & 7); voK = (unsigned)(row * ldk + 8 * ch) * 2u; }
  const unsigned ldsV = (unsigned)(uintptr_t)V_lds + (unsigned)wid * 1024u, ldsK = (unsigned)(uintptr_t)K_lds + (unsigned)wid * 1024u;
  constexpr int NDMA = (DQK == 64) ? 3 : 4;
#define ATT_DMA(j) do { const int tl_ = min(t0 + (j), tmax); const char* vt_ = (const char*)Vh + (size_t)tl_ * (KVBLK * 2) * ldv; const char* kt_ = (const char*)Kh + (size_t)tl_ * (KVBLK * 2) * ldk;   \
    const unsigned dv_ = (unsigned)__builtin_amdgcn_readfirstlane(ldsV + (unsigned)(((j) & 3) * SHM_V)), dk_ = (unsigned)__builtin_amdgcn_readfirstlane(ldsK + (unsigned)(((j) % 3) * SHM_K));   \
    if (DQK == 64) { glds16s(vt_, voV, dv_); glds16s(vt_ + (size_t)64 * ldv, voV, dv_ + 8192u); glds16s(kt_, voK, dk_); }       \
    else { glds16(vt_ + voV, dv_); glds16(vt_ + (size_t)64 * ldv + voV, dv_ + 8192u); glds16(kt_ + voK, dk_); glds16(kt_ + (size_t)64 * ldk + voK, dk_ + 8192u); } } while (0)
#define ATT_WAITBAR(j) do { if ((j) + 2 < NT) { if (DQK == 64) asm volatile("s_waitcnt vmcnt(3) lgkmcnt(0)\n\ts_barrier" ::: "memory"); else asm volatile("s_waitcnt vmcnt(4) lgkmcnt(0)\n\ts_barrier" ::: "memory"); }   \
    else asm volatile("s_waitcnt vmcnt(0) lgkmcnt(0)\n\ts_barrier" ::: "memory"); } while (0)
#define ATT_RESC(a) do { if (__any((a) != 1.f)) { if (hi == 0) al_l[r32] = (a); asm volatile("s_waitcnt lgkmcnt(0)" ::: "memory"); \
    _Pragma("unroll") for (int d = 0; d < 4; ++d) _Pragma("unroll") for (int r = 0; r < 16; ++r) o[d][r] *= al_l[crow(r, hi)]; } } while (0)
#define ATT_BM(P0, P1, j, BADD) do { const int t_ = t0 + (j); const bool valid_ = (t_ >= A.wlo) && (t_ <= A.whi); const int rk_ = A.relw + t_ * KVBLK;   \
    BADD = bias_mask<BIAS>(P0, P1, valid_, (rk_ + 63 <= -128), NEGC ? 0.f : cfar, lut, rk_ - r32 + 256, hi); } while (0)
#define ATT_PRE(j) do { if constexpr (NEGC) { const int rk_ = A.relw + (t0 + (j)) * KVBLK; const float cf_ = ((BIAS && (rk_ + 63 <= -128)) ? cfar : 0.f) - m_reg;   \
    if (__any(cf_ != ccur)) { ccur = cf_; _Pragma("unroll") for (int r = 0; r < 16; ++r) negc[r] = cf_; asm volatile("" : "+v"(negc)); } } } while (0)
#define ATT_PSM(P0, P1, AL) do { if constexpr (NEGC) partialSM_negc<false>(P0, P1, m_reg, AL); else partialSM(P0, P1, badd, m_reg, AL); } while (0)
#define ATT_VALID(j) ((!SKIPW || act) && (__builtin_amdgcn_readfirstlane((int)(((t0 + (j)) >= A.wlo) && ((t0 + (j)) <= A.whi))) != 0))
#define ATT_STEP(PC0, PC1, ALC, PP0, PP1, ALP, j) do {                                                                \
    if ((j) + 2 < NT && !(abl & 1)) ATT_DMA((j) + 2);                                                                 \
    const bool cv_ = ATT_VALID(j), pv_ = ATT_VALID((j) - 1);                                                          \
    if (cv_) { ATT_PRE(j); ATT_SBAR(); qkt<DQK>(PC0, PC1, K_lds + ((j) % 3) * SHM_K, qr, r32, hi, negc); }            \
    if (pv_) { finishSM(PP0, PP1, ALP, l_reg, pa0, pa1, pa2, pa3); ATT_SBAR(); pv_all(o, vb0 + (((j) + 3) & 3) * SHM_V, pa0, pa1, pa2, pa3); }   \
    if (cv_) { ATT_BM(PC0, PC1, j, badd); ATT_PSM(PC0, PC1, ALC); ATT_RESC(ALC); }                                    \
    ATT_WAITBAR(j); } while (0)
#define ATT_PIN(x) asm volatile("" : "+v"(x))
#define ATT_KLD(D0, B0, B1) do { const int cb_ = ((D0) * 16 + hi * 8) * 2; B0 = *reinterpret_cast<const bf16x8*>(kb_ + kswz<64>(r32, cb_)); B1 = *reinterpret_cast<const bf16x8*>(kb_ + kswz<64>(32 + r32, cb_)); } while (0)
#define ATT_PKT(P, BASE, OUT) do { u32x4 w_ = {cvtpk(P[BASE + 0], P[BASE + 1]), cvtpk(P[BASE + 2], P[BASE + 3]), cvtpk(P[BASE + 4], P[BASE + 5]), cvtpk(P[BASE + 6], P[BASE + 7])}; OUT = *reinterpret_cast<bf16x8*>(&w_); } while (0)
#define ATT_G1(D0, PC0, PC1, PP, PB, PAK, CB0, CB1, NB0, NB1) do { if ((D0) < 3) ATT_KLD((D0) + 1, NB0, NB1);          \
    PC0 = __builtin_amdgcn_mfma_f32_32x32x16_bf16(CB0, qr[D0], (D0) == 0 ? negc : PC0, 0, 0, 0);                         \
    sacc_ += PP[PB + 0]; sacc_ += PP[PB + 1]; sacc_ += PP[PB + 2]; sacc_ += PP[PB + 3]; ATT_PIN(sacc_);                 \
    const unsigned a0_ = cvtpk(PP[PB + 0], PP[PB + 1]), a1_ = cvtpk(PP[PB + 2], PP[PB + 3]); ATT_SBAR();                \
    PC1 = __builtin_amdgcn_mfma_f32_32x32x16_bf16(CB1, qr[D0], (D0) == 0 ? negc : PC1, 0, 0, 0);                         \
    sacc_ += PP[PB + 4]; sacc_ += PP[PB + 5]; sacc_ += PP[PB + 6]; sacc_ += PP[PB + 7]; ATT_PIN(sacc_);                 \
    const unsigned b0c_ = cvtpk(PP[PB + 4], PP[PB + 5]), b1c_ = cvtpk(PP[PB + 6], PP[PB + 7]);                          \
    u32x4 w_ = {a0_, a1_, b0c_, b1c_}; PAK = *reinterpret_cast<bf16x8*>(&w_); ATT_SBAR(); } while (0)
#define ATT_TRIG(PP0, PP1, PC0, PC1, HAVE_CUR) do { if (!__builtin_expect(__all(sacc_ <= 16384.f), 1)) {                                        \
      float full_; { auto rr_ = __builtin_amdgcn_permlane32_swap(__float_as_uint(sacc_), __float_as_uint(sacc_), false, false); full_ = __uint_as_float(rr_[0]) + __uint_as_float(rr_[1]); }   \
      const bool big_ = full_ > 16384.f;                                      \
      const float al_ = big_ ? __builtin_amdgcn_rcpf(full_) : 1.f, dl_ = big_ ? __builtin_amdgcn_logf(full_) : 0.f;                            \
      PP0 = PP0 * al_; PP1 = PP1 * al_; sacc_ *= al_; l_reg *= al_; m_reg += dl_;                                                              \
      _Pragma("unroll") for (int d_ = 0; d_ < 4; ++d_) o[d_] = o[d_] * al_;                                                                     \
      if (HAVE_CUR) { PC0 = PC0 - dl_; PC1 = PC1 - dl_; }                                                                                      \
      ATT_PKT(PP0, 0, pa0); ATT_PKT(PP0, 8, pa1); ATT_PKT(PP1, 0, pa2); ATT_PKT(PP1, 8, pa3); } } while (0)
#define ATT_B1(PC0, PC1, PP0, PP1, j) do { const char* kb_ = K_lds + ((j) % 3) * SHM_K; float sacc_ = 0.f; bf16x8 ke0_, ke1_, ko0_, ko1_;   \
    ATT_KLD(0, ke0_, ke1_); ATT_SBAR();                                                                                 \
    ATT_G1(0, PC0, PC1, PP0, 0, pa0, ke0_, ke1_, ko0_, ko1_); ATT_G1(1, PC0, PC1, PP0, 8, pa1, ko0_, ko1_, ke0_, ke1_); \
    ATT_G1(2, PC0, PC1, PP1, 0, pa2, ke0_, ke1_, ko0_, ko1_); ATT_G1(3, PC0, PC1, PP1, 8, pa3, ko0_, ko1_, ke0_, ke1_); \
    ATT_TRIG(PP0, PP1, PC0, PC1, true); l_reg += sacc_; } while (0)
#define ATT_PKV(L, H) (bf16x8){L[0], L[1], L[2], L[3], H[0], H[1], H[2], H[3]}
#define ATT_EX2(X, B) do { X[B] = __builtin_amdgcn_exp2f(X[B]); X[(B) + 1] = __builtin_amdgcn_exp2f(X[(B) + 1]); ATT_PIN(X); ATT_SBAR(); } while (0)
#define ATT_VRD(KS, S) do { S##l0 = tr_read<v_rd_off(0, KS, 0)>(vb_); S##h0 = tr_read<v_rd_off(0, KS, 1)>(vb_); S##l1 = tr_read<v_rd_off(1, KS, 0)>(vb_); S##h1 = tr_read<v_rd_off(1, KS, 1)>(vb_);   \
    S##l2 = tr_read<v_rd_off(2, KS, 0)>(vb_); S##h2 = tr_read<v_rd_off(2, KS, 1)>(vb_); S##l3 = tr_read<v_rd_off(3, KS, 0)>(vb_); S##h3 = tr_read<v_rd_off(3, KS, 1)>(vb_); } while (0)
#define ATT_VMF(S, PAK, X, XB) do {                                                                                     \
    o[0] = __builtin_amdgcn_mfma_f32_32x32x16_bf16(ATT_PKV(S##l0, S##h0), PAK, o[0], 0, 0, 0); ATT_EX2(X, XB);          \
    o[1] = __builtin_amdgcn_mfma_f32_32x32x16_bf16(ATT_PKV(S##l1, S##h1), PAK, o[1], 0, 0, 0); ATT_EX2(X, (XB) + 2);    \
    o[2] = __builtin_amdgcn_mfma_f32_32x32x16_bf16(ATT_PKV(S##l2, S##h2), PAK, o[2], 0, 0, 0); ATT_EX2(X, (XB) + 4);    \
    o[3] = __builtin_amdgcn_mfma_f32_32x32x16_bf16(ATT_PKV(S##l3, S##h3), PAK, o[3], 0, 0, 0); ATT_EX2(X, (XB) + 6); } while (0)
#define ATT_LW8() do { asm volatile("s_waitcnt lgkmcnt(8)" ::: "memory"); ATT_SBAR(); } while (0)
#define ATT_LW0() do { asm volatile("s_waitcnt lgkmcnt(0)" ::: "memory"); ATT_SBAR(); } while (0)
#define ATT_B2(PC0, PC1, j) do { const int vb_ = vb0 + (((j) + 3) & 3) * SHM_V;                                         \
    s16x4 fa_l0, fa_h0, fa_l1, fa_h1, fa_l2, fa_h2, fa_l3, fa_h3, fb_l0, fb_h0, fb_l1, fb_h1, fb_l2, fb_h2, fb_l3, fb_h3;   \
    ATT_VRD(0, fa_); ATT_VRD(1, fb_); ATT_LW8(); ATT_VMF(fa_, pa0, PC0, 0);                                             \
    ATT_VRD(2, fa_); ATT_LW8(); ATT_VMF(fb_, pa1, PC0, 8);                                                              \
    ATT_VRD(3, fb_); ATT_LW8(); ATT_VMF(fa_, pa2, PC1, 0);                                                              \
    ATT_LW0(); ATT_VMF(fb_, pa3, PC1, 8); } while (0)
#define ATT_ISTEP(PC0, PC1, PP0, PP1, j) do {                                                                           \
    if ((j) + 2 < NT) ATT_DMA((j) + 2);                                                                                 \
    if (!SKIPW || act) {                                                                                                \
      ATT_PRE(j); ATT_SBAR(); ATT_B1(PC0, PC1, PP0, PP1, j);                                                            \
      ATT_BM(PC0, PC1, j, badd); ATT_SBAR();                                                                            \
      ATT_B2(PC0, PC1, j); }                                                                                            \
    ATT_WAITBAR(j); } while (0)
  f32x16 pA0 = f32x16{}, pA1 = f32x16{}, pB0 = f32x16{}, pB1 = f32x16{}; float alA = 1.f, alB = 1.f; bf16x8 pa0 = bf16x8{}, pa1 = bf16x8{}, pa2 = bf16x8{}, pa3 = bf16x8{}; const int NT = A.NT; const int abl = A.abl;
  const bool act = !SKIPW || (__builtin_amdgcn_readfirstlane(wid) < 2);
  float badd; constexpr bool NEGC = (DQK == 64);
  asm volatile("s_waitcnt lgkmcnt(0)\n\ts_barrier" ::: "memory");
  ATT_DMA(0); ATT_DMA(1);
  if (wid >= 4) __builtin_amdgcn_s_setprio(1);
  f32x16 negc = f32x16{}; float ccur = 0.f;
  if constexpr (NEGC) { m_reg = 0.f; float z_ = 0.f; asm volatile("" : "+v"(z_));
#pragma unroll
    for (int r = 0; r < 16; ++r) negc[r] = z_;
    asm volatile("" : "+v"(negc)); }
  asm volatile("s_waitcnt vmcnt(0)\n\ts_barrier" ::: "memory");
  if (2 < NT) ATT_DMA(2);
  if (!SKIPW || act) { ATT_PRE(0); qkt<DQK>(pA0, pA1, K_lds, qr, r32, hi, negc); ATT_BM(pA0, pA1, 0, badd); }
  if constexpr (NEGC) {
    if (!SKIPW || act) {
      partialSM_negc<true>(pA0, pA1, m_reg, alA);
#pragma unroll
      for (int r = 0; r < 16; ++r) pA1[r] = __builtin_amdgcn_exp2f(pA1[r]);
    }
    ATT_WAITBAR(0);
    for (int j = 1; j + 1 < NT; j += 2) {
      ATT_ISTEP(pB0, pB1, pA0, pA1, j);
      ATT_ISTEP(pA0, pA1, pB0, pB1, j + 1);
    }
    ATT_ISTEP(pB0, pB1, pA0, pA1, NT - 1);
    if (!SKIPW || act) { float sacc_ = 0.f;
#pragma unroll
      for (int r = 0; r < 16; ++r) sacc_ += pB0[r];
#pragma unroll
      for (int r = 0; r < 16; ++r) sacc_ += pB1[r];
      ATT_PKT(pB0, 0, pa0); ATT_PKT(pB0, 8, pa1); ATT_PKT(pB1, 0, pa2); ATT_PKT(pB1, 8, pa3);
      ATT_TRIG(pB0, pB1, pA0, pA1, false); l_reg += sacc_;
    }
    ATT_SBAR();
    if (!SKIPW || act) pv_all_t(o, vb0 + ((NT - 1) & 3) * SHM_V, pa0, pa1, pa2, pa3);
  } else {
    if (ATT_VALID(0)) partialSM(pA0, pA1, badd, m_reg, alA);
    ATT_WAITBAR(0);
    for (int j = 1; j + 1 < NT; j += 2) {
      ATT_STEP(pB0, pB1, alB, pA0, pA1, alA, j);
      ATT_STEP(pA0, pA1, alA, pB0, pB1, alB, j + 1);
    }
    ATT_STEP(pB0, pB1, alB, pA0, pA1, alA, NT - 1);
    if (ATT_VALID(NT - 1)) { finishSM(pB0, pB1, alB, l_reg, pa0, pa1, pa2, pa3); ATT_SBAR();
      pv_all(o, vb0 + ((NT - 1) & 3) * SHM_V, pa0, pa1, pa2, pa3); }
  }
  __builtin_amdgcn_s_setprio(0);
  l_out = l_reg;
#undef ATT_DMA
#undef ATT_WAITBAR
#undef ATT_RESC
#undef ATT_BM
#undef ATT_STEP
#undef ATT_VALID
#undef ATT_PIN
#undef ATT_KLD
#undef ATT_G1
#undef ATT_B1
#undef ATT_PKV
#undef ATT_EX2
#undef ATT_VRD
#undef ATT_VMF
#undef ATT_LW8
#undef ATT_LW0
#undef ATT_B2
#undef ATT_PKT
#undef ATT_TRIG
#undef ATT_ISTEP
#undef ATT_PRE
#undef ATT_PSM
}
__device__ __forceinline__ void attn_normalize_t(f32x16 (&o)[4], float l_part) {
  auto rr = __builtin_amdgcn_permlane32_swap(__float_as_uint(l_part), __float_as_uint(l_part), false, false);
  const float rl = __builtin_amdgcn_rcpf(__uint_as_float(rr[0]) + __uint_as_float(rr[1]));
#pragma unroll
  for (int d = 0; d < 4; ++d) o[d] = o[d] * rl;
}
__device__ __forceinline__ void attn_normalize(f32x16 (&o)[4], float l_reg, char* lds) {
  int tid_l = threadIdx.x; asm volatile("" : "+v"(tid_l));
  const int tid = tid_l, wid = tid >> 6, lane = tid & 63, r32 = lane & 31, hi = lane >> 5;
  float* li_l = (float*)(lds + LDS_WS) + wid * 64;
  if (hi == 0) li_l[r32] = l_reg; asm volatile("s_waitcnt lgkmcnt(0)" ::: "memory");
#pragma unroll
  for (int r = 0; r < 16; ++r) { const float rl = __builtin_amdgcn_rcpf(li_l[crow(r, hi)]);
#pragma unroll
    for (int d = 0; d < 4; ++d) o[d][r] *= rl; }
  asm volatile("s_waitcnt lgkmcnt(0)" ::: "memory");
}
#undef ATT_SBAR
#undef ATT_GCP
#undef ATT_GVP
}
#define GAS __attribute__((address_space(1)))
#define LAS __attribute__((address_space(3)))
typedef unsigned short bf16;
typedef unsigned v4u __attribute__((ext_vector_type(4)));
typedef float f32x4 __attribute__((ext_vector_type(4)));
typedef short bf16x8 __attribute__((ext_vector_type(8)));
typedef GAS unsigned gu32;
typedef GAS unsigned long long gu64;
#define RLX_AGENT __ATOMIC_RELAXED, __HIP_MEMORY_SCOPE_AGENT
#define LDS_WAIT() asm volatile("s_waitcnt lgkmcnt(0)" ::: "memory")
#define VM_WAIT() asm volatile("s_waitcnt vmcnt(0)" ::: "memory")
__device__ __forceinline__ unsigned long long rt() { return __builtin_amdgcn_s_memrealtime(); }
__device__ __forceinline__ unsigned f2bf(float f) { unsigned u = __builtin_bit_cast(unsigned, f); return (u + 0x7fffu + ((u >> 16) & 1u)) >> 16; }
__device__ __forceinline__ unsigned pk2(float lo, float hi) { return f2bf(lo) | (f2bf(hi) << 16); }

#define XB_TMO      128
#define XB_XCNT(j)  (256  + 64 * (j))
#define XB_XSUB(j)  (1280 + 64 * (j))
#define XB_XGEN(j)  (2304 + 64 * (j))
#define XB_TOP      3328
#define XB_TOPGEN   3392
#define XCD_BAR_WORDS 3456
#define XB_SPIN_CAP (1u << 18)

__device__ __forceinline__ unsigned xb_ld(unsigned* p)              { return __hip_atomic_load(p, __ATOMIC_RELAXED, __HIP_MEMORY_SCOPE_AGENT); }
__device__ __forceinline__ unsigned xb_add(unsigned* p, unsigned v) { return __hip_atomic_fetch_add(p, v, __ATOMIC_RELAXED, __HIP_MEMORY_SCOPE_AGENT); }
__device__ __forceinline__ unsigned xb_xcc_id() { return (unsigned)__builtin_amdgcn_s_getreg((3 << 11) | 20) & 0xFu; }
#define XB_SPIN(cond, bar) do { unsigned _sp = 0; while (cond) { __builtin_amdgcn_s_sleep(1); \
    if ((++_sp & 255u) == 0u) { if (xb_ld(&(bar)[XB_TMO])) break; if (_sp > XB_SPIN_CAP) { atomicAdd(&(bar)[XB_TMO], 1u); break; } } } } while (0)

struct XcdBarrier {
    unsigned* bar; unsigned x;
    volatile LAS unsigned* st;
};

__device__ __forceinline__ XcdBarrier xcd_barrier_post(unsigned* bar, volatile LAS unsigned* st) {
    XcdBarrier b; b.bar = bar; b.x = xb_xcc_id(); b.st = st;
    if (threadIdx.x == 0) (void)xb_add(&bar[XB_XCNT(b.x)], 1u);
    return b;
}
__device__ __forceinline__ void xcd_barrier_complete(unsigned* bar, unsigned x, unsigned& nloc, unsigned& nx) {
    const unsigned G = gridDim.x * gridDim.y * gridDim.z;
    unsigned sum, cnt, mine, sp = 0u;
    for (;;) {
        sum = 0u; cnt = 0u; mine = 0u;
#pragma unroll
        for (unsigned j = 0; j < 16; ++j) { const unsigned c = xb_ld(&bar[XB_XCNT(j)]); sum += c; cnt += (c > 0u) ? 1u : 0u; mine = (j == x) ? c : mine; }
        if (sum == G) break;
        __builtin_amdgcn_s_sleep(1);
        if ((++sp & 255u) == 0u) { if (xb_ld(&bar[XB_TMO])) break; if (sp > XB_SPIN_CAP) { atomicAdd(&bar[XB_TMO], 1u); break; } }
    }
    nloc = mine > 0u ? mine : 1u; nx = cnt > 0u ? cnt : 1u;
}

__device__ __forceinline__ void xcd_barrier(const XcdBarrier& b) {
    asm volatile("s_waitcnt vmcnt(0)" ::: "memory");
    __syncthreads();
    if (threadIdx.x == 0) {
        unsigned* bar = b.bar;
        __builtin_amdgcn_s_waitcnt(0);
        unsigned nloc = b.st[0], nx = b.st[1];
        if (nloc == 0u) { xcd_barrier_complete(bar, b.x, nloc, nx); b.st[0] = nloc; b.st[1] = nx; }
        const unsigned old = xb_add(&bar[XB_XSUB(b.x)], 1u);
        const unsigned gen = old / nloc;
        if (old + 1u == (gen + 1u) * nloc) {
            __builtin_amdgcn_fence(__ATOMIC_RELEASE, "agent");
            asm volatile("s_waitcnt vmcnt(0)" ::: "memory");
            const unsigned og = xb_add(&bar[XB_TOP], 1u);
            const unsigned tg = og / nx;
            if (og + 1u == (tg + 1u) * nx) xb_add(&bar[XB_TOPGEN], 1u);
            else XB_SPIN(xb_ld(&bar[XB_TOPGEN]) == tg, bar);
            __builtin_amdgcn_fence(__ATOMIC_ACQUIRE, "agent");
            xb_add(&bar[XB_XGEN(b.x)], 1u);
            asm volatile("s_waitcnt vmcnt(0)" ::: "memory");
        } else {
            XB_SPIN(xb_ld(&bar[XB_XGEN(b.x)]) == gen, bar);
            __builtin_amdgcn_fence(__ATOMIC_ACQUIRE, "agent");
            asm volatile("s_waitcnt vmcnt(0)" ::: "memory");
        }
    }
    __syncthreads();
}
struct Args { const float* in[33]; float* out; unsigned char* ws; int ph_lo, ph_hi, li, pad; };
constexpr int N_PHASES = 17;
#ifndef MK_N_LAUNCHES
#define MK_N_LAUNCHES 1
#endif
constexpr int N_LAUNCHES = MK_N_LAUNCHES;

enum InIdx { I_XP = 0, I_XS, I_CDAK, I_CDAV, I_CCBK, I_CCBV, I_CMK, I_CMV, I_MEMP, I_T5, I_G1, I_W1G, I_W1U, I_W1D, I_GMIX, I_WIN, I_BGATE, I_LAMBDA, I_DAG, I_CBREL,
             I_WBRDA, I_WBRCB, I_WOUT, I_GCROSS, I_GMEM, I_WMKV, I_WCQ, I_WCO, I_G2, I_W2G, I_W2U, I_W2D, I_GFINAL };

__device__ __forceinline__ float wave_sum(float v) {
#pragma unroll
    for (int o = 1; o < 64; o <<= 1) v += __shfl_xor(v, o);
    return v;
}
__device__ __forceinline__ void tr_item(const float* W, int ldw, int N, bf16* WT, int pitch, int koff, int il, int half, LAS float* scr, int item, int lane) {
    const int nblk = N / 32, kb = item / nblk, nb = item % nblk, k0 = 64 * kb, n0 = 32 * nb;
#pragma unroll 8
    for (int i = 0; i < 32; ++i) { const int kk = 2 * i + (lane >> 5); scr[kk * 33 + (lane & 31)] = W[(size_t)(k0 + kk) * ldw + n0 + (lane & 31)]; }
    LDS_WAIT(); asm volatile("" ::: "memory");
    const int c = lane & 7;
#pragma unroll
    for (int j = 0; j < 4; ++j) { const int n = (lane >> 3) + 8 * j; const LAS float* s = scr + (8 * c) * 33 + n;
        v4u o; o.x = pk2(s[0 * 33], s[1 * 33]); o.y = pk2(s[2 * 33], s[3 * 33]); o.z = pk2(s[4 * 33], s[5 * 33]); o.w = pk2(s[6 * 33], s[7 * 33]);
        const int nn = n0 + n, drow = il ? ((nn >> 7) * 256 + half * 128 + (nn & 127)) : nn;
        *(GAS v4u*)(WT + (size_t)drow * pitch + koff + k0 + 8 * c) = o; }
    LDS_WAIT(); asm volatile("" ::: "memory");
}
__device__ __forceinline__ void rms_row_to_bf16(const float* xrow, const float* g, bf16* orow, int lane) {
    const GAS f32x4* xr = (const GAS f32x4*)xrow + lane; const GAS f32x4* gr = (const GAS f32x4*)g + lane;
    f32x4 v[8]; float s = 0.f;
#pragma unroll
    for (int j = 0; j < 8; ++j) { v[j] = xr[64 * j]; s += (v[j].x * v[j].x + v[j].y * v[j].y) + (v[j].z * v[j].z + v[j].w * v[j].w); }
    const float rs = 1.f / sqrtf(wave_sum(s) * (1.f / DM) + EPS);
    GAS unsigned long long* o8 = (GAS unsigned long long*)orow + lane;
#pragma unroll
    for (int j = 0; j < 8; ++j) { const f32x4 gg = gr[64 * j];
        o8[64 * j] = (unsigned long long)pk2(v[j].x * rs * gg.x, v[j].y * rs * gg.y) | ((unsigned long long)pk2(v[j].z * rs * gg.z, v[j].w * rs * gg.w) << 32); }
}
__device__ __forceinline__ void cvt_row1024(const float* src, bf16* dst, float* fcopy, int lane) {
    const GAS f32x4* s = (const GAS f32x4*)src + lane; GAS unsigned long long* d = (GAS unsigned long long*)dst + lane;
#pragma unroll
    for (int j = 0; j < 4; ++j) { const f32x4 v = s[64 * j]; d[64 * j] = (unsigned long long)pk2(v.x, v.y) | ((unsigned long long)pk2(v.z, v.w) << 32);
        if (fcopy) ((GAS f32x4*)fcopy)[lane + 64 * j] = v; }
}
__device__ __forceinline__ int t5_bucket(int rel) {
    const int base = rel > 0 ? 16 : 0, n = rel < 0 ? -rel : rel;
    if (n < 8) return base + n;
    const float nf = (float)n;
    int large = 8 + (int)(logf(nf / 8.f) / 2.772588722239781f * 8.f);
    large = large < 15 ? large : 15;
    return base + large;
}

struct Frame {
    LAS unsigned char* lds; volatile LAS unsigned* MISC; gu32* ctl;
    int tid, lane, wave, vcu, G;
};

constexpr int I_FFN = 32 * 176, I_FFD = 88 * 64, I_QKV = 32 * 192, I_G = 32 * 64, I_BR = 16 * 64, I_O = 32 * 64, I_MKV = 32 * 32, I_CQ = 32 * 16, I_CO = 8 * 64;
constexpr int N_EARLY = 2 * I_FFN + I_MKV, N_W1D = N_EARLY + I_FFD, N_W2 = N_W1D + 2 * I_FFN + I_FFD, NITEMS = 6 * I_FFN + I_QKV + 2 * I_G + 2 * I_BR + I_O + I_MKV + I_CQ + I_CO;
static_assert(I_FFN == I_FFD, "items");
__device__ __forceinline__ void tr_items(const Args& a, LAS float* scr, int first, int last, int gw, int NGW, int lane) {
    unsigned char* ws = a.ws;
    for (int it = first + gw; it < last; it += NGW) {
        int r = it;
        if (r < I_FFN) { tr_item(a.in[I_W1G], FF, FF, (bf16*)(ws + WS_W1GU), DM, 0, 1, 0, scr, r, lane); continue; } r -= I_FFN;
        if (r < I_FFN) { tr_item(a.in[I_W1U], FF, FF, (bf16*)(ws + WS_W1GU), DM, 0, 1, 1, scr, r, lane); continue; } r -= I_FFN;
        if (r < I_MKV) { tr_item(a.in[I_WMKV], 1024, 1024, (bf16*)(ws + WS_WMKV), DM, 0, 0, 0, scr, r, lane); continue; } r -= I_MKV;
        if (r < I_FFD) { tr_item(a.in[I_W1D], DM, DM, (bf16*)(ws + WS_W1D), FF, 0, 0, 0, scr, r, lane); continue; } r -= I_FFD;
        if (r < I_FFN) { tr_item(a.in[I_W2G], FF, FF, (bf16*)(ws + WS_W2GU), DM, 0, 1, 0, scr, r, lane); continue; } r -= I_FFN;
        if (r < I_FFN) { tr_item(a.in[I_W2U], FF, FF, (bf16*)(ws + WS_W2GU), DM, 0, 1, 1, scr, r, lane); continue; } r -= I_FFN;
        if (r < I_FFD) { tr_item(a.in[I_W2D], DM, DM, (bf16*)(ws + WS_W2D), FF, 0, 0, 0, scr, r, lane); continue; } r -= I_FFD;
        if (r < I_QKV) { tr_item(a.in[I_WIN], 10240, 6144, (bf16*)(ws + WS_WQKV), DM, 0, 0, 0, scr, r, lane); continue; } r -= I_QKV;
        if (r < I_G) { tr_item(a.in[I_WIN] + 6144, 10240, 2048, (bf16*)(ws + WS_WG), DM, 0, 1, 0, scr, r, lane); continue; } r -= I_G;
        if (r < I_G) { tr_item(a.in[I_WIN] + 8192, 10240, 2048, (bf16*)(ws + WS_WG), DM, 0, 1, 1, scr, r, lane); continue; } r -= I_G;
        if (r < I_BR) { tr_item(a.in[I_WBRDA], DM, DM, (bf16*)(ws + WS_WBR), DM, 0, 0, 0, scr, r, lane); continue; } r -= I_BR;
        if (r < I_BR) { tr_item(a.in[I_WBRCB], DM, DM, (bf16*)(ws + WS_WBR), DM, 1024, 0, 0, scr, r, lane); continue; } r -= I_BR;
        if (r < I_O) { tr_item(a.in[I_WOUT], DM, DM, (bf16*)(ws + WS_WO), DM, 0, 0, 0, scr, r, lane); continue; } r -= I_O;
        if (r < I_CQ) { tr_item(a.in[I_WCQ], XW, XW, (bf16*)(ws + WS_WCQ), DM, 0, 0, 0, scr, r, lane); continue; } r -= I_CQ;
        tr_item(a.in[I_WCO], DM, DM, (bf16*)(ws + WS_WCO), XW, 0, 0, 0, scr, r, lane);
    }
}
__device__ __forceinline__ void cache_rows(const Args& a, int gw, int NGW, int lane) {
    unsigned char* ws = a.ws;
    constexpr int R_DA = DB * PAST, R_CB = DB * CBR, R_MEM = DB * NMEM * XW / 1024;
    for (int r0 = gw; r0 < 2 * R_DA + 2 * R_CB + 2 * R_MEM; r0 += NGW) {
        int r = r0;
        if (r < 2 * R_DA) { const int v = r >= R_DA; r -= v * R_DA; const int b = r >> 10, t = r & 1023;
            cvt_row1024(a.in[v ? I_CDAV : I_CDAK] + (size_t)r * 1024, (bf16*)(ws + (v ? WS_VDAS : WS_KDAS)) + (size_t)(b * KDAS_ROWS + t) * 1024, nullptr, lane); continue; }
        r -= 2 * R_DA;
        if (r < 2 * R_CB) { const int v = r >= R_CB; r -= v * R_CB; const int b = r >> 9, t = r & 511;
            float* fc = t >= DT ? a.out + (v ? O_CBVS : O_CBKS) + (size_t)(b * CBR + t - DT) * 1024 : nullptr;
            cvt_row1024(a.in[v ? I_CCBV : I_CCBK] + (size_t)r * 1024, (bf16*)(ws + (v ? WS_VCBS : WS_KCBS)) + (size_t)(b * KCBS_ROWS + t) * 1024, fc, lane); continue; }
        r -= 2 * R_CB;
        { const int v = r >= R_MEM; r -= v * R_MEM;
          cvt_row1024(a.in[v ? I_CMV : I_CMK] + (size_t)r * 1024, (bf16*)(ws + (v ? WS_MVS : WS_MKS)) + (size_t)r * 1024, nullptr, lane); }
    }
}
#ifndef DIFF_XCD32
#define DIFF_XCD32 0
#endif
#ifndef WGM_QKV
#define WGM_QKV 4
#endif
#ifndef WGM_GU
#define WGM_GU 4
#endif
#ifndef A_BLOCKED
#define A_BLOCKED 0
#endif
#ifndef PANEL_REV
#define PANEL_REV 0
#endif
#ifndef DEFER_CVT
#define DEFER_CVT 1
#endif
__device__ __forceinline__ void p0_prologue(Frame& F, const Args& a) {
    LAS float* scr = (LAS float*)(F.lds + RING_OFF + F.wave * 16384);
    const int gw = F.vcu * NWAVES + F.wave, NGW = F.G * NWAVES;
    unsigned char* ws = a.ws;
    tr_items(a, scr, 0, DEFER_CVT ? N_EARLY : NITEMS, gw, NGW, F.lane);
    for (int m = gw; m < MTOT + NBP * NMEM; m += NGW) {
        if (m < MP) rms_row_to_bf16(a.in[I_XP] + (size_t)m * DM, a.in[I_G1], (bf16*)(ws + WS_XN) + (size_t)m * DM, F.lane);
        else if (m < MTOT) rms_row_to_bf16(a.in[I_XS] + (size_t)(m - MP) * DM, a.in[I_G1], (bf16*)(ws + WS_XN) + (size_t)m * DM, F.lane);
        else rms_row_to_bf16(a.in[I_MEMP] + (size_t)(m - MTOT) * DM, a.in[I_GMEM], (bf16*)(ws + WS_XM) + (size_t)(m - MTOT) * DM, F.lane);
    }
    if (!DEFER_CVT) cache_rows(a, gw, NGW, F.lane);
    if (blockIdx.x == 0) {
        float* lut = (float*)(ws + WS_LUT);
        for (int i = F.tid; i < 2 * 8 * 320; i += NWAVES * 64) { const int ty = i / 2560, h = (i / 320) & 7, e = i % 320, rel = e - 256;
            float v;
            if (ty == 0) v = a.in[I_T5][t5_bucket(rel) * 8 + h];
            else { const int idx = (rel < -128 ? -128 : (rel > 128 ? 128 : rel)) + 128; v = a.in[I_CBREL][idx * 8 + h]; }
            lut[i] = v * LOG2E; }
        if (F.wave == 0) { const float* lp = a.in[I_LAMBDA]; const float s1 = wave_sum(lp[F.lane] * lp[64 + F.lane]), s2 = wave_sum(lp[128 + F.lane] * lp[192 + F.lane]);
            if (F.lane == 0) *(float*)(ws + WS_LUT + 32768) = expf(s1) - expf(s2) + LAM_INIT; }
    }
}

__device__ __forceinline__ void rstd_phase(Frame& F, unsigned char* ws, int nrows) {
    const float* ssq = (const float*)(ws + WS_SSQ); float* rstd = (float*)(ws + WS_RSTD);
    for (int row = F.vcu * (NWAVES * 64) + F.tid; row < nrows; row += F.G * NWAVES * 64) {
        const f32x4* p = (const f32x4*)(ssq + (size_t)row * 32); float s = 0.f;
#pragma unroll
        for (int k = 0; k < 8; ++k) { const f32x4 v = p[k]; s += (v.x + v.y) + (v.z + v.w); }
        rstd[row] = 1.f / sqrtf(s * (1.f / DM) + EPS);
    }
}
__device__ __forceinline__ void final_phase(Frame& F, unsigned char* ws, float* outp, int nrows) {
    const float* ssq = (const float*)(ws + WS_SSQ); const bf16* XN = (const bf16*)(ws + WS_XN);
    const int gw = F.vcu * NWAVES + F.wave, NGW = F.G * NWAVES;
    for (int row = gw; row < nrows; row += NGW) {
        const GAS v4u* x = (const GAS v4u*)(XN + (size_t)row * DM) + F.lane; GAS f32x4* y = (GAS f32x4*)(outp + O_Y + (size_t)row * DM) + 2 * F.lane;
        v4u w[4];
#pragma unroll
        for (int j = 0; j < 4; ++j) w[j] = x[64 * j];
        const float part = F.lane < 32 ? ((const GAS float*)ssq)[(size_t)row * 32 + F.lane] : 0.f;
        const float rs = 1.f / sqrtf(wave_sum(part) * (1.f / DM) + EPS);
#pragma unroll
        for (int j = 0; j < 4; ++j) { f32x4 a, b;
            a[0] = __uint_as_float(w[j].x << 16); a[1] = __uint_as_float(w[j].x & 0xffff0000u); a[2] = __uint_as_float(w[j].y << 16); a[3] = __uint_as_float(w[j].y & 0xffff0000u);
            b[0] = __uint_as_float(w[j].z << 16); b[1] = __uint_as_float(w[j].z & 0xffff0000u); b[2] = __uint_as_float(w[j].w << 16); b[3] = __uint_as_float(w[j].w & 0xffff0000u);
            y[128 * j] = a * rs; y[128 * j + 1] = b * rs; }
    }
}
constexpr size_t WS_SLAB15 = 864 * MiB;
static_assert(WS_SLAB15 >= WS_A + (size_t)MTOT * FF * 2 && WS_SLAB15 + 4 * 64 * 65536 * 4 <= WS_END, "slab region");
template <int MODE  >
__device__ __forceinline__ f32x4 fixup_v(const float* slab, const bf16* XN, const float* xs, const float* gprev, float alpha, int s, int pn, int lane) {
    const int row = MP + s, tt = (s >> 8) + 8 * pn, col = pn * 256 + lane * 4;
    const GAS f32x4* sp = (const GAS f32x4*)(slab + (size_t)tt * 65536 + (s & 255) * 256 + lane * 4);
    const f32x4 a = (sp[0] + sp[(size_t)64 * 65536 / 4]) + (sp[(size_t)2 * 64 * 65536 / 4] + sp[(size_t)3 * 64 * 65536 / 4]);
    f32x4 b;
    if (MODE == 0) b = *(const GAS f32x4*)(xs + (size_t)s * DM + col);
    else { const unsigned long long w = *(const GAS unsigned long long*)(XN + (size_t)row * DM + col); const f32x4 gp = *(const GAS f32x4*)(gprev + col);
        b[0] = __uint_as_float((unsigned)w << 16) / gp[0]; b[1] = __uint_as_float((unsigned)w & 0xffff0000u) / gp[1];
        b[2] = __uint_as_float((unsigned)(w >> 32) << 16) / gp[2]; b[3] = __uint_as_float((unsigned)(w >> 32) & 0xffff0000u) / gp[3]; }
    return b + a * alpha;
}
template <int MODE, bool FINAL>
__device__ __forceinline__ void fixup_rows(Frame& F, unsigned char* ws, const float* slab, const float* xs, const float* gprev, const float* gnext, float alpha, float* outy) {
    const int gw = F.vcu * NWAVES + F.wave, NGW = F.G * NWAVES, lane = F.lane;
    bf16* XN = (bf16*)(ws + WS_XN); float* rstd = (float*)(ws + WS_RSTD);
    for (int s = gw; s < MS; s += NGW) { const int row = MP + s;
        float ss = 0.f;
#pragma unroll 1
        for (int pn = 0; pn < 8; ++pn) { const f32x4 v = fixup_v<MODE>(slab, XN, xs, gprev, alpha, s, pn, lane); ss += (v[0] * v[0] + v[1] * v[1]) + (v[2] * v[2] + v[3] * v[3]); }
        const float rs = 1.f / sqrtf(wave_sum(ss) * (1.f / DM) + EPS);
#pragma unroll 1
        for (int pn = 0; pn < 8; ++pn) { const f32x4 v = fixup_v<MODE>(slab, XN, xs, gprev, alpha, s, pn, lane); const int col = pn * 256 + lane * 4; const f32x4 gnx = *(const GAS f32x4*)(gnext + col);
            if (FINAL) *(GAS f32x4*)(outy + (size_t)row * DM + col) = v * rs * gnx;
            else { const f32x4 o = v * gnx; *(GAS unsigned long long*)(XN + (size_t)row * DM + col) = (unsigned long long)pk2(o[0], o[1]) | ((unsigned long long)pk2(o[2], o[3]) << 32); } }
        if (!FINAL && lane == 0) rstd[row] = rs;
    }
}
#ifndef ABL_BITS
#define ABL_BITS 0
#endif
#ifndef NO_DIFF
#define NO_DIFF 0
#endif
#ifndef NO_BAND
#define NO_BAND 0
#endif
#ifndef ATT_SD_DIFF
#define ATT_SD_DIFF 1
#endif
#ifndef ATT_SD_BAND
#define ATT_SD_BAND 1
#endif
using att::f32x16;
__device__ __forceinline__ void load_lut(Frame& F, const float* glut, char* lds) {
    __syncthreads();
    int t_ = threadIdx.x; asm volatile("" : "+v"(t_));
    if (t_ < 320) ((float*)(lds + att::LDS_LUT))[t_] = glut[t_];
    __syncthreads();
}
__device__ __forceinline__ void store_o_bf16(const f32x16 (&o)[4], bf16* Ow, int ld, char* lds, int wid) {
    int lane = threadIdx.x; asm volatile("" : "+v"(lane)); lane &= 63;
    const int r32 = lane & 31, hi = lane >> 5;
    bf16* stg = (bf16*)(lds + att::LDS_OSTAGE + wid * 4096);
#pragma unroll
    for (int hf = 0; hf < 2; ++hf) {
#pragma unroll
        for (int r = 0; r < 16; ++r) { const int orow = att::crow(r, hi);
#pragma unroll
            for (int dd = 0; dd < 2; ++dd) stg[orow * 64 + dd * 32 + r32] = (bf16)f2bf(o[2 * hf + dd][r]); }
        asm volatile("s_waitcnt lgkmcnt(0)" ::: "memory");
        bf16* gp = Ow + (size_t)(lane >> 3) * ld + hf * 64 + (lane & 7) * 8;
#pragma unroll
        for (int i = 0; i < 4; ++i) { const v4u v = *(const v4u*)(stg + (i * 8 + (lane >> 3)) * 64 + (lane & 7) * 8); *(v4u*)gp = v; gp += (size_t)8 * ld; }
        asm volatile("s_waitcnt lgkmcnt(0)" ::: "memory");
    }
}
__device__ __forceinline__ void store_ot_bf16(const f32x16 (&o)[4], bf16* Ow, int ld, char* lds, int wid) {
    int lane = threadIdx.x; asm volatile("" : "+v"(lane)); lane &= 63;
    const int q = lane & 31, hi = lane >> 5;
    bf16* stg = (bf16*)(lds + att::LDS_OSTAGE + wid * 4096);
#pragma unroll
    for (int hf = 0; hf < 2; ++hf) {
#pragma unroll
        for (int dd = 0; dd < 2; ++dd)
#pragma unroll
            for (int r = 0; r < 16; ++r) stg[q * 64 + dd * 32 + att::crow(r, hi)] = (bf16)f2bf(o[2 * hf + dd][r]);
        asm volatile("s_waitcnt lgkmcnt(0)" ::: "memory");
        bf16* gp = Ow + (size_t)(lane >> 3) * ld + hf * 64 + (lane & 7) * 8;
#pragma unroll
        for (int i = 0; i < 4; ++i) { const v4u v = *(const v4u*)(stg + (i * 8 + (lane >> 3)) * 64 + (lane & 7) * 8); *(v4u*)gp = v; gp += (size_t)8 * ld; }
        asm volatile("s_waitcnt lgkmcnt(0)" ::: "memory");
    }
}
template <bool sample>
__device__ __forceinline__ void diff_unit(Frame& F, unsigned char* ws, const float* dag, char* lds, int b, int h, int qb, bool dostore = true) {
    bf16* QO = (bf16*)(ws + WS_QO);
    const int wid = F.wave;
    const float lam = *(const float*)(ws + WS_LUT + 32768);
    const float* lut = (const float*)(lds + att::LDS_LUT);
    load_lut(F, (const float*)(ws + WS_LUT) + h * 320, lds);
    att::TileArgs T; T.abl = dostore ? 0 : ABL_BITS;
    size_t qrow; const bf16 *Kb, *Vb;
    if (!sample) { qrow = (size_t)b * SEQ + qb * 256 + wid * 32; Kb = (const bf16*)(ws + WS_KDAP) + (size_t)b * SEQ * 1024 + h * 128; Vb = (const bf16*)(ws + WS_VDAP) + (size_t)b * SEQ * 1024 + h * 128;
        T.t0 = 0; T.NT = 4 * qb + 4; T.tmax = T.NT - 1; T.wlo = 0; T.whi = 4 * qb + (wid >> 1); T.relw = -(qb * 256 + wid * 32); }
    else { qrow = (size_t)MP + b * DT + (wid & 1) * 32; Kb = (const bf16*)(ws + WS_KDAS) + (size_t)b * KDAS_ROWS * 1024 + h * 128; Vb = (const bf16*)(ws + WS_VDAS) + (size_t)b * KDAS_ROWS * 1024 + h * 128;
        T.t0 = 0; T.NT = 18; T.tmax = 16; T.wlo = 0; T.whi = 16; T.relw = -(PAST + (wid & 1) * 32); }
    T.ldq = DM; T.ldk = 1024; T.ldv = 1024; T.Vh = Vb;
    f32x16 o[4]; float l;
#pragma unroll 1
    for (int map = 0; map < 2; ++map) {
        T.Qw = QO + qrow * DM + h * 128 + map * 64; T.Kh = Kb + map * 64;
        att::attn_tiles<64, true, ATT_SD_DIFF, sample>(T, lut, lds, o, l);
        att::attn_normalize_t(o, l);
        if (map == 0) { int t_ = threadIdx.x; asm volatile("" : "+v"(t_));
            f32x4* stash = (f32x4*)(ws + WS_STASH) + ((size_t)blockIdx.x * 512 + t_) * 16;
#pragma unroll
            for (int d = 0; d < 4; ++d)
#pragma unroll
                for (int q = 0; q < 4; ++q) stash[d * 4 + q] = (f32x4){o[d][4 * q], o[d][4 * q + 1], o[d][4 * q + 2], o[d][4 * q + 3]};
        }
    }
    int t2_ = threadIdx.x; asm volatile("" : "+v"(t2_));
    const f32x4* stash = (const f32x4*)(ws + WS_STASH) + ((size_t)blockIdx.x * 512 + t2_) * 16; const int hib = (t2_ >> 5) & 1;
    float ssp = 0.f;
#pragma unroll
    for (int d = 0; d < 4; ++d)
#pragma unroll
        for (int q = 0; q < 4; ++q) { const f32x4 s4 = stash[d * 4 + q];
#pragma unroll
            for (int e = 0; e < 4; ++e) { const int r = 4 * q + e; const float v = s4[e] - lam * o[d][r]; o[d][r] = v; ssp += v * v; } }
    { auto rr = __builtin_amdgcn_permlane32_swap(__float_as_uint(ssp), __float_as_uint(ssp), false, false); ssp = __uint_as_float(rr[0]) + __uint_as_float(rr[1]); }
    const float rsn = (1.f - LAM_INIT) / sqrtf(ssp * (1.f / 128.f) + EPS);
#pragma unroll
    for (int d = 0; d < 4; ++d)
#pragma unroll
        for (int r = 0; r < 16; ++r) o[d][r] *= rsn * dag[d * 32 + (r & 3) + 8 * (r >> 2) + 4 * hib];
    __syncthreads();
    if (dostore && (!sample || wid < 2)) store_ot_bf16(o, QO + qrow * DM + h * 128, DM, lds, wid);
}
template <bool sample>
__device__ __forceinline__ void band_unit(Frame& F, unsigned char* ws, char* lds, int b, int h, int qb, bool dostore = true) {
    bf16* QO = (bf16*)(ws + WS_QO);
    const int wid = F.wave;
    const float* lut = (const float*)(lds + att::LDS_LUT);
    load_lut(F, (const float*)(ws + WS_LUT) + 2560 + h * 320, lds);
    att::TileArgs T; T.abl = 0; size_t qrow;
    if (!sample) { qrow = (size_t)b * SEQ + qb * 256 + wid * 32; const int c0 = 4 * qb, c = c0 + (wid >> 1);
        T.Kh = (const bf16*)(ws + WS_KCBP) + (size_t)b * SEQ * 1024 + h * 128; T.Vh = (const bf16*)(ws + WS_VCBP) + (size_t)b * SEQ * 1024 + h * 128;
        T.t0 = c0 >= 8 ? c0 - 8 : 0; T.tmax = c0 + 3; T.NT = T.tmax - T.t0 + 1; T.wlo = c >= 8 ? c - 8 : 0; T.whi = c; T.relw = -(qb * 256 + wid * 32); }
    else { qrow = (size_t)MP + b * DT + (wid & 1) * 32;
        T.Kh = (const bf16*)(ws + WS_KCBS) + (size_t)b * KCBS_ROWS * 1024 + h * 128; T.Vh = (const bf16*)(ws + WS_VCBS) + (size_t)b * KCBS_ROWS * 1024 + h * 128;
        T.t0 = 0; T.NT = 10; T.tmax = 8; T.wlo = 0; T.whi = 8; T.relw = (PAST - CBR) - (PAST + (wid & 1) * 32); }
    T.ldq = DM; T.ldk = 1024; T.ldv = 1024; T.Qw = QO + qrow * DM + 1024 + h * 128;
    f32x16 o[4]; float l;
    att::attn_tiles<128, true, ATT_SD_BAND, sample>(T, lut, lds, o, l); att::attn_normalize(o, l, lds);
    __syncthreads();
    if (dostore && (!sample || wid < 2)) store_o_bf16(o, QO + qrow * DM + 1024 + h * 128, DM, lds, wid);
}
__device__ __forceinline__ void cross_unit(Frame& F, unsigned char* ws, char* lds, bool sample, int b, int h, int qb, const float* qslab = nullptr) {
    bf16* QX = (bf16*)(ws + WS_QX);
    const int wid = F.wave;
    __syncthreads();
    if (sample && qslab) {
        int t = threadIdx.x; asm volatile("" : "+v"(t));
        const int r = t >> 3, cg = (t & 7) * 16, s = b * DT + r, tt = (s >> 8) + 8 * (h >> 1);
        const GAS f32x4* sp = (const GAS f32x4*)(qslab + (size_t)tt * 65536 + (s & 255) * 256 + (h & 1) * 128 + cg);
        const float sc = ((const GAS float*)(ws + WS_RSTD))[MP + s] * SC_CB;
        f32x4 a[4];
#pragma unroll
        for (int q = 0; q < 4; ++q) a[q] = ((sp[q] + sp[q + (size_t)16 * 65536 / 4]) + (sp[q + (size_t)2 * 16 * 65536 / 4] + sp[q + (size_t)3 * 16 * 65536 / 4])) * sc;
        v4u o0, o1; o0.x = pk2(a[0][0], a[0][1]); o0.y = pk2(a[0][2], a[0][3]); o0.z = pk2(a[1][0], a[1][1]); o0.w = pk2(a[1][2], a[1][3]);
        o1.x = pk2(a[2][0], a[2][1]); o1.y = pk2(a[2][2], a[2][3]); o1.z = pk2(a[3][0], a[3][1]); o1.w = pk2(a[3][2], a[3][3]);
        GAS v4u* d = (GAS v4u*)(QX + (size_t)(MP + s) * XW + h * 128 + cg); d[0] = o0; d[1] = o1;
        asm volatile("s_waitcnt vmcnt(0)" ::: "memory"); __syncthreads();
    }
    att::TileArgs T; T.abl = 0; size_t qrow;
    if (!sample) { qrow = (size_t)b * SEQ + qb * 256 + wid * 32; T.Kh = (const bf16*)(ws + WS_MKP) + (size_t)b * NMEM * XW + h * 128; T.Vh = (const bf16*)(ws + WS_MVP) + (size_t)b * NMEM * XW + h * 128; }
    else { qrow = (size_t)MP + b * DT + (wid & 1) * 32; T.Kh = (const bf16*)(ws + WS_MKS) + (size_t)b * NMEM * XW + h * 128; T.Vh = (const bf16*)(ws + WS_MVS) + (size_t)b * NMEM * XW + h * 128; }
    T.t0 = 0; T.NT = 4; T.tmax = 3; T.wlo = 0; T.whi = 3; T.relw = 0; T.ldq = XW; T.ldk = XW; T.ldv = XW; T.Qw = QX + qrow * XW + h * 128;
    f32x16 o[4]; float l;
    att::attn_tiles<128, false, 2>(T, nullptr, lds, o, l); att::attn_normalize(o, l, lds);
    __syncthreads();
    if (!sample || wid < 2) store_o_bf16(o, QX + qrow * XW + h * 128, XW, lds, wid);
}

constexpr int PT_OFF = MISC_OFF + 128;
__device__ __forceinline__ unsigned long long ldp(LAS unsigned char* lds, int idx) {
    volatile LAS unsigned* p = (volatile LAS unsigned*)(lds + PT_OFF) + 2 * idx;
    const unsigned lo = __builtin_amdgcn_readfirstlane(p[0]), hi = __builtin_amdgcn_readfirstlane(p[1]);
    return ((unsigned long long)hi << 32) | lo;
}
__global__ void __launch_bounds__(NWAVES * 64, 2) mega_fwd(Args args) {
    extern __shared__ __attribute__((aligned(16))) unsigned char lds[];
    Frame F;
    F.lds = (LAS unsigned char*)lds; F.MISC = (volatile LAS unsigned*)(F.lds + MISC_OFF);
    F.tid = threadIdx.x; F.lane = F.tid & 63; F.wave = __builtin_amdgcn_readfirstlane(F.tid >> 6);
    F.G = gridDim.x; { const int bx = blockIdx.x; F.vcu = (F.G % 8 == 0) ? (bx % 8) * (F.G / 8) + bx / 8 : bx; }
    F.ctl = (gu32*)(args.ws + WS_CTL);
    for (int u = F.tid; u < (LDS_BYTES - LDSCTL_OFF) / 4; u += NWAVES * 64) ((LAS unsigned*)(F.lds + LDSCTL_OFF))[u] = 0u;
    __syncthreads();
    if (F.tid == 0) { volatile LAS unsigned long long* PT = (volatile LAS unsigned long long*)(F.lds + PT_OFF);
        PT[0] = (unsigned long long)args.out; PT[1] = (unsigned long long)args.ws; PT[2] = (unsigned long long)args.in[I_XP]; PT[3] = (unsigned long long)args.in[I_XS];
        PT[4] = (unsigned long long)args.in[I_GMIX]; PT[5] = (unsigned long long)args.in[I_BGATE]; PT[6] = (unsigned long long)args.in[I_GCROSS]; PT[7] = (unsigned long long)args.in[I_G2];
        PT[8] = (unsigned long long)args.in[I_DAG]; PT[9] = (unsigned long long)args.in[I_GFINAL]; }
    __syncthreads();
#define LDP(T, idx) ((T)ldp(F.lds, (idx)))
    XcdBarrier bar; bar.bar = (unsigned*)(F.ctl + CW_BAR); bar.x = 0; bar.st = nullptr;
    if (N_LAUNCHES == 1) bar = xcd_barrier_post((unsigned*)(F.ctl + CW_BAR), F.MISC + 8);
#define GRID_BAR() do { if (N_LAUNCHES == 1) xcd_barrier(bar); } while (0)
    const int lo = args.ph_lo, hi = args.ph_hi;
#ifndef PH_MASK
#define PH_MASK 0x1ffff
#endif
#define IN(k) (((PH_MASK >> (k)) & 1) && lo <= (k) && (k) < hi)
#define BOTH(k) (IN(k) && IN((k) + 1))
#define IDS() do { int t_ = threadIdx.x; asm volatile("" : "+v"(t_)); F.tid = t_; F.lane = t_ & 63; } while (0)
    const int G = F.G, bx = (int)blockIdx.x;
    LAS unsigned char* ring = F.lds + RING_OFF;

    if (IN(0)) { IDS(); p0_prologue(F, args); if (BOTH(0)) GRID_BAR(); }
    if (IN(1)) {
        unsigned char* ws = LDP(unsigned char*, 1);
        { pg8::Gemm g{(const bf16*)(ws + WS_XN), (const bf16*)(ws + WS_W1GU), MTOT, 2 * FF, DM}; pg8::StaticOrder S; S.init(MTOT, 2 * FF, G, bx, 0, WGM_GU);
          pg8::EpiSwiGLU E{(bf16*)(ws + WS_A), FF, nullptr, A_BLOCKED};
          pg8::gemm_phase<pg8::EpiSwiGLU, pg8::StaticOrder, true, true>(ring, g, S, E); }
        if (bx >= G - 8) { float* out = LDP(float*, 0);
          pg8::Gemm g{(const bf16*)(ws + WS_XM), (const bf16*)(ws + WS_WMKV), NBP * NMEM, 1024, DM}; pg8::StaticOrder S; S.init(NBP * NMEM, 1024, G, bx - (G - 8));
          pg8::EpiMemKV E{(bf16*)(ws + WS_MKP), (bf16*)(ws + WS_MVP), out};
          pg8::gemm_phase<pg8::EpiMemKV, pg8::StaticOrder, true, true>(ring, g, S, E); }
        if (DEFER_CVT) {
            const int nfull = (MTOT / 256) * (2 * FF / 256) - ((MTOT / 256) * (2 * FF / 256) / G) * G;
            const int lo_b = nfull, hi_b = G - 8;
            if (hi_b > lo_b) { if (bx >= lo_b && bx < hi_b) { IDS(); tr_items(args, (LAS float*)(F.lds + RING_OFF + F.wave * 16384), N_EARLY, N_W1D, (bx - lo_b) * NWAVES + F.wave, (hi_b - lo_b) * NWAVES, F.lane); } }
            else { IDS(); tr_items(args, (LAS float*)(F.lds + RING_OFF + F.wave * 16384), N_EARLY, N_W1D, bx * NWAVES + F.wave, G * NWAVES, F.lane); }
        }
        if (BOTH(1)) GRID_BAR();
    }
    if (IN(2)) {
        unsigned char* ws = LDP(unsigned char*, 1); float* out = LDP(float*, 0);
        pg8::Gemm g{(const bf16*)(ws + WS_A), (const bf16*)(ws + WS_W1D), MTOT, DM, FF, 0, A_BLOCKED}; pg8::StaticOrder S; S.init(MTOT, DM, G, bx, PANEL_REV);
        pg8::EpiResidX E{LDP(const float*, 2), LDP(const float*, 3) - (size_t)MP * DM, 0.5f, LDP(const float*, 4), (bf16*)(ws + WS_XN), (float*)(ws + WS_SSQ)};
        pg8::gemm_phase<pg8::EpiResidX, pg8::StaticOrder, true, true>(ring, g, S, E);
        if (DEFER_CVT) {
            const int nfull = (MTOT / 256) * (DM / 256) - 4 * G;
            if (nfull >= 0 && nfull < G && bx >= nfull) { IDS(); const int gw = (bx - nfull) * NWAVES + F.wave, NGW = (G - nfull) * NWAVES;
                tr_items(args, (LAS float*)(F.lds + RING_OFF + F.wave * 16384), N_W2, NITEMS, gw, NGW, F.lane); cache_rows(args, gw, NGW, F.lane); }
            else if (nfull < 0 || nfull >= G) { IDS(); const int gw = bx * NWAVES + F.wave, NGW = G * NWAVES;
                tr_items(args, (LAS float*)(F.lds + RING_OFF + F.wave * 16384), N_W2, NITEMS, gw, NGW, F.lane); cache_rows(args, gw, NGW, F.lane); }
        }
        if (BOTH(2)) GRID_BAR();
    }
    if (IN(3)) { IDS(); rstd_phase(F, LDP(unsigned char*, 1), MTOT); if (BOTH(3)) GRID_BAR(); }
    if (IN(4)) {
        unsigned char* ws = LDP(unsigned char*, 1); float* out = LDP(float*, 0);
        pg8::Gemm g{(const bf16*)(ws + WS_XN), (const bf16*)(ws + WS_WQKV), MTOT, 6144, DM}; pg8::StaticOrder S; S.init(MTOT, 6144, G, bx, 0, WGM_QKV);
        pg8::EpiQKV E{(const float*)(ws + WS_RSTD), (bf16*)(ws + WS_QO), (bf16*)(ws + WS_KDAP), (bf16*)(ws + WS_KDAS), (bf16*)(ws + WS_KCBS), out};
        pg8::gemm_phase<pg8::EpiQKV, pg8::StaticOrder, true, true>(ring, g, S, E);
        if (BOTH(4)) GRID_BAR();
    }
    if (IN(5)) {
        IDS();
        unsigned char* ws = LDP(unsigned char*, 1); const float* dag = LDP(const float*, 8);
        char* al = (char*)lds + RING_OFF;
#ifndef DUP_DIFF
#define DUP_DIFF 0
#endif
#ifndef DUP_BAND
#define DUP_BAND 0
#endif
        for (int u = F.vcu; u < 1024; u += G) {
            const int v = u & 255, i = u >> 8, bh = v >> 4, s = v & 15; const int qb = i == 0 ? s : i == 1 ? 31 - s : i == 2 ? 32 + s : 63 - s;
            if (!NO_DIFF) diff_unit<false>(F, ws, dag, al, bh >> 3, bh & 7, qb); }
        for (int u = 1024 + F.vcu; u < 1280; u += G) {
            const int v = u & 255;
            if (!NO_DIFF) diff_unit<true>(F, ws, dag, al, v >> 3, v & 7, 0); }
        for (int u = F.vcu; u < 1024; u += G) { const int v = u & 255, i = u >> 8, bh = v >> 4;
            if (!NO_BAND) band_unit<false>(F, ws, al, bh >> 3, bh & 7, (v & 15) * 4 + i); }
        for (int u = 1024 + F.vcu; u < 1280; u += G) { const int v = u & 255;
            if (!NO_BAND) band_unit<true>(F, ws, al, v >> 3, v & 7, 0); }
        __syncthreads();
        if (BOTH(5)) GRID_BAR();
    }
    if (IN(6)) {
        unsigned char* ws = LDP(unsigned char*, 1);
        pg8::Gemm g{(const bf16*)(ws + WS_XN), (const bf16*)(ws + WS_WG), MTOT, 4096, DM}; pg8::StaticOrder S; S.init(MTOT, 4096, G, bx, PANEL_REV, WGM_QKV);
        pg8::EpiGates E{(const float*)(ws + WS_RSTD), LDP(const float*, 5), (bf16*)(ws + WS_GR), (bf16*)(ws + WS_GB)};
        pg8::gemm_phase<pg8::EpiGates, pg8::StaticOrder, true, true>(ring, g, S, E);
        if (BOTH(6)) GRID_BAR();
    }
    if (IN(7)) {
        unsigned char* ws = LDP(unsigned char*, 1);
        pg8::Gemm g{(const bf16*)(ws + WS_QO), (const bf16*)(ws + WS_WBR), MTOT, DM, DM}; pg8::StaticOrder S; S.init(MTOT, DM, G, bx);
        pg8::EpiMix E{(const bf16*)(ws + WS_GR), (const bf16*)(ws + WS_GB), (bf16*)(ws + WS_MIX)};
        pg8::gemm_phase<pg8::EpiMix, pg8::StaticOrder, true, true>(ring, g, S, E);
        if (DEFER_CVT) {
            const int nfull = (MTOT / 256) * (DM / 256) - 4 * G;
            if (nfull >= 0 && nfull < G) { if (bx >= nfull) { IDS(); tr_items(args, (LAS float*)(F.lds + RING_OFF + F.wave * 16384), N_W1D, N_W2, (bx - nfull) * NWAVES + F.wave, (G - nfull) * NWAVES, F.lane); } }
            else { IDS(); tr_items(args, (LAS float*)(F.lds + RING_OFF + F.wave * 16384), N_W1D, N_W2, bx * NWAVES + F.wave, G * NWAVES, F.lane); }
        }
        if (BOTH(7)) GRID_BAR();
    }
    if (IN(8)) {
        unsigned char* ws = LDP(unsigned char*, 1); const bool split = (G == 256);
        { pg8::Gemm g{(const bf16*)(ws + WS_MIX), (const bf16*)(ws + WS_WO), split ? MP : MTOT, DM, DM}; pg8::StaticOrder S; S.init(split ? MP : MTOT, DM, G, bx, PANEL_REV);
          pg8::EpiResidH<false> E{(bf16*)(ws + WS_XN), LDP(const float*, 4), LDP(const float*, 6), nullptr, 1.0f, (float*)(ws + WS_SSQ)};
          pg8::gemm_phase<pg8::EpiResidH<false>, pg8::StaticOrder, true, true>(ring, g, S, E); }
        if (split) { const int tt = bx >> 2, ks = bx & 3; float* slab = LDP(float*, 0) + O_Y;
          pg8::Gemm g{(const bf16*)(ws + WS_MIX) + (size_t)MP * DM + ks * (DM / 4), (const bf16*)(ws + WS_WO) + ks * (DM / 4), MS, DM, DM / 4, DM}; pg8::OneUnit S{{tt & 7, tt >> 3}};
          pg8::EpiSlab E{slab + (size_t)(ks * 64 + tt) * 65536};
          pg8::gemm_phase<pg8::EpiSlab, pg8::OneUnit, true, true>(ring, g, S, E); }
        if (BOTH(8)) GRID_BAR();
    }
    if (IN(9)) { IDS(); unsigned char* ws = LDP(unsigned char*, 1); const bool split = (G == 256); rstd_phase(F, ws, split ? MP : MTOT);
        if (split) fixup_rows<1, false>(F, ws, LDP(const float*, 0) + O_Y, nullptr, LDP(const float*, 4), LDP(const float*, 6), 1.0f, nullptr);
        if (BOTH(9)) GRID_BAR(); }
    if (IN(10)) {
        unsigned char* ws = LDP(unsigned char*, 1);
        const bool split = (G == 256);
        { pg8::Gemm g{(const bf16*)(ws + WS_XN), (const bf16*)(ws + WS_WCQ), split ? MP : MTOT, XW, DM}; pg8::StaticOrder S; S.init(split ? MP : MTOT, XW, G, bx);
          pg8::EpiScaleBf16 E{(const float*)(ws + WS_RSTD), (bf16*)(ws + WS_QX), XW, SC_CB};
          pg8::gemm_phase<pg8::EpiScaleBf16, pg8::StaticOrder, true, true>(ring, g, S, E); }
        if (split && bx < 64) { const int tt = bx >> 2, ks = bx & 3; float* slab = LDP(float*, 0) + O_Y;
          pg8::Gemm g{(const bf16*)(ws + WS_XN) + (size_t)MP * DM + ks * (DM / 4), (const bf16*)(ws + WS_WCQ) + ks * (DM / 4), MS, XW, DM / 4, DM}; pg8::OneUnit S{{tt & 7, tt >> 3}};
          pg8::EpiSlab E{slab + (size_t)(ks * 16 + tt) * 65536};
          pg8::gemm_phase<pg8::EpiSlab, pg8::OneUnit, true, true>(ring, g, S, E); }
        if (BOTH(10)) GRID_BAR();
    }
    if (IN(11)) {
        IDS();
        unsigned char* ws = LDP(unsigned char*, 1);
        char* al = (char*)lds + RING_OFF;
        for (int u = F.vcu; u < 640; u += G) {
            const bool smp = u >= 512;
            cross_unit(F, ws, al, smp, smp ? ((u - 512) >> 2) : (u >> 8), smp ? ((u - 512) & 3) : ((u >> 6) & 3), smp ? 0 : (u & 63), (G == 256) ? LDP(const float*, 0) + O_Y : nullptr);
        }
        __syncthreads();
        if (BOTH(11)) GRID_BAR();
    }
    if (IN(12)) {
        unsigned char* ws = LDP(unsigned char*, 1); const bool split = (G == 256);
        { pg8::Gemm g{(const bf16*)(ws + WS_QX), (const bf16*)(ws + WS_WCO), split ? MP : MTOT, DM, XW}; pg8::StaticOrder S; S.init(split ? MP : MTOT, DM, G, bx, PANEL_REV);
          pg8::EpiResidH<false> E{(bf16*)(ws + WS_XN), LDP(const float*, 6), LDP(const float*, 7), nullptr, 1.0f, (float*)(ws + WS_SSQ)};
          pg8::gemm_phase<pg8::EpiResidH<false>, pg8::StaticOrder, true, true>(ring, g, S, E); }
        if (split) { const int tt = bx >> 2, ks = bx & 3; float* slab = LDP(float*, 0) + O_Y;
          pg8::Gemm g{(const bf16*)(ws + WS_QX) + (size_t)MP * XW + ks * (XW / 4), (const bf16*)(ws + WS_WCO) + ks * (XW / 4), MS, DM, XW / 4, XW}; pg8::OneUnit S{{tt & 7, tt >> 3}};
          pg8::EpiSlab E{slab + (size_t)(ks * 64 + tt) * 65536};
          pg8::gemm_phase<pg8::EpiSlab, pg8::OneUnit, true, true>(ring, g, S, E); }
        if (BOTH(12)) GRID_BAR();
    }
    if (IN(13)) { IDS(); unsigned char* ws = LDP(unsigned char*, 1); const bool split = (G == 256); rstd_phase(F, ws, split ? MP : MTOT);
        if (split) fixup_rows<1, false>(F, ws, LDP(const float*, 0) + O_Y, nullptr, LDP(const float*, 6), LDP(const float*, 7), 1.0f, nullptr);
        if (BOTH(13)) GRID_BAR(); }
    if (IN(14)) {
        unsigned char* ws = LDP(unsigned char*, 1);
        pg8::Gemm g{(const bf16*)(ws + WS_XN), (const bf16*)(ws + WS_W2GU), MTOT, 2 * FF, DM}; pg8::StaticOrder S; S.init(MTOT, 2 * FF, G, bx, 0, WGM_GU);
        pg8::EpiSwiGLU E{(bf16*)(ws + WS_A), FF, (const float*)(ws + WS_RSTD), A_BLOCKED};
        pg8::gemm_phase<pg8::EpiSwiGLU, pg8::StaticOrder, true, true>(ring, g, S, E);
        if (BOTH(14)) GRID_BAR();
    }
    if (IN(15)) {
        unsigned char* ws = LDP(unsigned char*, 1); const bool split = (G == 256);
        { pg8::Gemm g{(const bf16*)(ws + WS_A), (const bf16*)(ws + WS_W2D), split ? MP : MTOT, DM, FF, 0, A_BLOCKED}; pg8::StaticOrder S; S.init(split ? MP : MTOT, DM, G, bx, PANEL_REV);
          pg8::EpiResidH<false> E{(bf16*)(ws + WS_XN), LDP(const float*, 7), LDP(const float*, 9), nullptr, 0.5f, (float*)(ws + WS_SSQ)};
          pg8::gemm_phase<pg8::EpiResidH<false>, pg8::StaticOrder, true, true>(ring, g, S, E); }
        if (split) { const int tt = bx >> 2, ks = bx & 3; float* slab = (float*)(ws + WS_SLAB15);
          pg8::Gemm g{(const bf16*)(ws + WS_A) + (size_t)MP * FF + (A_BLOCKED ? (size_t)ks * (FF / 4 / 64) * (256 * 64) : (size_t)ks * (FF / 4)), (const bf16*)(ws + WS_W2D) + ks * (FF / 4), MS, DM, FF / 4, FF, A_BLOCKED}; pg8::OneUnit S{{tt & 7, tt >> 3}};
          pg8::EpiSlab E{slab + (size_t)(ks * 64 + tt) * 65536};
          pg8::gemm_phase<pg8::EpiSlab, pg8::OneUnit, true, true>(ring, g, S, E); }
        if (BOTH(15)) GRID_BAR();
    }
    if (IN(16)) { IDS(); unsigned char* ws = LDP(unsigned char*, 1); float* out = LDP(float*, 0); const bool split = (G == 256); final_phase(F, ws, out, split ? MP : MTOT);
        if (split) fixup_rows<1, true>(F, ws, (const float*)(ws + WS_SLAB15), nullptr, LDP(const float*, 7), LDP(const float*, 9), 0.5f, out + O_Y); }
#undef IN
#undef BOTH
#undef GRID_BAR
#undef LDP
#undef IDS
}

extern "C" void kernel_launch(void* const* d_in, const int* in_sizes, int n_in, void* d_out, int out_size, void* d_ws, size_t ws_size, hipStream_t stream) {
    static int grid = 0;
    if (grid == 0) {
        if (n_in != 33 || (size_t)out_size != O_TOTAL || ws_size < WS_END) { fprintf(stderr, "kernel_launch: shape mismatch: n_in %d out %d ws %zu (need 33, %zu, >= %zu)\n", n_in, out_size, ws_size, (size_t)O_TOTAL, (size_t)WS_END); grid = -1; return; }
        int dev = 0, cus = 0, per_cu = 0;
        if (hipGetDevice(&dev) != hipSuccess || hipDeviceGetAttribute(&cus, hipDeviceAttributeMultiprocessorCount, dev) != hipSuccess) { grid = -1; return; }
        if (hipFuncSetAttribute((const void*)mega_fwd, hipFuncAttributeMaxDynamicSharedMemorySize, LDS_BYTES) != hipSuccess) { fprintf(stderr, "kernel_launch: hipFuncSetAttribute failed\n"); grid = -1; return; }
        if (hipOccupancyMaxActiveBlocksPerMultiprocessor(&per_cu, (const void*)mega_fwd, NWAVES * 64, LDS_BYTES) != hipSuccess || per_cu < 1)
            fprintf(stderr, "kernel_launch: note: occupancy query reports %d workgroups per CU\n", per_cu);
        (void)hipGetLastError();
        grid = cus;
    }
    if (grid < 0) return;
    if (hipMemsetAsync((char*)d_ws + WS_CTL, 0, CTL_ZERO_BYTES, stream) != hipSuccess) return;
    Args a{};
    for (int i = 0; i < 33; ++i) a.in[i] = (const float*)d_in[i];
    a.out = (float*)d_out; a.ws = (unsigned char*)d_ws;
    if (N_LAUNCHES == 1) { a.ph_lo = 0; a.ph_hi = N_PHASES; a.li = 0; hipLaunchKernelGGL(mega_fwd, dim3(grid), dim3(NWAVES * 64), LDS_BYTES, stream, a); }
    else for (int p = 0; p < N_PHASES; ++p) { a.ph_lo = p; a.ph_hi = p + 1; a.li = p; hipLaunchKernelGGL(mega_fwd, dim3(grid), dim3(NWAVES * 64), LDS_BYTES, stream, a); }
    const hipError_t le = hipPeekAtLastError();
    if (le != hipSuccess) fprintf(stderr, "kernel_launch: launch failed: %s\n", hipGetErrorName(le));
}
```
